# Optimizing an MI355X kernel written in HIP

```python
import jax, jax.numpy as jnp
from jax import lax
import numpy as np

D_MODEL = 1024
BATCH = 8
SEQ = 4096
DEPTH = 1
DEC_BATCH = 32
DEC_SEQ = 64
PAST_LEN = 4096

CHUNK = 64
HEAD_DIM = 64
N_HEADS = D_MODEL // HEAD_DIM
RWKV_W = N_HEADS * HEAD_DIM
LORA_W = 64
LORA_A = 64
LORA_G = 128
SHIFT_W = 3 * RWKV_W + LORA_W + LORA_A + LORA_G
GMLP_W = D_MODEL
GMLP_CHUNK = 128
GMLP_GC = 128
GMLP_GROUPS = GMLP_W // GMLP_GC
IN_W = SHIFT_W + 2 * GMLP_W + 2 * D_MODEL
D_FF = -(-8 * D_MODEL // (3 * 256)) * 256
RMS_EPS = 1e-6
GN_EPS = 64e-5
LN_EPS = 1e-5

kernel_name = "rwkv7_gmlp_griffin_merge_stream_step"


def _rms_norm(x, g):
    xf = x.astype(jnp.float32)
    y = xf * lax.rsqrt(jnp.mean(xf * xf, axis=-1, keepdims=True) + RMS_EPS)
    return (y * g.astype(jnp.float32)).astype(x.dtype)


def _layer_norm(x, g, b):
    xf = x.astype(jnp.float32)
    mean = jnp.mean(xf, axis=-1, keepdims=True)
    var = jnp.mean(jnp.square(xf - mean), axis=-1, keepdims=True)
    return (xf - mean) * lax.rsqrt(var + LN_EPS) * g.astype(jnp.float32) + b.astype(jnp.float32)


def _wkv7_scan(S0, r, w, k, v, a, b):
    xs = tuple(jnp.swapaxes(t, 0, 1) for t in (r, w, k, v, a, b))

    def step(S, inp):
        r_t, w_t, k_t, v_t, a_t, b_t = inp
        sa = jnp.einsum('bhvk,bhk->bhv', S, a_t)
        S = S * w_t[:, :, None, :] + sa[..., None] * b_t[:, :, None, :] + v_t[..., None] * k_t[:, :, None, :]
        y = jnp.einsum('bhvk,bhk->bhv', S, r_t)
        return S, y

    S, ys = lax.scan(step, S0, xs)
    return jnp.swapaxes(ys, 0, 1), S


def _rwkv7(p, prev_row, S0, lp):
    B, T, _ = p.shape
    p_prev = jnp.concatenate([prev_row.astype(p.dtype), p[:, :-1]], axis=1)
    xm = p + (p_prev - p) * lp['mu_shift']
    o = 0
    r = xm[..., o:o + RWKV_W]; o += RWKV_W
    k = xm[..., o:o + RWKV_W]; o += RWKV_W
    v = xm[..., o:o + RWKV_W]; o += RWKV_W
    dw = xm[..., o:o + LORA_W]; o += LORA_W
    da = xm[..., o:o + LORA_A]; o += LORA_A
    dg = xm[..., o:o + LORA_G]
    f32 = lambda t: t.astype(jnp.float32)
    w_log = -jax.nn.softplus(-(f32(lp['w0']) + f32(jnp.tanh(dw) @ lp['w_lora_w']))) - 0.5
    decay = jnp.exp(-jnp.exp(w_log))
    a_rate = jax.nn.sigmoid(f32(lp['a0']) + f32(da @ lp['w_lora_a']))
    g = jax.nn.sigmoid(dg) @ lp['w_lora_g']
    hd = lambda t: f32(t).reshape(B, T, N_HEADS, HEAD_DIM)
    kk = hd(k * lp['k_k'])
    kk = kk / jnp.maximum(jnp.sqrt(jnp.sum(kk * kk, axis=-1, keepdims=True)), 1e-12)
    k_mod = f32(k) * (1.0 + (a_rate - 1.0) * f32(lp['k_a']))
    rh, kh, vh = hd(r), hd(k_mod), hd(v)
    ah = hd(a_rate)
    y, S = _wkv7_scan(S0.astype(jnp.float32), rh, hd(decay), kh, vh, -kk, kk * ah)
    mean = jnp.mean(y, axis=-1, keepdims=True)
    var = jnp.mean(jnp.square(y - mean), axis=-1, keepdims=True)
    yn = ((y - mean) * lax.rsqrt(var + GN_EPS)).reshape(B, T, RWKV_W) * f32(lp['gn_g']) + f32(lp['gn_b'])
    bonus = (jnp.sum(rh * kh * f32(lp['r_k']), axis=-1, keepdims=True) * vh).reshape(B, T, RWKV_W)
    out = ((yn + bonus) * f32(g)).astype(p.dtype)
    return out, S, p[:, -1:]


def _gmlp(u, vg, chunk, lp):
    B, T, _ = vg.shape
    vn = _layer_norm(vg, lp['ln_v_g'], lp['ln_v_b'])
    vc = vn.reshape(B, T // chunk, chunk, GMLP_GROUPS, GMLP_GC)
    mask = jnp.tril(jnp.ones((chunk, chunk), jnp.float32))
    ws = lp['w_spatial'][:, :chunk, :chunk].astype(jnp.float32) * mask
    bias = jnp.transpose(lp['b_spatial'][:, :chunk].astype(jnp.float32))
    z = jnp.einsum('gts,bnsgc->bntgc', ws, vc) + bias[None, None, :, :, None]
    out = (u.astype(jnp.float32) * z.reshape(B, T, GMLP_W)).astype(u.dtype)
    return out, vn.astype(u.dtype)


def _layer(x, prev_row, S0, chunk, lp):
    h = _rms_norm(x, lp['g_pre_mix'])
    p = h @ lp['w_in']
    o = SHIFT_W
    p_shift = p[..., :o]
    pu = p[..., o:o + GMLP_W]; o += GMLP_W
    pv = p[..., o:o + GMLP_W]; o += GMLP_W
    pga = p[..., o:o + D_MODEL]; o += D_MODEL
    pgb = p[..., o:o + D_MODEL]
    o_a, S, last_row = _rwkv7(p_shift, prev_row, S0, lp)
    o_b, vn = _gmlp(pu, pv, chunk, lp)
    m = jax.nn.sigmoid(pga) * (o_a @ lp['w_proj_a']) + jax.nn.sigmoid(pgb) * (o_b @ lp['w_proj_b'])
    x = x + _rms_norm(m @ lp['w_o'], lp['g_post_mix'])
    f = _rms_norm(x, lp['g_pre_ffn'])
    f = (jax.nn.silu(f @ lp['w_gate']) * (f @ lp['w_up'])) @ lp['w_down']
    x = x + _rms_norm(f, lp['g_post_ffn'])
    return x, last_row, S.astype(x.dtype), vn


def setup_inputs(seed: int = 0) -> dict:
    key = jax.random.key(seed)
    ks = jax.random.split(key, 32)
    nrm = lambda k, shape, s: jax.random.normal(k, shape, jnp.float32) * s
    L = DEPTH
    return {
        "x_prompt": nrm(ks[0], (BATCH, SEQ, D_MODEL), 1.0),
        "x_sample": nrm(ks[1], (DEC_BATCH, DEC_SEQ, D_MODEL), 1.0),
        "state_shift": nrm(ks[2], (L, DEC_BATCH, 1, SHIFT_W), 1.0),
        "state_wkv": nrm(ks[3], (L, DEC_BATCH, N_HEADS, HEAD_DIM, HEAD_DIM), 0.1),
        "g_pre_mix": 1.0 + nrm(ks[4], (L, D_MODEL), 0.05),
        "w_in": nrm(ks[5], (L, D_MODEL, IN_W), D_MODEL ** -0.5),
        "mu_shift": jax.random.uniform(ks[6], (L, SHIFT_W), jnp.float32),
        "w0": jax.random.uniform(ks[7], (L, RWKV_W), jnp.float32, -4.0, -0.5),
        "w_lora_w": nrm(ks[8], (L, LORA_W, RWKV_W), 0.5 * LORA_W ** -0.5),
        "a0": nrm(ks[9], (L, RWKV_W), 0.1),
        "w_lora_a": nrm(ks[10], (L, LORA_A, RWKV_W), 0.5 * LORA_A ** -0.5),
        "w_lora_g": nrm(ks[11], (L, LORA_G, RWKV_W), LORA_G ** -0.5),
        "k_k": 0.85 + nrm(ks[12], (L, RWKV_W), 0.05),
        "k_a": 1.0 + nrm(ks[13], (L, RWKV_W), 0.05),
        "r_k": nrm(ks[14], (L, N_HEADS, HEAD_DIM), 0.1),
        "gn_g": 1.0 + nrm(ks[15], (L, RWKV_W), 0.05),
        "gn_b": nrm(ks[16], (L, RWKV_W), 0.01),
        "ln_v_g": 1.0 + nrm(ks[17], (L, GMLP_W), 0.05),
        "ln_v_b": nrm(ks[18], (L, GMLP_W), 0.01),
        "w_spatial": nrm(ks[19], (L, GMLP_GROUPS, GMLP_CHUNK, GMLP_CHUNK), GMLP_CHUNK ** -0.5),
        "b_spatial": 1.0 + nrm(ks[20], (L, GMLP_GROUPS, GMLP_CHUNK), 0.05),
        "w_proj_a": nrm(ks[21], (L, RWKV_W, D_MODEL), RWKV_W ** -0.5),
        "w_proj_b": nrm(ks[22], (L, GMLP_W, D_MODEL), GMLP_W ** -0.5),
        "w_o": nrm(ks[23], (L, D_MODEL, D_MODEL), D_MODEL ** -0.5),
        "g_post_mix": 1.0 + nrm(ks[24], (L, D_MODEL), 0.05),
        "g_pre_ffn": 1.0 + nrm(ks[25], (L, D_MODEL), 0.05),
        "w_gate": nrm(ks[26], (L, D_MODEL, D_FF), D_MODEL ** -0.5),
        "w_up": nrm(ks[27], (L, D_MODEL, D_FF), D_MODEL ** -0.5),
        "w_down": nrm(ks[28], (L, D_FF, D_MODEL), D_FF ** -0.5),
        "g_post_ffn": 1.0 + nrm(ks[29], (L, D_MODEL), 0.05),
    }


def reference(x_prompt, x_sample, state_shift, state_wkv, g_pre_mix, w_in, mu_shift, w0, w_lora_w, a0,
              w_lora_a, w_lora_g, k_k, k_a, r_k, gn_g, gn_b, ln_v_g, ln_v_b, w_spatial, b_spatial,
              w_proj_a, w_proj_b, w_o, g_post_mix, g_pre_ffn, w_gate, w_up, w_down, g_post_ffn):
    yp, ys = x_prompt, x_sample
    shift_p, wkv_p, shift_s, wkv_s, v_s = [], [], [], [], []
    Bp = x_prompt.shape[0]
    for l in range(DEPTH):
        lp = {
            'g_pre_mix': g_pre_mix[l], 'w_in': w_in[l], 'mu_shift': mu_shift[l], 'w0': w0[l],
            'w_lora_w': w_lora_w[l], 'a0': a0[l], 'w_lora_a': w_lora_a[l], 'w_lora_g': w_lora_g[l],
            'k_k': k_k[l], 'k_a': k_a[l], 'r_k': r_k[l], 'gn_g': gn_g[l], 'gn_b': gn_b[l],
            'ln_v_g': ln_v_g[l], 'ln_v_b': ln_v_b[l], 'w_spatial': w_spatial[l], 'b_spatial': b_spatial[l],
            'w_proj_a': w_proj_a[l], 'w_proj_b': w_proj_b[l], 'w_o': w_o[l], 'g_post_mix': g_post_mix[l],
            'g_pre_ffn': g_pre_ffn[l], 'w_gate': w_gate[l], 'w_up': w_up[l], 'w_down': w_down[l],
            'g_post_ffn': g_post_ffn[l],
        }
        zero_row = jnp.zeros((Bp, 1, SHIFT_W), x_prompt.dtype)
        zero_S = jnp.zeros((Bp, N_HEADS, HEAD_DIM, HEAD_DIM), jnp.float32)
        yp, sp, wp, _ = _layer(yp, zero_row, zero_S, GMLP_CHUNK, lp)
        ys, ss, wsm, vs = _layer(ys, state_shift[l], state_wkv[l], x_sample.shape[1], lp)
        shift_p.append(sp); wkv_p.append(wp); shift_s.append(ss); wkv_s.append(wsm); v_s.append(vs)
    return (yp, ys, jnp.stack(shift_p), jnp.stack(wkv_p), jnp.stack(shift_s), jnp.stack(wkv_s), jnp.stack(v_s))
```

```cpp
#include <hip/hip_runtime.h>
#include <hip/hip_cooperative_groups.h>
#include <cstdio>
#include <cstdint>
namespace cg = cooperative_groups;
namespace pg8 {
#define PG8_LAS __attribute__((address_space(3)))
typedef unsigned short bf16_t;
typedef short bf16x8 __attribute__((ext_vector_type(8)));
typedef float f32x4 __attribute__((ext_vector_type(4)));
typedef unsigned u32x4 __attribute__((ext_vector_type(4)));
constexpr int BM = 256, BK = 64, HALF = 128, HTB = HALF * BK * 2  , STAGE_BYTES = 8 * HTB, NXCD = 8, WGM = 8;

__host__ __device__ __forceinline__ int lds_byte(int r, int c) { const int st = (r >> 4) * 2 + (c >> 5), rr = r & 15, cc = c & 31, ob = rr * 64 + cc * 2; return st * 1024 + (ob ^ (((ob >> 9) & 1) << 5)); }
__host__ __device__ __forceinline__ void stage_rc(int b, int& R, int& C) { const int st = b / 1024, sb = b % 1024, swz = sb ^ (((sb >> 9) & 1) << 5); R = (st >> 1) * 16 + swz / 64; C = (st & 1) * 32 + (swz % 64) / 2; }
__host__ __device__ __forceinline__ int perm32(int rho) { const int n = rho >> 4, i = rho & 15; return 8 * (i >> 2) + 4 * n + (i & 3); }

struct Unit { int pm, pn; };
struct Gemm { const bf16_t* A; const bf16_t* Bt; int M, N, K; };

struct StaticOrder {
    int nM, nN, nwg, G, c;
    __host__ __device__ void init(int M, int N, int G_, int c_) { nM = M / BM; nN = N / BM; nwg = nM * nN; G = G_; c = c_; }
    __host__ __device__ bool next(int i, Unit& u) const {
        const long L = (long)i * G + c; if (L >= nwg) return false;
        int wgid = (int)L; { const int q = nwg / NXCD, r = nwg % NXCD, xcd = wgid % NXCD, off = wgid / NXCD; wgid = (xcd < r ? xcd * (q + 1) : r * (q + 1) + (xcd - r) * q) + off; }
        const int nig = WGM * nN, gid = wgid / nig, fm = gid * WGM, gsz = (nM - fm) < WGM ? (nM - fm) : WGM;
        u.pm = fm + ((wgid % nig) % gsz); u.pn = (wgid % nig) / gsz; return true;
    }
    __device__ __forceinline__ void a_ready(const Unit&) const {}
    __device__ __forceinline__ void done(const Unit&) const {}
};

__device__ __forceinline__ unsigned cvt_pk_bf16(float lo, float hi) { unsigned r; asm volatile("v_cvt_pk_bf16_f32 %0, %1, %2" : "=v"(r) : "v"(lo), "v"(hi)); return r; }
typedef float f32x2 __attribute__((ext_vector_type(2)));
template <class Epi, class Sched, bool ALIGN_EPI = false, bool SP2 = false>
__device__ __forceinline__ void gemm_phase(PG8_LAS unsigned char* lds, const Gemm g, const Sched& S, const Epi& E) {
    const int tid = threadIdx.x, wid = __builtin_amdgcn_readfirstlane(tid >> 6), lane = tid & 63, wr = wid >> 2, wc = wid & 3, fr = lane & 15, fq = lane >> 4;
    const int K = g.K, nt = K / BK;
    unsigned voffA[2], voffB[2];
#pragma unroll
    for (int i = 0; i < 2; ++i) { int R, C; stage_rc(tid * 16 + i * 8192, R, C); const int Rb = Epi::PERM ? ((R & ~31) + perm32(R & 31)) : R;
        voffA[i] = (unsigned)(R * K + C) * 2u; voffB[i] = (unsigned)(Rb * K + C) * 2u; }
    const size_t kstep = (size_t)(BK * 2);
    const size_t hstep = (size_t)HALF * K * 2;
    const size_t tstep = 2 * hstep;
    const unsigned ldsw = (unsigned)wid * 1024u;
    const int aoff = lds_byte(wr * 64 + fr, fq * 8), boff = lds_byte(wc * 32 + fr, fq * 8);
#define PG8_SA(b, h) (((b) * 2 + (h)) * HTB)
#define PG8_SB(b, h) ((4 + (b) * 2 + (h)) * HTB)
#define PG8_STAGE(bufoff, gbase, voff) do { _Pragma("unroll") for (int _i = 0; _i < 2; ++_i) \
        __builtin_amdgcn_global_load_lds((const unsigned*)((const char*)(gbase) + (voff)[_i]), (PG8_LAS unsigned*)(lds + (bufoff) + ldsw + _i * 8192), 16, 0, 0); } while (0)
#define PG8_LDA(dst, b, h) do { _Pragma("unroll") for (int m = 0; m < 4; ++m) _Pragma("unroll") for (int k = 0; k < 2; ++k) dst[m][k] = *(const PG8_LAS bf16x8*)(lds + PG8_SA(b, h) + aoff + m * 2048 + k * 1024); } while (0)
#define PG8_LDB(dst, b, h) do { _Pragma("unroll") for (int n = 0; n < 2; ++n) _Pragma("unroll") for (int k = 0; k < 2; ++k) dst[n][k] = *(const PG8_LAS bf16x8*)(lds + PG8_SB(b, h) + boff + n * 2048 + k * 1024); } while (0)
#define PG8_MMA(ai, bj, At, Bt) do { __builtin_amdgcn_s_setprio(1); _Pragma("unroll") for (int m = 0; m < 4; ++m) _Pragma("unroll") for (int n = 0; n < 2; ++n) _Pragma("unroll") for (int k = 0; k < 2; ++k) \
        acc[ai][bj][m][n] = __builtin_amdgcn_mfma_f32_16x16x32_bf16(Bt[n][k], At[m][k], acc[ai][bj][m][n], 0, 0, 0); __builtin_amdgcn_s_setprio(0); } while (0)
#define PG8_WAIT_V(n) asm volatile("s_waitcnt vmcnt(" #n ")" ::: "memory")
#define PG8_WAIT_L(n) asm volatile("s_waitcnt lgkmcnt(" #n ")" ::: "memory")
#define PG8_BAR __builtin_amdgcn_s_barrier()
#define PG8_SCHED __builtin_amdgcn_sched_barrier(0)
    Unit cur, nxt; int ui = 0;
    if (!S.next(0, cur)) return;
    f32x4 acc[2][2][4][2];
#pragma unroll
    for (int a = 0; a < 2; ++a)
#pragma unroll
        for (int b = 0; b < 2; ++b)
#pragma unroll
            for (int m = 0; m < 4; ++m)
#pragma unroll
                for (int n = 0; n < 2; ++n) acc[a][b][m][n] = (f32x4){0.f, 0.f, 0.f, 0.f};
    bf16x8 At[4][2], B0[2][2], B1[2][2];
    const char* cA = (const char*)g.A + (size_t)cur.pm * tstep; const char* cB = (const char*)g.Bt + (size_t)cur.pn * tstep;
    S.a_ready(cur);
    if constexpr (SP2) {
        PG8_STAGE(PG8_SB(0, 0), cB, voffB); PG8_STAGE(PG8_SB(0, 1), cB + hstep, voffB); PG8_STAGE(PG8_SA(0, 0), cA, voffA); PG8_STAGE(PG8_SA(0, 1), cA + hstep, voffA);
        if (wr == 1) PG8_BAR;
        PG8_WAIT_V(2); PG8_BAR;
        PG8_STAGE(PG8_SB(1, 0), cB + kstep, voffB); PG8_STAGE(PG8_SA(1, 0), cA + kstep, voffA); PG8_STAGE(PG8_SB(1, 1), cB + hstep + kstep, voffB);
        PG8_WAIT_V(6); PG8_BAR;
    } else {
        PG8_STAGE(PG8_SB(0, 0), cB, voffB); PG8_STAGE(PG8_SA(0, 0), cA, voffA); PG8_STAGE(PG8_SB(0, 1), cB + hstep, voffB); PG8_STAGE(PG8_SA(0, 1), cA + hstep, voffA);
        if (wr == 1) PG8_BAR;
        PG8_WAIT_V(4); PG8_BAR;
        PG8_STAGE(PG8_SB(1, 0), cB + kstep, voffB); PG8_STAGE(PG8_SA(1, 0), cA + kstep, voffA); PG8_STAGE(PG8_SB(1, 1), cB + hstep + kstep, voffB);
        PG8_WAIT_V(6); PG8_BAR;
    }
    for (;;) {
        const bool has_next = S.next(ui + 1, nxt);
        const char* nA = has_next ? (const char*)g.A + (size_t)nxt.pm * tstep : cA; const char* nB = has_next ? (const char*)g.Bt + (size_t)nxt.pn * tstep : cB;
        for (int t = 0; t < nt; t += 2) {
            const bool last = (t == nt - 2);
            const char* a1 = cA + (size_t)(t + 1) * kstep;
            const char* a2 = last ? nA : cA + (size_t)(t + 2) * kstep; const char* b2 = last ? nB : cB + (size_t)(t + 2) * kstep;
            const char* a3 = a2 + kstep; const char* b3 = b2 + kstep;
            if (last && has_next) S.a_ready(nxt);
            if constexpr (SP2) {
            PG8_LDB(B0, 0, 0); PG8_LDB(B1, 0, 1); PG8_SCHED; PG8_LDA(At, 0, 0); PG8_STAGE(PG8_SA(1, 1), a1 + hstep, voffA);
            PG8_WAIT_V(8); PG8_WAIT_L(0); PG8_BAR; PG8_MMA(0, 0, At, B0); PG8_MMA(0, 1, At, B1); PG8_BAR; PG8_SCHED;
            PG8_LDA(At, 0, 1); PG8_STAGE(PG8_SB(0, 0), b2, voffB); PG8_STAGE(PG8_SB(0, 1), b2 + hstep, voffB); PG8_STAGE(PG8_SA(0, 0), a2, voffA);
            PG8_WAIT_V(8); PG8_WAIT_L(0); PG8_BAR; PG8_MMA(1, 0, At, B0); PG8_MMA(1, 1, At, B1); PG8_BAR; PG8_SCHED;
            PG8_LDB(B0, 1, 0); PG8_LDB(B1, 1, 1); PG8_SCHED; PG8_LDA(At, 1, 0); PG8_STAGE(PG8_SA(0, 1), a2 + hstep, voffA);
            PG8_WAIT_V(8); PG8_WAIT_L(0); PG8_BAR; PG8_MMA(0, 0, At, B0); PG8_MMA(0, 1, At, B1); PG8_BAR; PG8_SCHED;
            PG8_LDA(At, 1, 1); PG8_STAGE(PG8_SB(1, 0), b3, voffB); PG8_STAGE(PG8_SB(1, 1), b3 + hstep, voffB); PG8_STAGE(PG8_SA(1, 0), a3, voffA);
            PG8_WAIT_V(8); PG8_WAIT_L(0); PG8_BAR; PG8_MMA(1, 0, At, B0); PG8_MMA(1, 1, At, B1); PG8_BAR; PG8_SCHED;
            } else {
            PG8_LDB(B0, 0, 0); PG8_SCHED; PG8_LDA(At, 0, 0); PG8_STAGE(PG8_SA(1, 1), a1 + hstep, voffA);
            PG8_WAIT_L(8); PG8_BAR; PG8_WAIT_L(0); PG8_MMA(0, 0, At, B0); PG8_BAR; PG8_SCHED;
            PG8_LDB(B1, 0, 1); PG8_STAGE(PG8_SB(0, 0), b2, voffB);
            PG8_BAR; PG8_WAIT_L(0); PG8_MMA(0, 1, At, B1); PG8_BAR;
            PG8_LDA(At, 0, 1); PG8_STAGE(PG8_SA(0, 0), a2, voffA);
            PG8_BAR; PG8_WAIT_L(0); PG8_MMA(1, 0, At, B0); PG8_BAR; PG8_SCHED;
            PG8_STAGE(PG8_SB(0, 1), b2 + hstep, voffB);
            PG8_WAIT_V(6); PG8_BAR; PG8_MMA(1, 1, At, B1); PG8_BAR;
            PG8_LDB(B0, 1, 0); PG8_SCHED; PG8_LDA(At, 1, 0); PG8_STAGE(PG8_SA(0, 1), a2 + hstep, voffA);
            PG8_WAIT_L(8); PG8_BAR; PG8_WAIT_L(0); PG8_MMA(0, 0, At, B0); PG8_BAR; PG8_SCHED;
            PG8_LDB(B1, 1, 1); PG8_STAGE(PG8_SB(1, 0), b3, voffB);
            PG8_BAR; PG8_WAIT_L(0); PG8_MMA(0, 1, At, B1); PG8_BAR;
            PG8_LDA(At, 1, 1); PG8_STAGE(PG8_SA(1, 0), a3, voffA);
            PG8_BAR; PG8_WAIT_L(0); PG8_MMA(1, 0, At, B0); PG8_BAR; PG8_SCHED;
            PG8_STAGE(PG8_SB(1, 1), b3 + hstep, voffB);
            PG8_WAIT_V(6); PG8_BAR; PG8_MMA(1, 1, At, B1); PG8_BAR;
            }
        }
        if constexpr (ALIGN_EPI) { if (wr == 0) PG8_BAR; }
        if constexpr (!Epi::AFTER_DRAIN) { E(acc, cur, wr, wc, fr, fq); S.done(cur); }
        if (!has_next) break;
#pragma unroll
        for (int a = 0; a < 2; ++a)
#pragma unroll
            for (int b = 0; b < 2; ++b)
#pragma unroll
                for (int m = 0; m < 4; ++m)
#pragma unroll
                    for (int n = 0; n < 2; ++n) acc[a][b][m][n] = (f32x4){0.f, 0.f, 0.f, 0.f};
        cur = nxt; cA = nA; cB = nB; ++ui;
        if constexpr (ALIGN_EPI) { if (wr == 1) PG8_BAR; }
    }
    PG8_WAIT_V(0);
    if constexpr (!ALIGN_EPI) { if (wr == 0) PG8_BAR; }
    PG8_BAR;
    if constexpr (Epi::AFTER_DRAIN) { E.fused(acc, cur, wr, wc, fr, fq, lds, wid, lane); S.done(cur); }
#undef PG8_SA
#undef PG8_SB
#undef PG8_STAGE
#undef PG8_LDA
#undef PG8_LDB
#undef PG8_MMA
#undef PG8_WAIT_V
#undef PG8_WAIT_L
#undef PG8_BAR
#undef PG8_SCHED
}
}
#define LAS __attribute__((address_space(3)))
typedef unsigned short bf16;
typedef _Float16 f16;
typedef float f32x4 __attribute__((ext_vector_type(4)));
typedef short bf16x8 __attribute__((ext_vector_type(8)));
typedef short s16x4 __attribute__((ext_vector_type(4)));
typedef unsigned u32x4 __attribute__((ext_vector_type(4)));
typedef unsigned u32x2 __attribute__((ext_vector_type(2)));
typedef _Float16 h2 __attribute__((ext_vector_type(2)));

#ifndef MK_ONE_LAUNCH
#define MK_ONE_LAUNCH 0
#endif

constexpr int NPROMPT = 8 * 4096, NSAMP = 32 * 64, M = NPROMPT + NSAMP;
constexpr int DM = 1024, SHW = 3328, DFF = 2816;
constexpr size_t MiB = 1u << 20;
constexpr size_t U = (size_t)M * 1024 * 2;
constexpr size_t WS_WIN = 1 * MiB;
constexpr size_t WS_WA = WS_WIN + (size_t)7424 * 1024 * 2;
constexpr size_t WS_WB = WS_WA + (size_t)1024 * 1024 * 2;
constexpr size_t WS_WO = WS_WB + (size_t)1024 * 1024 * 2;
constexpr size_t WS_GU = WS_WO + (size_t)1024 * 1024 * 2;
constexpr size_t WS_WD = WS_GU + (size_t)5632 * 1024 * 2;
constexpr size_t WS_LORA = WS_WD + (size_t)1024 * 2816 * 2;
constexpr size_t WS_WSP = WS_LORA + (size_t)3072 * 256 * 2;
constexpr size_t WS_R0 = 40 * MiB;
static_assert(WS_WSP + 8 * 128 * 128 * 2 <= WS_R0, "weights fit below R0");
constexpr size_t WS_XN = WS_R0;
constexpr size_t WS_WL = WS_R0;
constexpr size_t WS_PS = WS_R0 + U;
constexpr size_t WS_AR = WS_R0 + U * 17 / 4;
constexpr size_t WS_G = WS_R0 + U * 21 / 4;
constexpr size_t WS_LX = WS_R0 + U * 25 / 4;
constexpr size_t WS_END = WS_R0 + U * 26 / 4;
constexpr size_t WS_XN2 = WS_R0;
constexpr size_t WS_P4 = WS_R0 + U;
constexpr size_t WS_OA = WS_G;
constexpr size_t WS_OB = WS_R0;
constexpr size_t WS_MM = WS_R0 + U;
constexpr size_t WS_MO = WS_R0 + 2 * U;
constexpr size_t WS_F = WS_R0;
constexpr size_t WS_H = WS_R0 + U;
constexpr size_t WS_F2 = WS_R0 + 4 * U;
constexpr size_t OUT_Y = 0;
constexpr size_t OUT_SHIFT_P = (size_t)M * 1024;
constexpr size_t OUT_WKV_P = OUT_SHIFT_P + 8 * 3328;
constexpr size_t OUT_SHIFT_S = OUT_WKV_P + (size_t)8 * 16 * 4096;
constexpr size_t OUT_WKV_S = OUT_SHIFT_S + 32 * 3328;
constexpr size_t OUT_VS = OUT_WKV_S + (size_t)32 * 16 * 4096;
constexpr size_t OUT_END = OUT_VS + (size_t)32 * 64 * 1024;
static_assert(OUT_END == 40503296, "output size");

constexpr int LDS_BYTES = 147456;
constexpr int NPHASE = 15;

struct Args { const float* in[30]; float* out; unsigned char* ws; int ph_lo, ph_hi; };

__device__ __forceinline__ float bf_lo(unsigned u) { return __uint_as_float(u << 16); }
__device__ __forceinline__ float bf_hi(unsigned u) { return __uint_as_float(u & 0xffff0000u); }
__device__ __forceinline__ f32x4 dec4bf(u32x2 u) { return (f32x4){bf_lo(u.x), bf_hi(u.x), bf_lo(u.y), bf_hi(u.y)}; }
__device__ __forceinline__ unsigned pkbf(float lo, float hi) { return pg8::cvt_pk_bf16(lo, hi); }
__device__ __forceinline__ u32x2 pk4bf(f32x4 v) { u32x2 r; r.x = pkbf(v[0], v[1]); r.y = pkbf(v[2], v[3]); return r; }
__device__ __forceinline__ unsigned pkh(float lo, float hi) { h2 h; h.x = (f16)lo; h.y = (f16)hi; return __builtin_bit_cast(unsigned, h); }
__device__ __forceinline__ u32x2 pk4h(f32x4 v) { u32x2 r; r.x = pkh(v[0], v[1]); r.y = pkh(v[2], v[3]); return r; }
__device__ __forceinline__ h2 as_h2(unsigned u) { return __builtin_bit_cast(h2, u); }
__device__ __forceinline__ f32x4 dec4h(u32x2 u) { const h2 a = as_h2(u.x), b = as_h2(u.y); return (f32x4){(float)a.x, (float)a.y, (float)b.x, (float)b.y}; }
__device__ __forceinline__ float sigm(float x) { return __builtin_amdgcn_rcpf(1.f + __expf(-x)); }
__device__ __forceinline__ float wave_sum(float v) {
#pragma unroll
    for (int o = 1; o < 64; o <<= 1) v += __shfl_xor(v, o);
    return v;
}
template <int CTRL> __device__ __forceinline__ float dppf(float x) { return __int_as_float(__builtin_amdgcn_update_dpp(0, __float_as_int(x), CTRL, 0xF, 0xF, false)); }
__device__ __forceinline__ float row_sum16(float x) { x += dppf<0x128>(x); x += dppf<0x124>(x); x += dppf<0x122>(x); x += dppf<0x121>(x); return x; }
__device__ __forceinline__ float quad_sum(float x) { x += dppf<0xB1>(x); x += dppf<0x4E>(x); return x; }
__device__ __forceinline__ const float* xrow_ptr(const Args& a, int m) { return m < NPROMPT ? a.in[0] + (size_t)m * 1024 : a.in[1] + (size_t)(m - NPROMPT) * 1024; }

template <class F> struct Epi8 {
    static constexpr bool PERM = true, AFTER_DRAIN = false; F f;
    __device__ __forceinline__ void operator()(const f32x4 (&acc)[2][2][4][2], const pg8::Unit& u, int wr, int wc, int fr, int fq) const {
        const int row0 = u.pm * 256 + wr * 64 + fr, col0 = u.pn * 256 + wc * 32 + 8 * fq;
#pragma unroll
        for (int ai = 0; ai < 2; ++ai)
#pragma unroll
            for (int m = 0; m < 4; ++m)
#pragma unroll
                for (int bj = 0; bj < 2; ++bj) f(row0 + ai * 128 + m * 16, col0 + bj * 128, acc[ai][bj][m][0], acc[ai][bj][m][1]);
    }
};
template <class F> struct Epi4 {
    static constexpr bool PERM = false, AFTER_DRAIN = false; F f;
    __device__ __forceinline__ void operator()(const f32x4 (&acc)[2][2][4][2], const pg8::Unit& u, int wr, int wc, int fr, int fq) const {
        const int row0 = u.pm * 256 + wr * 64 + fr, col0 = u.pn * 256 + wc * 32 + 4 * fq;
#pragma unroll
        for (int ai = 0; ai < 2; ++ai)
#pragma unroll
            for (int m = 0; m < 4; ++m)
#pragma unroll
                for (int bj = 0; bj < 2; ++bj)
#pragma unroll
                    for (int n = 0; n < 2; ++n) f(row0 + ai * 128 + m * 16, col0 + bj * 128 + n * 16, acc[ai][bj][m][n]);
    }
};
__device__ __forceinline__ u32x4 pk8bf(f32x4 a, f32x4 b) { u32x4 w; w.x = pkbf(a[0], a[1]); w.y = pkbf(a[2], a[3]); w.z = pkbf(b[0], b[1]); w.w = pkbf(b[2], b[3]); return w; }
__device__ __forceinline__ u32x4 pk8h(f32x4 a, f32x4 b) { u32x4 w; w.x = pkh(a[0], a[1]); w.y = pkh(a[2], a[3]); w.z = pkh(b[0], b[1]); w.w = pkh(b[2], b[3]); return w; }
__device__ __forceinline__ void dec8bf(u32x4 w, f32x4& a, f32x4& b) { a = (f32x4){bf_lo(w.x), bf_hi(w.x), bf_lo(w.y), bf_hi(w.y)}; b = (f32x4){bf_lo(w.z), bf_hi(w.z), bf_lo(w.w), bf_hi(w.w)}; }

struct FStoreBf16 { bf16* O; int ldc;
    __device__ __forceinline__ void operator()(int r, int c, f32x4 v0, f32x4 v1) const { *(u32x4*)(O + (size_t)r * ldc + c) = pk8bf(v0, v1); } };
struct FStoreF32 { float* O; int ldc;
    __device__ __forceinline__ void operator()(int r, int c, f32x4 v) const { *(f32x4*)(O + (size_t)r * ldc + c) = v; } };
struct FLora { f16* WL; f16* AR; f16* G; const float* w0; const float* a0;
    __device__ __forceinline__ void operator()(int r, int c, f32x4 v0, f32x4 v1) const {
        const int t = c >> 10, cc = c & 1023;
        if (t == 0) { const f32x4 b0 = *(const f32x4*)(w0 + cc), b1 = *(const f32x4*)(w0 + cc + 4);
#pragma unroll
            for (int i = 0; i < 4; ++i) { v0[i] = __expf(-0.60653066f * sigm(v0[i] + b0[i])); v1[i] = __expf(-0.60653066f * sigm(v1[i] + b1[i])); }
            *(u32x4*)(WL + (size_t)r * 1024 + cc) = pk8h(v0, v1); }
        else if (t == 1) { const f32x4 b0 = *(const f32x4*)(a0 + cc), b1 = *(const f32x4*)(a0 + cc + 4);
#pragma unroll
            for (int i = 0; i < 4; ++i) { v0[i] = sigm(v0[i] + b0[i]); v1[i] = sigm(v1[i] + b1[i]); }
            *(u32x4*)(AR + (size_t)r * 1024 + cc) = pk8h(v0, v1); }
        else *(u32x4*)(G + (size_t)r * 1024 + cc) = pk8h(v0, v1);
    } };
struct FP1b { bf16* base;
    __device__ __forceinline__ void operator()(int r, int c, f32x4 v0, f32x4 v1) const {
        const int t = c >> 10, cc = c & 1023;
        if (t >= 2) {
#pragma unroll
            for (int i = 0; i < 4; ++i) { v0[i] = sigm(v0[i]); v1[i] = sigm(v1[i]); } }
        *(u32x4*)(base + (size_t)t * (U / 2) + (size_t)r * 1024 + cc) = pk8bf(v0, v1);
    } };
struct FGateA { const bf16* GA; bf16* M1;
    __device__ __forceinline__ void operator()(int r, int c, f32x4 v0, f32x4 v1) const {
        const size_t o = (size_t)r * 1024 + c; f32x4 g0, g1; dec8bf(*(const u32x4*)(GA + o), g0, g1);
        *(u32x4*)(M1 + o) = pk8bf(v0 * g0, v1 * g1);
    } };
struct FGateB { const bf16* GB; bf16* MMp;
    __device__ __forceinline__ void operator()(int r, int c, f32x4 v0, f32x4 v1) const {
        const size_t o = (size_t)r * 1024 + c; f32x4 g0, g1, m0, m1; dec8bf(*(const u32x4*)(GB + o), g0, g1); dec8bf(*(const u32x4*)(MMp + o), m0, m1);
        *(u32x4*)(MMp + o) = pk8bf(m0 + v0 * g0, m1 + v1 * g1);
    } };
struct EpiGU {
    static constexpr bool PERM = true, AFTER_DRAIN = false; bf16* H;
    __device__ __forceinline__ void operator()(const f32x4 (&acc)[2][2][4][2], const pg8::Unit& u, int wr, int wc, int fr, int fq) const {
        const int row0 = u.pm * 256 + wr * 64 + fr, h0 = u.pn * 128 + wc * 32 + 8 * fq;
#pragma unroll
        for (int ai = 0; ai < 2; ++ai)
#pragma unroll
            for (int m = 0; m < 4; ++m) {
                f32x4 o0, o1;
#pragma unroll
                for (int i = 0; i < 4; ++i) { const float g0 = acc[ai][0][m][0][i], g1 = acc[ai][1][m][0][i];
                    o0[i] = g0 * sigm(g0) * acc[ai][0][m][1][i]; o1[i] = g1 * sigm(g1) * acc[ai][1][m][1][i]; }
                *(u32x4*)(H + (size_t)(row0 + ai * 128 + m * 16) * DFF + h0) = pk8bf(o0, o1);
            }
    }
};

#define PH_PROLOG const int tid = threadIdx.x, lane = tid & 63, wave = __builtin_amdgcn_readfirstlane(tid >> 6); const int G = gridDim.x, bid = blockIdx.x; const int gw = bid * 8 + wave, NGW = G * 8; (void)lane; (void)gw; (void)NGW; (void)lds;

__device__ __forceinline__ float conv_src(const Args& a, int mat, int R, int k) {
    switch (mat) {
    case 0: return a.in[5][(size_t)k * 7424 + R];
    case 1: return a.in[21][(size_t)k * 1024 + R];
    case 2: return a.in[22][(size_t)k * 1024 + R];
    case 3: return a.in[23][(size_t)k * 1024 + R];
    case 4: { const int cl = R & 255, pn = R >> 8, bj = (cl >> 7) & 1, wc = (cl >> 5) & 3, fq = (cl >> 3) & 3, n = (cl >> 2) & 1, e = cl & 3;
              const int hcol = 128 * pn + 32 * wc + 8 * fq + 4 * bj + e; return (n ? a.in[27] : a.in[26])[(size_t)k * DFF + hcol]; }
    case 5: return a.in[28][(size_t)k * 1024 + R];
    case 6: { if (R < 1024) return k < 64 ? a.in[8][k * 1024 + R] : 0.f;
              if (R < 2048) return (k >= 64 && k < 128) ? a.in[10][(k - 64) * 1024 + R - 1024] : 0.f;
              return k >= 128 ? a.in[11][(k - 128) * 1024 + R - 2048] : 0.f; }
    default: { const int t = R & 127; return k <= t ? a.in[19][(size_t)R * 128 + k] : 0.f; }
    }
}
__device__ __forceinline__ void rms_row_to_bf16(const float* xrow, const float* gain, bf16* orow, int lane) {
    f32x4 v[4]; float ss = 0.f;
#pragma unroll
    for (int j = 0; j < 4; ++j) { v[j] = ((const f32x4*)xrow)[lane + 64 * j]; ss += (v[j][0] * v[j][0] + v[j][1] * v[j][1]) + (v[j][2] * v[j][2] + v[j][3] * v[j][3]); }
    const float rs = rsqrtf(wave_sum(ss) * (1.f / 1024.f) + 1e-6f);
#pragma unroll
    for (int j = 0; j < 4; ++j) { const f32x4 g = ((const f32x4*)gain)[lane + 64 * j]; ((u32x2*)orow)[lane + 64 * j] = pk4bf(v[j] * rs * g); }
}
__device__ __forceinline__ void phase_p0(const Args& a, LAS unsigned char* lds) {
    PH_PROLOG
    constexpr int NIT[8] = {928 * 16, 128 * 16, 128 * 16, 128 * 16, 704 * 16, 128 * 44, 384 * 4, 128 * 2};
    constexpr int KD[8] = {1024, 1024, 1024, 1024, 1024, 2816, 256, 128};
    constexpr size_t DST[8] = {WS_WIN, WS_WA, WS_WB, WS_WO, WS_GU, WS_WD, WS_LORA, WS_WSP};
    constexpr int NITEMS = NIT[0] + NIT[1] + NIT[2] + NIT[3] + NIT[4] + NIT[5] + NIT[6] + NIT[7];
    for (int it = gw; it < NITEMS; it += NGW) {
        int r = it, mat = 0;
#pragma unroll
        for (int q = 0; q < 7; ++q) { if (mat == q && r >= NIT[q]) { r -= NIT[q]; mat = q + 1; } }
        int Kd = 1024; size_t dst = WS_WIN;
#pragma unroll
        for (int q = 0; q < 8; ++q) if (mat == q) { Kd = KD[q]; dst = DST[q]; }
        const int kbn = Kd >> 6, rb = r / kbn, kb = r - rb * kbn;
        const int R = rb * 8 + (lane >> 3), k0 = kb * 64 + (lane & 7) * 8;
        float s[8];
#pragma unroll
        for (int j = 0; j < 8; ++j) s[j] = conv_src(a, mat, R, k0 + j);
        u32x4 w; w.x = pkbf(s[0], s[1]); w.y = pkbf(s[2], s[3]); w.z = pkbf(s[4], s[5]); w.w = pkbf(s[6], s[7]);
        *(u32x4*)(a.ws + dst + ((size_t)R * Kd + k0) * 2) = w;
    }
    bf16* XN = (bf16*)(a.ws + WS_XN);
    for (int m = gw; m < M; m += NGW) rms_row_to_bf16(xrow_ptr(a, m), a.in[4], XN + (size_t)m * 1024, lane);
}

__device__ __forceinline__ void phase_p2a(const Args& a, LAS unsigned char* lds) {
    PH_PROLOG
    const bf16* PS = (const bf16*)(a.ws + WS_PS); bf16* LX = (bf16*)(a.ws + WS_LX);
    const f32x4 mu = *(const f32x4*)(a.in[6] + 3072 + 4 * lane);
    for (int m = gw; m < M; m += NGW) {
        const bool samp = m >= NPROMPT; const int t = samp ? ((m - NPROMPT) & 63) : (m & 4095);
        const f32x4 p = dec4bf(*(const u32x2*)(PS + (size_t)m * SHW + 3072 + 4 * lane));
        f32x4 pp = (f32x4){0.f, 0.f, 0.f, 0.f};
        if (t > 0) pp = dec4bf(*(const u32x2*)(PS + (size_t)(m - 1) * SHW + 3072 + 4 * lane));
        else if (samp) pp = *(const f32x4*)(a.in[2] + (size_t)((m - NPROMPT) >> 6) * SHW + 3072 + 4 * lane);
        f32x4 x = p + (pp - p) * mu;
        if (lane < 16) {
#pragma unroll
            for (int i = 0; i < 4; ++i) x[i] = 1.f - 2.f * __builtin_amdgcn_rcpf(__expf(2.f * x[i]) + 1.f); }
        else if (lane >= 32) {
#pragma unroll
            for (int i = 0; i < 4; ++i) x[i] = sigm(x[i]); }
        *(u32x2*)(LX + (size_t)m * 256 + 4 * lane) = pk4bf(x);
    }
    if (gw < 40) {
        const int row = gw < 8 ? gw * 4096 + 4095 : NPROMPT + (gw - 8) * 64 + 63;
        float* dst = a.out + (gw < 8 ? OUT_SHIFT_P + (size_t)gw * SHW : OUT_SHIFT_S + (size_t)(gw - 8) * SHW);
        for (int c = lane; c < SHW; c += 64) dst[c] = bf_lo((unsigned)PS[(size_t)row * SHW + c]);
    }
}

constexpr int SC_STEPS = 32, SC_PK = SC_STEPS * 16 * 48, SC_BUF = SC_PK + SC_STEPS * 64 * 4;
struct ScanK { f32x4 mu_r, mu_k, mu_v, kk, ka; };
__device__ __forceinline__ void scan_stage_write(LAS unsigned char* buf, int s_st, int kg_st, const ScanK& K, f32x4 r, f32x4 k, f32x4 v, f32x4 pr, f32x4 pk, f32x4 pv, u32x2 wl, u32x2 ar) {
    const f32x4 xr = r + (pr - r) * K.mu_r, xk = k + (pk - k) * K.mu_k, xv = v + (pv - v) * K.mu_v;
    const f32x4 ar4 = dec4h(ar);
    const f32x4 kkr = xk * K.kk;
    float ssq = (kkr[0] * kkr[0] + kkr[1] * kkr[1]) + (kkr[2] * kkr[2] + kkr[3] * kkr[3]);
    ssq = row_sum16(ssq);
    const float inv = 1.f / fmaxf(sqrtf(ssq), 1e-12f);
    const f32x4 kkn = kkr * inv, bb = kkn * ar4, km = xk * (1.f + (ar4 - 1.f) * K.ka);
    LAS unsigned char* p = buf + (s_st * 16 + kg_st) * 48;
    const u32x2 hk = pk4h(kkn), hb = pk4h(bb), hm = pk4h(km), hr = pk4h(xr);
    *(LAS u32x4*)p = (u32x4){wl.x, wl.y, hk.x, hk.y};
    *(LAS u32x4*)(p + 16) = (u32x4){hb.x, hb.y, hm.x, hm.y};
    *(LAS u32x2*)(p + 32) = hr;
    *(LAS f32x4*)(buf + SC_PK + (s_st * 64 + 4 * kg_st) * 4) = xv;
}
__device__ __forceinline__ void phase_scan(const Args& a, LAS unsigned char* lds) {
    PH_PROLOG
    const bf16* PS = (const bf16*)(a.ws + WS_PS); const f16* WL = (const f16*)(a.ws + WS_WL); const f16* AR = (const f16*)(a.ws + WS_AR);
    float* Y = a.out + OUT_Y;
    const int s_st = tid >> 4, kg_st = tid & 15;
    const int rw = lane >> 4, kg = lane & 15;
    for (int task = bid; task < 1280; task += G) {
        const bool samp = task >= 256; const int q = samp ? task - 256 : task;
        const int b = q >> 5, h = (q >> 1) & 15, half = q & 1;
        const int m0 = samp ? NPROMPT + b * 64 : b * 4096, T = samp ? 64 : 4096, nch = T / SC_STEPS;
        const int v = half * 32 + wave * 4 + rw;
        f32x4 S = (f32x4){0.f, 0.f, 0.f, 0.f};
        if (samp) S = *(const f32x4*)(a.in[3] + ((size_t)((b * 16 + h) * 64 + v)) * 64 + 4 * kg);
        const int c = h * 64 + 4 * kg_st;
        ScanK K; K.mu_r = *(const f32x4*)(a.in[6] + c); K.mu_k = *(const f32x4*)(a.in[6] + 1024 + c); K.mu_v = *(const f32x4*)(a.in[6] + 2048 + c);
        K.kk = *(const f32x4*)(a.in[12] + c); K.ka = *(const f32x4*)(a.in[13] + c);
        {
            const size_t m = (size_t)m0 + s_st; const bf16* base = PS + m * SHW + c;
            const f32x4 r = dec4bf(*(const u32x2*)base), k = dec4bf(*(const u32x2*)(base + 1024)), vv = dec4bf(*(const u32x2*)(base + 2048));
            f32x4 pr, pk, pv;
            if (s_st > 0) { pr = dec4bf(*(const u32x2*)(base - SHW)); pk = dec4bf(*(const u32x2*)(base - SHW + 1024)); pv = dec4bf(*(const u32x2*)(base - SHW + 2048)); }
            else if (samp) { const float* ss = a.in[2] + (size_t)b * SHW + c; pr = *(const f32x4*)ss; pk = *(const f32x4*)(ss + 1024); pv = *(const f32x4*)(ss + 2048); }
            else { pr = (f32x4){0.f, 0.f, 0.f, 0.f}; pk = pr; pv = pr; }
            const u32x2 wl = *(const u32x2*)(WL + m * 1024 + c), ar = *(const u32x2*)(AR + m * 1024 + c);
            scan_stage_write(lds, s_st, kg_st, K, r, k, vv, pr, pk, pv, wl, ar);
        }
        __syncthreads();
        float ykeep = 0.f;
        for (int ch = 0; ch < nch; ++ch) {
            const bool more = ch + 1 < nch;
            u32x2 cr, ck, cv, qr, qk, qv, wl, ar;
            cr = ck = cv = qr = qk = qv = wl = ar = (u32x2){0u, 0u};
            if (more) {
                const size_t m = (size_t)m0 + (ch + 1) * SC_STEPS + s_st; const bf16* base = PS + m * SHW + c;
                cr = *(const u32x2*)base; ck = *(const u32x2*)(base + 1024); cv = *(const u32x2*)(base + 2048);
                qr = *(const u32x2*)(base - SHW); qk = *(const u32x2*)(base - SHW + 1024); qv = *(const u32x2*)(base - SHW + 2048);
                wl = *(const u32x2*)(WL + m * 1024 + c); ar = *(const u32x2*)(AR + m * 1024 + c);
            }
            LAS unsigned char* buf = lds + (ch & 1) * SC_BUF;
            const int t0 = ch * SC_STEPS;
#pragma unroll 16
            for (int s = 0; s < SC_STEPS; ++s) {
                const LAS unsigned char* p = buf + (s * 16 + kg) * 48;
                const u32x4 q0 = *(const LAS u32x4*)p, q1 = *(const LAS u32x4*)(p + 16); const u32x2 q2 = *(const LAS u32x2*)(p + 32);
                const float vval = *(const LAS float*)(buf + SC_PK + (s * 64 + v) * 4);
                const h2 w01 = as_h2(q0.x), w23 = as_h2(q0.y), k01 = as_h2(q0.z), k23 = as_h2(q0.w);
                const h2 b01 = as_h2(q1.x), b23 = as_h2(q1.y), m01 = as_h2(q1.z), m23 = as_h2(q1.w);
                const h2 r01 = as_h2(q2.x), r23 = as_h2(q2.y);
                float sa = S[0] * (float)k01.x; sa = __builtin_fmaf(S[1], (float)k01.y, sa); sa = __builtin_fmaf(S[2], (float)k23.x, sa); sa = __builtin_fmaf(S[3], (float)k23.y, sa);
                sa = -row_sum16(sa);
                S[0] = __builtin_fmaf(S[0], (float)w01.x, __builtin_fmaf(sa, (float)b01.x, vval * (float)m01.x));
                S[1] = __builtin_fmaf(S[1], (float)w01.y, __builtin_fmaf(sa, (float)b01.y, vval * (float)m01.y));
                S[2] = __builtin_fmaf(S[2], (float)w23.x, __builtin_fmaf(sa, (float)b23.x, vval * (float)m23.x));
                S[3] = __builtin_fmaf(S[3], (float)w23.y, __builtin_fmaf(sa, (float)b23.y, vval * (float)m23.y));
                float y = S[0] * (float)r01.x; y = __builtin_fmaf(S[1], (float)r01.y, y); y = __builtin_fmaf(S[2], (float)r23.x, y); y = __builtin_fmaf(S[3], (float)r23.y, y);
                y = row_sum16(y);
                ykeep = ((s & 15) == kg) ? y : ykeep;
                if ((s & 15) == 15) Y[(size_t)(m0 + t0 + s - 15 + kg) * 1024 + h * 64 + v] = ykeep;
            }
            if (more) {
                scan_stage_write(lds + ((ch + 1) & 1) * SC_BUF, s_st, kg_st, K, dec4bf(cr), dec4bf(ck), dec4bf(cv), dec4bf(qr), dec4bf(qk), dec4bf(qv), wl, ar);
            }
            __syncthreads();
        }
        float* So = a.out + (samp ? OUT_WKV_S : OUT_WKV_P) + ((size_t)((b * 16 + h) * 64 + v)) * 64 + 4 * kg;
        *(f32x4*)So = S;
    }
}

__device__ __forceinline__ void ld16bf(const bf16* p, float (&o)[16]) {
    const u32x4 w0 = *(const u32x4*)p, w1 = *(const u32x4*)(p + 8); f32x4 a, b, c, d; dec8bf(w0, a, b); dec8bf(w1, c, d);
#pragma unroll
    for (int i = 0; i < 4; ++i) { o[i] = a[i]; o[4 + i] = b[i]; o[8 + i] = c[i]; o[12 + i] = d[i]; }
}
__device__ __forceinline__ void ld16h(const f16* p, float (&o)[16]) {
    const u32x4 w0 = *(const u32x4*)p, w1 = *(const u32x4*)(p + 8);
    const f32x4 a = dec4h((u32x2){w0.x, w0.y}), b = dec4h((u32x2){w0.z, w0.w}), c = dec4h((u32x2){w1.x, w1.y}), d = dec4h((u32x2){w1.z, w1.w});
#pragma unroll
    for (int i = 0; i < 4; ++i) { o[i] = a[i]; o[4 + i] = b[i]; o[8 + i] = c[i]; o[12 + i] = d[i]; }
}
__device__ __forceinline__ void ld16f(const float* p, float (&o)[16]) {
#pragma unroll
    for (int j = 0; j < 4; ++j) { const f32x4 x = ((const f32x4*)p)[j];
#pragma unroll
        for (int i = 0; i < 4; ++i) o[4 * j + i] = x[i]; }
}
__device__ __forceinline__ void tokshift16(float (&x)[16], const bf16* prevp, bool has_prev, bool samp, const float* ssrc, const float* mu) {
    float tmp[16], cst[16];
    if (has_prev) ld16bf(prevp, tmp);
    else if (samp) ld16f(ssrc, tmp);
    else {
#pragma unroll
        for (int i = 0; i < 16; ++i) tmp[i] = 0.f; }
    ld16f(mu, cst);
#pragma unroll
    for (int i = 0; i < 16; ++i) x[i] = x[i] + (tmp[i] - x[i]) * cst[i];
}
__device__ __forceinline__ void phase_gn(const Args& a, LAS unsigned char* lds) {
    PH_PROLOG
    const bf16* PS = (const bf16*)(a.ws + WS_PS); const f16* AR = (const f16*)(a.ws + WS_AR); f16* Gp = (f16*)(a.ws + WS_G);
    const float* Y = a.out + OUT_Y;
    const int c = 16 * lane;
    for (int m = gw; m < M; m += NGW) {
        const bool samp = m >= NPROMPT; const int t = samp ? ((m - NPROMPT) & 63) : (m & 4095);
        float xr[16], xk[16], xv[16], tmp[16], cst[16];
        const bf16* base = PS + (size_t)m * SHW + c;
        ld16bf(base, xr); ld16bf(base + 1024, xk); ld16bf(base + 2048, xv);
        tokshift16(xr, base - SHW, t > 0, samp, a.in[2] + (size_t)((m - NPROMPT) >> 6) * SHW + c, a.in[6] + c);
        tokshift16(xk, base - SHW + 1024, t > 0, samp, a.in[2] + (size_t)((m - NPROMPT) >> 6) * SHW + 1024 + c, a.in[6] + 1024 + c);
        tokshift16(xv, base - SHW + 2048, t > 0, samp, a.in[2] + (size_t)((m - NPROMPT) >> 6) * SHW + 2048 + c, a.in[6] + 2048 + c);
        ld16h(AR + (size_t)m * 1024 + c, tmp); ld16f(a.in[13] + c, cst);
#pragma unroll
        for (int i = 0; i < 16; ++i) xk[i] = xk[i] * (1.f + (tmp[i] - 1.f) * cst[i]);
        ld16f(a.in[14] + c, cst);
        float rk = 0.f;
#pragma unroll
        for (int i = 0; i < 16; ++i) rk += xr[i] * xk[i] * cst[i];
        rk = quad_sum(rk);
        float y[16]; ld16f(Y + (size_t)m * 1024 + c, y);
        float s = 0.f;
#pragma unroll
        for (int i = 0; i < 16; ++i) s += y[i];
        const float mean = quad_sum(s) * (1.f / 64.f);
        float q2 = 0.f;
#pragma unroll
        for (int i = 0; i < 16; ++i) { y[i] -= mean; q2 += y[i] * y[i]; }
        const float rstd = rsqrtf(quad_sum(q2) * (1.f / 64.f) + 64e-5f);
        ld16f(a.in[15] + c, cst); ld16f(a.in[16] + c, tmp);
#pragma unroll
        for (int i = 0; i < 16; ++i) y[i] = y[i] * rstd * cst[i] + tmp[i] + rk * xv[i];
        ld16h(Gp + (size_t)m * 1024 + c, tmp);
        u32x4 o0, o1;
        o0.x = pkbf(y[0] * tmp[0], y[1] * tmp[1]); o0.y = pkbf(y[2] * tmp[2], y[3] * tmp[3]); o0.z = pkbf(y[4] * tmp[4], y[5] * tmp[5]); o0.w = pkbf(y[6] * tmp[6], y[7] * tmp[7]);
        o1.x = pkbf(y[8] * tmp[8], y[9] * tmp[9]); o1.y = pkbf(y[10] * tmp[10], y[11] * tmp[11]); o1.z = pkbf(y[12] * tmp[12], y[13] * tmp[13]); o1.w = pkbf(y[14] * tmp[14], y[15] * tmp[15]);
        bf16* OA = (bf16*)Gp + (size_t)m * 1024 + c;
        *(u32x4*)OA = o0; *(u32x4*)(OA + 8) = o1;
    }
    bf16* XN2 = (bf16*)(a.ws + WS_XN2);
    for (int m = gw; m < M; m += NGW) rms_row_to_bf16(xrow_ptr(a, m), a.in[4], XN2 + (size_t)m * 1024, lane);
}

__device__ __forceinline__ int gm_swz(int row) { return (row & 3) | (((row >> 3) & 1) << 2); }
__device__ __forceinline__ void phase_gmlp(const Args& a, LAS unsigned char* lds) {
    PH_PROLOG
    const bf16* PU = (const bf16*)(a.ws + WS_P4); const bf16* PV = (const bf16*)(a.ws + WS_P4 + U); bf16* OB = (bf16*)(a.ws + WS_OB);
    const bf16* WSP = (const bf16*)(a.ws + WS_WSP);
    LAS float* stats = (LAS float*)lds;
    LAS unsigned char* img = lds + 4096;
    for (int unit = bid; unit < 272; unit += G) {
        const bool samp = unit >= 256; const int m0 = unit * 128;
        for (int i = 0; i < 16; ++i) {
            const int tk = wave * 16 + i; float x[16]; ld16bf(PV + (size_t)(m0 + tk) * 1024 + 16 * lane, x);
            float s = 0.f;
#pragma unroll
            for (int j = 0; j < 16; ++j) s += x[j];
            const float mean = wave_sum(s) * (1.f / 1024.f); float q2 = 0.f;
#pragma unroll
            for (int j = 0; j < 16; ++j) { x[j] -= mean; q2 += x[j] * x[j]; }
            const float rstd = rsqrtf(wave_sum(q2) * (1.f / 1024.f) + 1e-5f);
            if (lane == 0) { stats[2 * tk] = mean; stats[2 * tk + 1] = rstd; }
            if (samp) {
                float g[16], bb[16]; ld16f(a.in[17] + 16 * lane, g); ld16f(a.in[18] + 16 * lane, bb);
                float* o = a.out + OUT_VS + (size_t)(m0 + tk - NPROMPT) * 1024 + 16 * lane;
#pragma unroll
                for (int j = 0; j < 4; ++j) ((f32x4*)o)[j] = (f32x4){x[4 * j] * rstd * g[4 * j] + bb[4 * j], x[4 * j + 1] * rstd * g[4 * j + 1] + bb[4 * j + 1], x[4 * j + 2] * rstd * g[4 * j + 2] + bb[4 * j + 2], x[4 * j + 3] * rstd * g[4 * j + 3] + bb[4 * j + 3]};
            }
        }
        __syncthreads();
        const int trow_off = (samp && wave >= 4) ? 64 : 0, t0 = wave * 16;
        const int ks_lo = trow_off >> 5, ks_hi = (t0 + 15) >> 5;
        for (int g = 0; g < 8; ++g) {
#pragma unroll
            for (int i = 0; i < 4; ++i) {
                const int p = tid + 512 * i, row = p >> 4, c8 = p & 15, gc = g * 128 + 8 * c8;
                f32x4 x0, x1; dec8bf(*(const u32x4*)(PV + (size_t)(m0 + row) * 1024 + gc), x0, x1);
                const float mean = stats[2 * row], rstd = stats[2 * row + 1];
                const f32x4 g0 = *(const f32x4*)(a.in[17] + gc), g1 = *(const f32x4*)(a.in[17] + gc + 4), b0 = *(const f32x4*)(a.in[18] + gc), b1 = *(const f32x4*)(a.in[18] + gc + 4);
                x0 = (x0 - mean) * rstd * g0 + b0; x1 = (x1 - mean) * rstd * g1 + b1;
                *(LAS u32x4*)(img + row * 256 + (((c8 >> 1) ^ gm_swz(row)) << 5) + (c8 & 1) * 16) = pk8bf(x0, x1);
            }
            __syncthreads();
            f32x4 acc[8];
#pragma unroll
            for (int ct = 0; ct < 8; ++ct) acc[ct] = (f32x4){0.f, 0.f, 0.f, 0.f};
            for (int ks = ks_lo; ks <= ks_hi; ++ks) {
                const bf16x8 wf = *(const bf16x8*)(WSP + ((size_t)(g * 128 + t0 - trow_off + (lane & 15))) * 128 + 32 * ks - trow_off + 8 * (lane >> 4));
                const int row = 32 * ks + 8 * (lane >> 4) + ((lane & 15) >> 2);
                const int sw = gm_swz(row);
#pragma unroll
                for (int ct = 0; ct < 8; ++ct) {
                    LAS unsigned char* p = img + row * 256 + ((ct ^ sw) << 5) + (lane & 3) * 8;
                    const s16x4 lo = __builtin_amdgcn_ds_read_tr16_b64_v4i16((LAS s16x4*)p), hi = __builtin_amdgcn_ds_read_tr16_b64_v4i16((LAS s16x4*)(p + 1024));
                    bf16x8 vf; vf[0] = lo[0]; vf[1] = lo[1]; vf[2] = lo[2]; vf[3] = lo[3]; vf[4] = hi[0]; vf[5] = hi[1]; vf[6] = hi[2]; vf[7] = hi[3];
                    acc[ct] = __builtin_amdgcn_mfma_f32_16x16x32_bf16(vf, wf, acc[ct], 0, 0, 0);
                }
            }
            const int t = t0 + (lane & 15);
            const float bias = a.in[20][g * 128 + t - trow_off];
#pragma unroll
            for (int ct = 0; ct < 8; ++ct) {
                const size_t o = (size_t)(m0 + t) * 1024 + g * 128 + 16 * ct + 4 * (lane >> 4);
                const f32x4 pu = dec4bf(*(const u32x2*)(PU + o));
                *(u32x2*)(OB + o) = pk4bf(pu * (acc[ct] + bias));
            }
            __syncthreads();
        }
    }
}

__device__ __forceinline__ void phase_p5b(const Args& a, LAS unsigned char* lds) {
    PH_PROLOG
    const float* MO = (const float*)(a.ws + WS_MO); bf16* F = (bf16*)(a.ws + WS_F);
    for (int m = gw; m < M; m += NGW) {
        const float* xr = xrow_ptr(a, m); f32x4 v[4]; float ss = 0.f;
#pragma unroll
        for (int j = 0; j < 4; ++j) { v[j] = ((const f32x4*)(MO + (size_t)m * 1024))[lane + 64 * j]; ss += (v[j][0] * v[j][0] + v[j][1] * v[j][1]) + (v[j][2] * v[j][2] + v[j][3] * v[j][3]); }
        const float rs = rsqrtf(wave_sum(ss) * (1.f / 1024.f) + 1e-6f); float s2 = 0.f;
#pragma unroll
        for (int j = 0; j < 4; ++j) { const f32x4 g = ((const f32x4*)a.in[24])[lane + 64 * j], x = ((const f32x4*)xr)[lane + 64 * j];
            v[j] = x + v[j] * rs * g; ((f32x4*)(a.out + OUT_Y + (size_t)m * 1024))[lane + 64 * j] = v[j];
            s2 += (v[j][0] * v[j][0] + v[j][1] * v[j][1]) + (v[j][2] * v[j][2] + v[j][3] * v[j][3]); }
        const float rs2 = rsqrtf(wave_sum(s2) * (1.f / 1024.f) + 1e-6f);
#pragma unroll
        for (int j = 0; j < 4; ++j) { const f32x4 g = ((const f32x4*)a.in[25])[lane + 64 * j]; ((u32x2*)(F + (size_t)m * 1024))[lane + 64 * j] = pk4bf(v[j] * rs2 * g); }
    }
}
__device__ __forceinline__ void phase_p7b(const Args& a, LAS unsigned char* lds) {
    PH_PROLOG
    const float* F2 = (const float*)(a.ws + WS_F2);
    for (int m = gw; m < M; m += NGW) {
        f32x4 v[4]; float ss = 0.f;
#pragma unroll
        for (int j = 0; j < 4; ++j) { v[j] = ((const f32x4*)(F2 + (size_t)m * 1024))[lane + 64 * j]; ss += (v[j][0] * v[j][0] + v[j][1] * v[j][1]) + (v[j][2] * v[j][2] + v[j][3] * v[j][3]); }
        const float rs = rsqrtf(wave_sum(ss) * (1.f / 1024.f) + 1e-6f);
        f32x4* o = (f32x4*)(a.out + OUT_Y + (size_t)m * 1024);
#pragma unroll
        for (int j = 0; j < 4; ++j) { const f32x4 g = ((const f32x4*)a.in[29])[lane + 64 * j]; o[lane + 64 * j] = o[lane + 64 * j] + v[j] * rs * g; }
    }
}

template <class E> __device__ __forceinline__ void run_gemm(LAS unsigned char* lds, const bf16* A, const bf16* Bt, int N, int K, const E& e) {
    pg8::Gemm g{A, Bt, M, N, K}; pg8::StaticOrder S; S.init(M, N, (int)gridDim.x, (int)blockIdx.x);
    pg8::gemm_phase<E, pg8::StaticOrder, true, true>(lds, g, S, e);
}
__global__ void __launch_bounds__(512, 2) mk_fwd(Args a) {
    extern __shared__ __attribute__((aligned(16))) unsigned char lds_raw[];
    LAS unsigned char* lds = (LAS unsigned char*)lds_raw;
    unsigned char* ws = a.ws;
    const int lo = a.ph_lo, hi = a.ph_hi;
#define IN(k) (lo <= (k) && (k) < hi)
#define SEAM(k) do { if (IN(k) && IN((k) + 1)) { cg::this_grid().sync(); } } while (0)
    if (IN(0)) { phase_p0(a, lds); } SEAM(0);
    if (IN(1)) { Epi8<FStoreBf16> e{{(bf16*)(ws + WS_PS), SHW}}; run_gemm(lds, (const bf16*)(ws + WS_XN), (const bf16*)(ws + WS_WIN), SHW, 1024, e); } SEAM(1);
    if (IN(2)) { phase_p2a(a, lds); } SEAM(2);
    if (IN(3)) { Epi8<FLora> e{{(f16*)(ws + WS_WL), (f16*)(ws + WS_AR), (f16*)(ws + WS_G), a.in[7], a.in[9]}}; run_gemm(lds, (const bf16*)(ws + WS_LX), (const bf16*)(ws + WS_LORA), 3072, 256, e); } SEAM(3);
    if (IN(4)) { phase_scan(a, lds); } SEAM(4);
    if (IN(5)) { phase_gn(a, lds); } SEAM(5);
    if (IN(6)) { Epi8<FP1b> e{{(bf16*)(ws + WS_P4)}}; run_gemm(lds, (const bf16*)(ws + WS_XN2), (const bf16*)(ws + WS_WIN) + (size_t)SHW * 1024, 4096, 1024, e); } SEAM(6);
    if (IN(7)) { phase_gmlp(a, lds); } SEAM(7);
    if (IN(8)) { Epi8<FGateA> e{{(const bf16*)(ws + WS_P4 + 2 * U), (bf16*)(ws + WS_MM)}}; run_gemm(lds, (const bf16*)(ws + WS_OA), (const bf16*)(ws + WS_WA), 1024, 1024, e); } SEAM(8);
    if (IN(9)) { Epi8<FGateB> e{{(const bf16*)(ws + WS_P4 + 3 * U), (bf16*)(ws + WS_MM)}}; run_gemm(lds, (const bf16*)(ws + WS_OB), (const bf16*)(ws + WS_WB), 1024, 1024, e); } SEAM(9);
    if (IN(10)) { Epi4<FStoreF32> e{{(float*)(ws + WS_MO), 1024}}; run_gemm(lds, (const bf16*)(ws + WS_MM), (const bf16*)(ws + WS_WO), 1024, 1024, e); } SEAM(10);
    if (IN(11)) { phase_p5b(a, lds); } SEAM(11);
    if (IN(12)) { EpiGU e{(bf16*)(ws + WS_H)}; run_gemm(lds, (const bf16*)(ws + WS_F), (const bf16*)(ws + WS_GU), 2 * DFF, 1024, e); } SEAM(12);
    if (IN(13)) { Epi4<FStoreF32> e{{(float*)(ws + WS_F2), 1024}}; run_gemm(lds, (const bf16*)(ws + WS_H), (const bf16*)(ws + WS_WD), 1024, DFF, e); } SEAM(13);
    if (IN(14)) { phase_p7b(a, lds); }
#undef IN
#undef SEAM
}


#ifndef MK_DBG
#define MK_DBG 0
#endif
__global__ void dbg_zero(float* p, size_t n) { for (size_t i = (size_t)blockIdx.x * blockDim.x + threadIdx.x; i < n; i += (size_t)gridDim.x * blockDim.x) p[i] = 0.f; }
extern "C" void kernel_launch(void* const* d_in, const int* in_sizes, int n_in, void* d_out, int out_size, void* d_ws, size_t ws_size, hipStream_t stream) {
    static int grid = 0;
    if (grid == 0) {
        if (n_in != 30 || (size_t)out_size != OUT_END || ws_size < WS_END) { fprintf(stderr, "kernel_launch: unexpected shapes (n_in %d out %d ws %zu, need ws >= %zu)\n", n_in, out_size, ws_size, (size_t)WS_END); }
        int dev = 0, cus = 0, per_cu = 0;
        (void)hipGetDevice(&dev); (void)hipDeviceGetAttribute(&cus, hipDeviceAttributeMultiprocessorCount, dev);
        (void)hipFuncSetAttribute((const void*)mk_fwd, hipFuncAttributeMaxDynamicSharedMemorySize, LDS_BYTES);
        (void)hipOccupancyMaxActiveBlocksPerMultiprocessor(&per_cu, (const void*)mk_fwd, 512, LDS_BYTES);
        if (per_cu < 1) { fprintf(stderr, "kernel_launch: occupancy query says %d blocks per CU\n", per_cu); per_cu = 1; }
        grid = cus > 0 ? cus : 256;
        (void)hipGetLastError();
    }
    Args a{};
    for (int i = 0; i < 30; ++i) a.in[i] = (const float*)d_in[i];
    a.out = (float*)d_out; a.ws = (unsigned char*)d_ws;
#if MK_ONE_LAUNCH
    a.ph_lo = 0; a.ph_hi = NPHASE;
    void* args[] = {&a};
    hipError_t e = hipLaunchCooperativeKernel((const void*)mk_fwd, dim3(grid), dim3(512), args, LDS_BYTES, stream);
    if (e != hipSuccess) fprintf(stderr, "cooperative launch failed: %s (grid %d)\n", hipGetErrorString(e), grid);
#else
    const int nph = MK_DBG == 1 ? 5 : (MK_DBG == 2 ? 3 : (MK_DBG == 3 ? 8 : NPHASE));
    for (int p = 0; p < nph; ++p) { a.ph_lo = p; a.ph_hi = p + 1; hipLaunchKernelGGL(mk_fwd, dim3(grid), dim3(512), LDS_BYTES, stream, a); }
    float* o = (float*)d_out;
    if (MK_DBG >= 1) hipLaunchKernelGGL(dbg_zero, dim3(1024), dim3(256), 0, stream, o + OUT_Y, (size_t)M * 1024);
    if (MK_DBG == 1 || MK_DBG == 2) hipLaunchKernelGGL(dbg_zero, dim3(1024), dim3(256), 0, stream, o + OUT_VS, (size_t)32 * 64 * 1024);
    if (MK_DBG == 2) { hipLaunchKernelGGL(dbg_zero, dim3(1024), dim3(256), 0, stream, o + OUT_WKV_P, (size_t)8 * 16 * 4096); hipLaunchKernelGGL(dbg_zero, dim3(1024), dim3(256), 0, stream, o + OUT_WKV_S, (size_t)32 * 16 * 4096); }
#endif
}
```

```cpp
#include <hip/hip_runtime.h>
#include <hip/hip_cooperative_groups.h>
#include <cstdio>
#include <cstdint>
namespace cg = cooperative_groups;
namespace pg8 {
#define PG8_LAS __attribute__((address_space(3)))
typedef unsigned short bf16_t;
typedef short bf16x8 __attribute__((ext_vector_type(8)));
typedef float f32x4 __attribute__((ext_vector_type(4)));
typedef unsigned u32x4 __attribute__((ext_vector_type(4)));
constexpr int BM = 256, BK = 64, HALF = 128, HTB = HALF * BK * 2  , STAGE_BYTES = 8 * HTB, NXCD = 8, WGM = 8;

__host__ __device__ __forceinline__ int lds_byte(int r, int c) { const int st = (r >> 4) * 2 + (c >> 5), rr = r & 15, cc = c & 31, ob = rr * 64 + cc * 2; return st * 1024 + (ob ^ (((ob >> 9) & 1) << 5)); }
__host__ __device__ __forceinline__ void stage_rc(int b, int& R, int& C) { const int st = b / 1024, sb = b % 1024, swz = sb ^ (((sb >> 9) & 1) << 5); R = (st >> 1) * 16 + swz / 64; C = (st & 1) * 32 + (swz % 64) / 2; }
__host__ __device__ __forceinline__ int perm32(int rho) { const int n = rho >> 4, i = rho & 15; return 8 * (i >> 2) + 4 * n + (i & 3); }

struct Unit { int pm, pn; };
struct Gemm { const bf16_t* A; const bf16_t* Bt; int M, N, K; };

struct StaticOrder {
    int nM, nN, nwg, G, c;
    __host__ __device__ void init(int M, int N, int G_, int c_) { nM = M / BM; nN = N / BM; nwg = nM * nN; G = G_; c = c_; }
    __host__ __device__ bool next(int i, Unit& u) const {
        const long L = (long)i * G + c; if (L >= nwg) return false;
        int wgid = (int)L; { const int q = nwg / NXCD, r = nwg % NXCD, xcd = wgid % NXCD, off = wgid / NXCD; wgid = (xcd < r ? xcd * (q + 1) : r * (q + 1) + (xcd - r) * q) + off; }
        const int nig = WGM * nN, gid = wgid / nig, fm = gid * WGM, gsz = (nM - fm) < WGM ? (nM - fm) : WGM;
        u.pm = fm + ((wgid % nig) % gsz); u.pn = (wgid % nig) / gsz; return true;
    }
    __device__ __forceinline__ void a_ready(const Unit&) const {}
    __device__ __forceinline__ void done(const Unit&) const {}
};

__device__ __forceinline__ unsigned cvt_pk_bf16(float lo, float hi) { unsigned r; asm volatile("v_cvt_pk_bf16_f32 %0, %1, %2" : "=v"(r) : "v"(lo), "v"(hi)); return r; }
typedef float f32x2 __attribute__((ext_vector_type(2)));
template <class Epi, class Sched, bool ALIGN_EPI = false, bool SP2 = false>
__device__ __forceinline__ void gemm_phase(PG8_LAS unsigned char* lds, const Gemm g, const Sched& S, const Epi& E) {
    const int tid = threadIdx.x, wid = __builtin_amdgcn_readfirstlane(tid >> 6), lane = tid & 63, wr = wid >> 2, wc = wid & 3, fr = lane & 15, fq = lane >> 4;
    const int K = g.K, nt = K / BK;
    unsigned voffA[2], voffB[2];
#pragma unroll
    for (int i = 0; i < 2; ++i) { int R, C; stage_rc(tid * 16 + i * 8192, R, C); const int Rb = Epi::PERM ? ((R & ~31) + perm32(R & 31)) : R;
        voffA[i] = (unsigned)(R * K + C) * 2u; voffB[i] = (unsigned)(Rb * K + C) * 2u; }
    const size_t kstep = (size_t)(BK * 2);
    const size_t hstep = (size_t)HALF * K * 2;
    const size_t tstep = 2 * hstep;
    const unsigned ldsw = (unsigned)wid * 1024u;
    const int aoff = lds_byte(wr * 64 + fr, fq * 8), boff = lds_byte(wc * 32 + fr, fq * 8);
#define PG8_SA(b, h) (((b) * 2 + (h)) * HTB)
#define PG8_SB(b, h) ((4 + (b) * 2 + (h)) * HTB)
#define PG8_STAGE(bufoff, gbase, voff) do { _Pragma("unroll") for (int _i = 0; _i < 2; ++_i) \
        __builtin_amdgcn_global_load_lds((const unsigned*)((const char*)(gbase) + (voff)[_i]), (PG8_LAS unsigned*)(lds + (bufoff) + ldsw + _i * 8192), 16, 0, 0); } while (0)
#define PG8_LDA(dst, b, h) do { _Pragma("unroll") for (int m = 0; m < 4; ++m) _Pragma("unroll") for (int k = 0; k < 2; ++k) dst[m][k] = *(const PG8_LAS bf16x8*)(lds + PG8_SA(b, h) + aoff + m * 2048 + k * 1024); } while (0)
#define PG8_LDB(dst, b, h) do { _Pragma("unroll") for (int n = 0; n < 2; ++n) _Pragma("unroll") for (int k = 0; k < 2; ++k) dst[n][k] = *(const PG8_LAS bf16x8*)(lds + PG8_SB(b, h) + boff + n * 2048 + k * 1024); } while (0)
#define PG8_MMA(ai, bj, At, Bt) do { __builtin_amdgcn_s_setprio(1); _Pragma("unroll") for (int m = 0; m < 4; ++m) _Pragma("unroll") for (int n = 0; n < 2; ++n) _Pragma("unroll") for (int k = 0; k < 2; ++k) \
        acc[ai][bj][m][n] = __builtin_amdgcn_mfma_f32_16x16x32_bf16(Bt[n][k], At[m][k], acc[ai][bj][m][n], 0, 0, 0); __builtin_amdgcn_s_setprio(0); } while (0)
#define PG8_WAIT_V(n) asm volatile("s_waitcnt vmcnt(" #n ")" ::: "memory")
#define PG8_WAIT_L(n) asm volatile("s_waitcnt lgkmcnt(" #n ")" ::: "memory")
#define PG8_BAR __builtin_amdgcn_s_barrier()
#define PG8_SCHED __builtin_amdgcn_sched_barrier(0)
    Unit cur, nxt; int ui = 0;
    if (!S.next(0, cur)) return;
    f32x4 acc[2][2][4][2];
#pragma unroll
    for (int a = 0; a < 2; ++a)
#pragma unroll
        for (int b = 0; b < 2; ++b)
#pragma unroll
            for (int m = 0; m < 4; ++m)
#pragma unroll
                for (int n = 0; n < 2; ++n) acc[a][b][m][n] = (f32x4){0.f, 0.f, 0.f, 0.f};
    bf16x8 At[4][2], B0[2][2], B1[2][2];
    const char* cA = (const char*)g.A + (size_t)cur.pm * tstep; const char* cB = (const char*)g.Bt + (size_t)cur.pn * tstep;
    S.a_ready(cur);
    if constexpr (SP2) {
        PG8_STAGE(PG8_SB(0, 0), cB, voffB); PG8_STAGE(PG8_SB(0, 1), cB + hstep, voffB); PG8_STAGE(PG8_SA(0, 0), cA, voffA); PG8_STAGE(PG8_SA(0, 1), cA + hstep, voffA);
        if (wr == 1) PG8_BAR;
        PG8_WAIT_V(2); PG8_BAR;
        PG8_STAGE(PG8_SB(1, 0), cB + kstep, voffB); PG8_STAGE(PG8_SA(1, 0), cA + kstep, voffA); PG8_STAGE(PG8_SB(1, 1), cB + hstep + kstep, voffB);
        PG8_WAIT_V(6); PG8_BAR;
    } else {
        PG8_STAGE(PG8_SB(0, 0), cB, voffB); PG8_STAGE(PG8_SA(0, 0), cA, voffA); PG8_STAGE(PG8_SB(0, 1), cB + hstep, voffB); PG8_STAGE(PG8_SA(0, 1), cA + hstep, voffA);
        if (wr == 1) PG8_BAR;
        PG8_WAIT_V(4); PG8_BAR;
        PG8_STAGE(PG8_SB(1, 0), cB + kstep, voffB); PG8_STAGE(PG8_SA(1, 0), cA + kstep, voffA); PG8_STAGE(PG8_SB(1, 1), cB + hstep + kstep, voffB);
        PG8_WAIT_V(6); PG8_BAR;
    }
    for (;;) {
        const bool has_next = S.next(ui + 1, nxt);
        const char* nA = has_next ? (const char*)g.A + (size_t)nxt.pm * tstep : cA; const char* nB = has_next ? (const char*)g.Bt + (size_t)nxt.pn * tstep : cB;
        for (int t = 0; t < nt; t += 2) {
            const bool last = (t == nt - 2);
            const char* a1 = cA + (size_t)(t + 1) * kstep;
            const char* a2 = last ? nA : cA + (size_t)(t + 2) * kstep; const char* b2 = last ? nB : cB + (size_t)(t + 2) * kstep;
            const char* a3 = a2 + kstep; const char* b3 = b2 + kstep;
            if (last && has_next) S.a_ready(nxt);
            if constexpr (SP2) {
            PG8_LDB(B0, 0, 0); PG8_LDB(B1, 0, 1); PG8_SCHED; PG8_LDA(At, 0, 0); PG8_STAGE(PG8_SA(1, 1), a1 + hstep, voffA);
            PG8_WAIT_V(8); PG8_WAIT_L(0); PG8_BAR; PG8_MMA(0, 0, At, B0); PG8_MMA(0, 1, At, B1); PG8_BAR; PG8_SCHED;
            PG8_LDA(At, 0, 1); PG8_STAGE(PG8_SB(0, 0), b2, voffB); PG8_STAGE(PG8_SB(0, 1), b2 + hstep, voffB); PG8_STAGE(PG8_SA(0, 0), a2, voffA);
            PG8_WAIT_V(8); PG8_WAIT_L(0); PG8_BAR; PG8_MMA(1, 0, At, B0); PG8_MMA(1, 1, At, B1); PG8_BAR; PG8_SCHED;
            PG8_LDB(B0, 1, 0); PG8_LDB(B1, 1, 1); PG8_SCHED; PG8_LDA(At, 1, 0); PG8_STAGE(PG8_SA(0, 1), a2 + hstep, voffA);
            PG8_WAIT_V(8); PG8_WAIT_L(0); PG8_BAR; PG8_MMA(0, 0, At, B0); PG8_MMA(0, 1, At, B1); PG8_BAR; PG8_SCHED;
            PG8_LDA(At, 1, 1); PG8_STAGE(PG8_SB(1, 0), b3, voffB); PG8_STAGE(PG8_SB(1, 1), b3 + hstep, voffB); PG8_STAGE(PG8_SA(1, 0), a3, voffA);
            PG8_WAIT_V(8); PG8_WAIT_L(0); PG8_BAR; PG8_MMA(1, 0, At, B0); PG8_MMA(1, 1, At, B1); PG8_BAR; PG8_SCHED;
            } else {
            PG8_LDB(B0, 0, 0); PG8_SCHED; PG8_LDA(At, 0, 0); PG8_STAGE(PG8_SA(1, 1), a1 + hstep, voffA);
            PG8_WAIT_L(8); PG8_BAR; PG8_WAIT_L(0); PG8_MMA(0, 0, At, B0); PG8_BAR; PG8_SCHED;
            PG8_LDB(B1, 0, 1); PG8_STAGE(PG8_SB(0, 0), b2, voffB);
            PG8_BAR; PG8_WAIT_L(0); PG8_MMA(0, 1, At, B1); PG8_BAR;
            PG8_LDA(At, 0, 1); PG8_STAGE(PG8_SA(0, 0), a2, voffA);
            PG8_BAR; PG8_WAIT_L(0); PG8_MMA(1, 0, At, B0); PG8_BAR; PG8_SCHED;
            PG8_STAGE(PG8_SB(0, 1), b2 + hstep, voffB);
            PG8_WAIT_V(6); PG8_BAR; PG8_MMA(1, 1, At, B1); PG8_BAR;
            PG8_LDB(B0, 1, 0); PG8_SCHED; PG8_LDA(At, 1, 0); PG8_STAGE(PG8_SA(0, 1), a2 + hstep, voffA);
            PG8_WAIT_L(8); PG8_BAR; PG8_WAIT_L(0); PG8_MMA(0, 0, At, B0); PG8_BAR; PG8_SCHED;
            PG8_LDB(B1, 1, 1); PG8_STAGE(PG8_SB(1, 0), b3, voffB);
            PG8_BAR; PG8_WAIT_L(0); PG8_MMA(0, 1, At, B1); PG8_BAR;
            PG8_LDA(At, 1, 1); PG8_STAGE(PG8_SA(1, 0), a3, voffA);
            PG8_BAR; PG8_WAIT_L(0); PG8_MMA(1, 0, At, B0); PG8_BAR; PG8_SCHED;
            PG8_STAGE(PG8_SB(1, 1), b3 + hstep, voffB);
            PG8_WAIT_V(6); PG8_BAR; PG8_MMA(1, 1, At, B1); PG8_BAR;
            }
        }
        if constexpr (ALIGN_EPI) { if (wr == 0) PG8_BAR; }
        if constexpr (!Epi::AFTER_DRAIN) { E(acc, cur, wr, wc, fr, fq); S.done(cur); }
        if (!has_next) break;
#pragma unroll
        for (int a = 0; a < 2; ++a)
#pragma unroll
            for (int b = 0; b < 2; ++b)
#pragma unroll
                for (int m = 0; m < 4; ++m)
#pragma unroll
                    for (int n = 0; n < 2; ++n) acc[a][b][m][n] = (f32x4){0.f, 0.f, 0.f, 0.f};
        cur = nxt; cA = nA; cB = nB; ++ui;
        if constexpr (ALIGN_EPI) { if (wr == 1) PG8_BAR; }
    }
    PG8_WAIT_V(0);
    if constexpr (!ALIGN_EPI) { if (wr == 0) PG8_BAR; }
    PG8_BAR;
    if constexpr (Epi::AFTER_DRAIN) { E.fused(acc, cur, wr, wc, fr, fq, lds, wid, lane); S.done(cur); }
#undef PG8_SA
#undef PG8_SB
#undef PG8_STAGE
#undef PG8_LDA
#undef PG8_LDB
#undef PG8_MMA
#undef PG8_WAIT_V
#undef PG8_WAIT_L
#undef PG8_BAR
#undef PG8_SCHED
}
}
#define LAS __attribute__((address_space(3)))
typedef unsigned short bf16;
typedef _Float16 f16;
typedef float f32x4 __attribute__((ext_vector_type(4)));
typedef short bf16x8 __attribute__((ext_vector_type(8)));
typedef short s16x4 __attribute__((ext_vector_type(4)));
typedef unsigned u32x4 __attribute__((ext_vector_type(4)));
typedef unsigned u32x2 __attribute__((ext_vector_type(2)));
typedef _Float16 h2 __attribute__((ext_vector_type(2)));

#ifndef MK_ONE_LAUNCH
#define MK_ONE_LAUNCH 1
#endif

constexpr int NPROMPT = 8 * 4096, NSAMP = 32 * 64, M = NPROMPT + NSAMP;
constexpr int DM = 1024, SHW = 3328, DFF = 2816;
constexpr size_t MiB = 1u << 20;
constexpr size_t U = (size_t)M * 1024 * 2;
constexpr size_t WS_WIN = 1 * MiB;
constexpr size_t WS_WA = WS_WIN + (size_t)7424 * 1024 * 2;
constexpr size_t WS_WB = WS_WA + (size_t)1024 * 1024 * 2;
constexpr size_t WS_WO = WS_WB + (size_t)1024 * 1024 * 2;
constexpr size_t WS_GU = WS_WO + (size_t)1024 * 1024 * 2;
constexpr size_t WS_WD = WS_GU + (size_t)5632 * 1024 * 2;
constexpr size_t WS_LORA = WS_WD + (size_t)1024 * 2816 * 2;
constexpr size_t WS_WSP = WS_LORA + (size_t)3072 * 256 * 2;
constexpr size_t WS_R0 = 40 * MiB;
static_assert(WS_WSP + 8 * 128 * 128 * 2 <= WS_R0, "weights fit below R0");
constexpr size_t WS_XN = WS_R0;
constexpr size_t WS_WL = WS_R0;
constexpr size_t WS_PS = WS_R0 + U;
constexpr size_t WS_AR = WS_R0 + U * 17 / 4;
constexpr size_t WS_G = WS_R0 + U * 21 / 4;
constexpr size_t WS_LX = WS_R0 + U * 25 / 4;
constexpr size_t WS_END = WS_R0 + U * 26 / 4;
constexpr size_t WS_XN2 = WS_R0;
constexpr size_t WS_P4 = WS_R0 + U;
constexpr size_t WS_OA = WS_G;
constexpr size_t WS_OB = WS_R0;
constexpr size_t WS_MM = WS_R0 + U;
constexpr size_t WS_MO = WS_R0 + 2 * U;
constexpr size_t WS_F = WS_R0;
constexpr size_t WS_H = WS_R0 + U;
constexpr size_t WS_F2 = WS_R0 + 4 * U;
constexpr size_t OUT_Y = 0;
constexpr size_t OUT_SHIFT_P = (size_t)M * 1024;
constexpr size_t OUT_WKV_P = OUT_SHIFT_P + 8 * 3328;
constexpr size_t OUT_SHIFT_S = OUT_WKV_P + (size_t)8 * 16 * 4096;
constexpr size_t OUT_WKV_S = OUT_SHIFT_S + 32 * 3328;
constexpr size_t OUT_VS = OUT_WKV_S + (size_t)32 * 16 * 4096;
constexpr size_t OUT_END = OUT_VS + (size_t)32 * 64 * 1024;
static_assert(OUT_END == 40503296, "output size");

constexpr int LDS_BYTES = 147456;
constexpr int NPHASE = 15;

struct Args { const float* in[30]; float* out; unsigned char* ws; int ph_lo, ph_hi; };

__device__ __forceinline__ float bf_lo(unsigned u) { return __uint_as_float(u << 16); }
__device__ __forceinline__ float bf_hi(unsigned u) { return __uint_as_float(u & 0xffff0000u); }
__device__ __forceinline__ f32x4 dec4bf(u32x2 u) { return (f32x4){bf_lo(u.x), bf_hi(u.x), bf_lo(u.y), bf_hi(u.y)}; }
__device__ __forceinline__ unsigned pkbf(float lo, float hi) { return pg8::cvt_pk_bf16(lo, hi); }
__device__ __forceinline__ u32x2 pk4bf(f32x4 v) { u32x2 r; r.x = pkbf(v[0], v[1]); r.y = pkbf(v[2], v[3]); return r; }
__device__ __forceinline__ unsigned pkh(float lo, float hi) { h2 h; h.x = (f16)lo; h.y = (f16)hi; return __builtin_bit_cast(unsigned, h); }
__device__ __forceinline__ u32x2 pk4h(f32x4 v) { u32x2 r; r.x = pkh(v[0], v[1]); r.y = pkh(v[2], v[3]); return r; }
__device__ __forceinline__ h2 as_h2(unsigned u) { return __builtin_bit_cast(h2, u); }
__device__ __forceinline__ f32x4 dec4h(u32x2 u) { const h2 a = as_h2(u.x), b = as_h2(u.y); return (f32x4){(float)a.x, (float)a.y, (float)b.x, (float)b.y}; }
__device__ __forceinline__ float sigm(float x) { return __builtin_amdgcn_rcpf(1.f + __expf(-x)); }
__device__ __forceinline__ float wave_sum(float v) {
#pragma unroll
    for (int o = 1; o < 64; o <<= 1) v += __shfl_xor(v, o);
    return v;
}
template <int CTRL> __device__ __forceinline__ float dppf(float x) { return __int_as_float(__builtin_amdgcn_update_dpp(0, __float_as_int(x), CTRL, 0xF, 0xF, false)); }
__device__ __forceinline__ float row_sum16(float x) { x += dppf<0x128>(x); x += dppf<0x124>(x); x += dppf<0x122>(x); x += dppf<0x121>(x); return x; }
__device__ __forceinline__ float quad_sum(float x) { x += dppf<0xB1>(x); x += dppf<0x4E>(x); return x; }
__device__ __forceinline__ const float* xrow_ptr(const Args& a, int m) { return m < NPROMPT ? a.in[0] + (size_t)m * 1024 : a.in[1] + (size_t)(m - NPROMPT) * 1024; }

template <class F> struct Epi8 {
    static constexpr bool PERM = true, AFTER_DRAIN = false; F f;
    __device__ __forceinline__ void operator()(const f32x4 (&acc)[2][2][4][2], const pg8::Unit& u, int wr, int wc, int fr, int fq) const {
        const int row0 = u.pm * 256 + wr * 64 + fr, col0 = u.pn * 256 + wc * 32 + 8 * fq;
#pragma unroll
        for (int ai = 0; ai < 2; ++ai)
#pragma unroll
            for (int m = 0; m < 4; ++m)
#pragma unroll
                for (int bj = 0; bj < 2; ++bj) f(row0 + ai * 128 + m * 16, col0 + bj * 128, acc[ai][bj][m][0], acc[ai][bj][m][1]);
    }
};
template <class F> struct Epi4 {
    static constexpr bool PERM = false, AFTER_DRAIN = false; F f;
    __device__ __forceinline__ void operator()(const f32x4 (&acc)[2][2][4][2], const pg8::Unit& u, int wr, int wc, int fr, int fq) const {
        const int row0 = u.pm * 256 + wr * 64 + fr, col0 = u.pn * 256 + wc * 32 + 4 * fq;
#pragma unroll
        for (int ai = 0; ai < 2; ++ai)
#pragma unroll
            for (int m = 0; m < 4; ++m)
#pragma unroll
                for (int bj = 0; bj < 2; ++bj)
#pragma unroll
                    for (int n = 0; n < 2; ++n) f(row0 + ai * 128 + m * 16, col0 + bj * 128 + n * 16, acc[ai][bj][m][n]);
    }
};
__device__ __forceinline__ u32x4 pk8bf(f32x4 a, f32x4 b) { u32x4 w; w.x = pkbf(a[0], a[1]); w.y = pkbf(a[2], a[3]); w.z = pkbf(b[0], b[1]); w.w = pkbf(b[2], b[3]); return w; }
__device__ __forceinline__ u32x4 pk8h(f32x4 a, f32x4 b) { u32x4 w; w.x = pkh(a[0], a[1]); w.y = pkh(a[2], a[3]); w.z = pkh(b[0], b[1]); w.w = pkh(b[2], b[3]); return w; }
__device__ __forceinline__ void dec8bf(u32x4 w, f32x4& a, f32x4& b) { a = (f32x4){bf_lo(w.x), bf_hi(w.x), bf_lo(w.y), bf_hi(w.y)}; b = (f32x4){bf_lo(w.z), bf_hi(w.z), bf_lo(w.w), bf_hi(w.w)}; }

struct FStoreBf16 { bf16* O; int ldc;
    __device__ __forceinline__ void operator()(int r, int c, f32x4 v0, f32x4 v1) const { *(u32x4*)(O + (size_t)r * ldc + c) = pk8bf(v0, v1); } };
struct FStoreF32 { float* O; int ldc;
    __device__ __forceinline__ void operator()(int r, int c, f32x4 v) const { *(f32x4*)(O + (size_t)r * ldc + c) = v; } };
struct FLora { f16* WL; f16* AR; f16* G; const float* w0; const float* a0;
    __device__ __forceinline__ void operator()(int r, int c, f32x4 v0, f32x4 v1) const {
        const int t = c >> 10, cc = c & 1023;
        if (t == 0) { const f32x4 b0 = *(const f32x4*)(w0 + cc), b1 = *(const f32x4*)(w0 + cc + 4);
#pragma unroll
            for (int i = 0; i < 4; ++i) { v0[i] = __expf(-0.60653066f * sigm(v0[i] + b0[i])); v1[i] = __expf(-0.60653066f * sigm(v1[i] + b1[i])); }
            *(u32x4*)(WL + (size_t)r * 1024 + cc) = pk8h(v0, v1); }
        else if (t == 1) { const f32x4 b0 = *(const f32x4*)(a0 + cc), b1 = *(const f32x4*)(a0 + cc + 4);
#pragma unroll
            for (int i = 0; i < 4; ++i) { v0[i] = sigm(v0[i] + b0[i]); v1[i] = sigm(v1[i] + b1[i]); }
            *(u32x4*)(AR + (size_t)r * 1024 + cc) = pk8h(v0, v1); }
        else *(u32x4*)(G + (size_t)r * 1024 + cc) = pk8h(v0, v1);
    } };
struct FP1b { bf16* base;
    __device__ __forceinline__ void operator()(int r, int c, f32x4 v0, f32x4 v1) const {
        const int t = c >> 10, cc = c & 1023;
        if (t >= 2) {
#pragma unroll
            for (int i = 0; i < 4; ++i) { v0[i] = sigm(v0[i]); v1[i] = sigm(v1[i]); } }
        *(u32x4*)(base + (size_t)t * (U / 2) + (size_t)r * 1024 + cc) = pk8bf(v0, v1);
    } };
struct FGateA { const bf16* GA; bf16* M1;
    __device__ __forceinline__ void operator()(int r, int c, f32x4 v0, f32x4 v1) const {
        const size_t o = (size_t)r * 1024 + c; f32x4 g0, g1; dec8bf(*(const u32x4*)(GA + o), g0, g1);
        *(u32x4*)(M1 + o) = pk8bf(v0 * g0, v1 * g1);
    } };
struct FGateB { const bf16* GB; bf16* MMp;
    __device__ __forceinline__ void operator()(int r, int c, f32x4 v0, f32x4 v1) const {
        const size_t o = (size_t)r * 1024 + c; f32x4 g0, g1, m0, m1; dec8bf(*(const u32x4*)(GB + o), g0, g1); dec8bf(*(const u32x4*)(MMp + o), m0, m1);
        *(u32x4*)(MMp + o) = pk8bf(m0 + v0 * g0, m1 + v1 * g1);
    } };
struct EpiGU {
    static constexpr bool PERM = true, AFTER_DRAIN = false; bf16* H;
    __device__ __forceinline__ void operator()(const f32x4 (&acc)[2][2][4][2], const pg8::Unit& u, int wr, int wc, int fr, int fq) const {
        const int row0 = u.pm * 256 + wr * 64 + fr, h0 = u.pn * 128 + wc * 32 + 8 * fq;
#pragma unroll
        for (int ai = 0; ai < 2; ++ai)
#pragma unroll
            for (int m = 0; m < 4; ++m) {
                f32x4 o0, o1;
#pragma unroll
                for (int i = 0; i < 4; ++i) { const float g0 = acc[ai][0][m][0][i], g1 = acc[ai][1][m][0][i];
                    o0[i] = g0 * sigm(g0) * acc[ai][0][m][1][i]; o1[i] = g1 * sigm(g1) * acc[ai][1][m][1][i]; }
                *(u32x4*)(H + (size_t)(row0 + ai * 128 + m * 16) * DFF + h0) = pk8bf(o0, o1);
            }
    }
};

#define PH_PROLOG const int tid = threadIdx.x, lane = tid & 63, wave = __builtin_amdgcn_readfirstlane(tid >> 6); const int G = gridDim.x, bid = blockIdx.x; const int gw = bid * 8 + wave, NGW = G * 8; (void)lane; (void)gw; (void)NGW; (void)lds;

__device__ __forceinline__ float conv_src(const Args& a, int mat, int R, int k) {
    switch (mat) {
    case 0: return a.in[5][(size_t)k * 7424 + R];
    case 1: return a.in[21][(size_t)k * 1024 + R];
    case 2: return a.in[22][(size_t)k * 1024 + R];
    case 3: return a.in[23][(size_t)k * 1024 + R];
    case 4: { const int cl = R & 255, pn = R >> 8, bj = (cl >> 7) & 1, wc = (cl >> 5) & 3, fq = (cl >> 3) & 3, n = (cl >> 2) & 1, e = cl & 3;
              const int hcol = 128 * pn + 32 * wc + 8 * fq + 4 * bj + e; return (n ? a.in[27] : a.in[26])[(size_t)k * DFF + hcol]; }
    case 5: return a.in[28][(size_t)k * 1024 + R];
    case 6: { if (R < 1024) return k < 64 ? a.in[8][k * 1024 + R] : 0.f;
              if (R < 2048) return (k >= 64 && k < 128) ? a.in[10][(k - 64) * 1024 + R - 1024] : 0.f;
              return k >= 128 ? a.in[11][(k - 128) * 1024 + R - 2048] : 0.f; }
    default: { const int t = R & 127; return k <= t ? a.in[19][(size_t)R * 128 + k] : 0.f; }
    }
}
__device__ __forceinline__ void rms_row_to_bf16(const float* xrow, const float* gain, bf16* orow, int lane) {
    f32x4 v[4]; float ss = 0.f;
#pragma unroll
    for (int j = 0; j < 4; ++j) { v[j] = ((const f32x4*)xrow)[lane + 64 * j]; ss += (v[j][0] * v[j][0] + v[j][1] * v[j][1]) + (v[j][2] * v[j][2] + v[j][3] * v[j][3]); }
    const float rs = rsqrtf(wave_sum(ss) * (1.f / 1024.f) + 1e-6f);
#pragma unroll
    for (int j = 0; j < 4; ++j) { const f32x4 g = ((const f32x4*)gain)[lane + 64 * j]; ((u32x2*)orow)[lane + 64 * j] = pk4bf(v[j] * rs * g); }
}
__device__ __forceinline__ void phase_p0(const Args& a, LAS unsigned char* lds) {
    PH_PROLOG
    constexpr int NIT[8] = {928 * 16, 128 * 16, 128 * 16, 128 * 16, 704 * 16, 128 * 44, 384 * 4, 128 * 2};
    constexpr int KD[8] = {1024, 1024, 1024, 1024, 1024, 2816, 256, 128};
    constexpr size_t DST[8] = {WS_WIN, WS_WA, WS_WB, WS_WO, WS_GU, WS_WD, WS_LORA, WS_WSP};
    constexpr int NITEMS = NIT[0] + NIT[1] + NIT[2] + NIT[3] + NIT[4] + NIT[5] + NIT[6] + NIT[7];
    for (int it = gw; it < NITEMS; it += NGW) {
        int r = it, mat = 0;
#pragma unroll
        for (int q = 0; q < 7; ++q) { if (mat == q && r >= NIT[q]) { r -= NIT[q]; mat = q + 1; } }
        int Kd = 1024; size_t dst = WS_WIN;
#pragma unroll
        for (int q = 0; q < 8; ++q) if (mat == q) { Kd = KD[q]; dst = DST[q]; }
        const int kbn = Kd >> 6, rb = r / kbn, kb = r - rb * kbn;
        const int R = rb * 8 + (lane >> 3), k0 = kb * 64 + (lane & 7) * 8;
        float s[8];
#pragma unroll
        for (int j = 0; j < 8; ++j) s[j] = conv_src(a, mat, R, k0 + j);
        u32x4 w; w.x = pkbf(s[0], s[1]); w.y = pkbf(s[2], s[3]); w.z = pkbf(s[4], s[5]); w.w = pkbf(s[6], s[7]);
        *(u32x4*)(a.ws + dst + ((size_t)R * Kd + k0) * 2) = w;
    }
    bf16* XN = (bf16*)(a.ws + WS_XN);
    for (int m = gw; m < M; m += NGW) rms_row_to_bf16(xrow_ptr(a, m), a.in[4], XN + (size_t)m * 1024, lane);
}

__device__ __forceinline__ void phase_p2a(const Args& a, LAS unsigned char* lds) {
    PH_PROLOG
    const bf16* PS = (const bf16*)(a.ws + WS_PS); bf16* LX = (bf16*)(a.ws + WS_LX);
    const f32x4 mu = *(const f32x4*)(a.in[6] + 3072 + 4 * lane);
    for (int m = gw; m < M; m += NGW) {
        const bool samp = m >= NPROMPT; const int t = samp ? ((m - NPROMPT) & 63) : (m & 4095);
        const f32x4 p = dec4bf(*(const u32x2*)(PS + (size_t)m * SHW + 3072 + 4 * lane));
        f32x4 pp = (f32x4){0.f, 0.f, 0.f, 0.f};
        if (t > 0) pp = dec4bf(*(const u32x2*)(PS + (size_t)(m - 1) * SHW + 3072 + 4 * lane));
        else if (samp) pp = *(const f32x4*)(a.in[2] + (size_t)((m - NPROMPT) >> 6) * SHW + 3072 + 4 * lane);
        f32x4 x = p + (pp - p) * mu;
        if (lane < 16) {
#pragma unroll
            for (int i = 0; i < 4; ++i) x[i] = 1.f - 2.f * __builtin_amdgcn_rcpf(__expf(2.f * x[i]) + 1.f); }
        else if (lane >= 32) {
#pragma unroll
            for (int i = 0; i < 4; ++i) x[i] = sigm(x[i]); }
        *(u32x2*)(LX + (size_t)m * 256 + 4 * lane) = pk4bf(x);
    }
    if (gw < 40) {
        const int row = gw < 8 ? gw * 4096 + 4095 : NPROMPT + (gw - 8) * 64 + 63;
        float* dst = a.out + (gw < 8 ? OUT_SHIFT_P + (size_t)gw * SHW : OUT_SHIFT_S + (size_t)(gw - 8) * SHW);
        for (int c = lane; c < SHW; c += 64) dst[c] = bf_lo((unsigned)PS[(size_t)row * SHW + c]);
    }
}

constexpr int SC_STEPS = 32, SC_PK = SC_STEPS * 16 * 48, SC_BUF = SC_PK + SC_STEPS * 64 * 4;
struct ScanK { f32x4 mu_r, mu_k, mu_v, kk, ka; };
__device__ __forceinline__ void scan_stage_write(LAS unsigned char* buf, int s_st, int kg_st, const ScanK& K, f32x4 r, f32x4 k, f32x4 v, f32x4 pr, f32x4 pk, f32x4 pv, u32x2 wl, u32x2 ar) {
    const f32x4 xr = r + (pr - r) * K.mu_r, xk = k + (pk - k) * K.mu_k, xv = v + (pv - v) * K.mu_v;
    const f32x4 ar4 = dec4h(ar);
    const f32x4 kkr = xk * K.kk;
    float ssq = (kkr[0] * kkr[0] + kkr[1] * kkr[1]) + (kkr[2] * kkr[2] + kkr[3] * kkr[3]);
    ssq = row_sum16(ssq);
    const float inv = 1.f / fmaxf(sqrtf(ssq), 1e-12f);
    const f32x4 kkn = kkr * inv, bb = kkn * ar4, km = xk * (1.f + (ar4 - 1.f) * K.ka);
    LAS unsigned char* p = buf + (s_st * 16 + kg_st) * 48;
    const u32x2 hk = pk4h(kkn), hb = pk4h(bb), hm = pk4h(km), hr = pk4h(xr);
    *(LAS u32x4*)p = (u32x4){wl.x, wl.y, hk.x, hk.y};
    *(LAS u32x4*)(p + 16) = (u32x4){hb.x, hb.y, hm.x, hm.y};
    *(LAS u32x2*)(p + 32) = hr;
    *(LAS f32x4*)(buf + SC_PK + (s_st * 64 + 4 * kg_st) * 4) = xv;
}
__device__ __forceinline__ void phase_scan(const Args& a, LAS unsigned char* lds) {
    PH_PROLOG
    const bf16* PS = (const bf16*)(a.ws + WS_PS); const f16* WL = (const f16*)(a.ws + WS_WL); const f16* AR = (const f16*)(a.ws + WS_AR);
    float* Y = a.out + OUT_Y;
    const int s_st = tid >> 4, kg_st = tid & 15;
    const int rw = lane >> 4, kg = lane & 15;
    for (int task = bid; task < 1280; task += G) {
        const bool samp = task >= 256; const int q = samp ? task - 256 : task;
        const int b = q >> 5, h = (q >> 1) & 15, half = q & 1;
        const int m0 = samp ? NPROMPT + b * 64 : b * 4096, T = samp ? 64 : 4096, nch = T / SC_STEPS;
        const int v = half * 32 + wave * 4 + rw;
        f32x4 S = (f32x4){0.f, 0.f, 0.f, 0.f};
        if (samp) S = *(const f32x4*)(a.in[3] + ((size_t)((b * 16 + h) * 64 + v)) * 64 + 4 * kg);
        const int c = h * 64 + 4 * kg_st;
        ScanK K; K.mu_r = *(const f32x4*)(a.in[6] + c); K.mu_k = *(const f32x4*)(a.in[6] + 1024 + c); K.mu_v = *(const f32x4*)(a.in[6] + 2048 + c);
        K.kk = *(const f32x4*)(a.in[12] + c); K.ka = *(const f32x4*)(a.in[13] + c);
        {
            const size_t m = (size_t)m0 + s_st; const bf16* base = PS + m * SHW + c;
            const f32x4 r = dec4bf(*(const u32x2*)base), k = dec4bf(*(const u32x2*)(base + 1024)), vv = dec4bf(*(const u32x2*)(base + 2048));
            f32x4 pr, pk, pv;
            if (s_st > 0) { pr = dec4bf(*(const u32x2*)(base - SHW)); pk = dec4bf(*(const u32x2*)(base - SHW + 1024)); pv = dec4bf(*(const u32x2*)(base - SHW + 2048)); }
            else if (samp) { const float* ss = a.in[2] + (size_t)b * SHW + c; pr = *(const f32x4*)ss; pk = *(const f32x4*)(ss + 1024); pv = *(const f32x4*)(ss + 2048); }
            else { pr = (f32x4){0.f, 0.f, 0.f, 0.f}; pk = pr; pv = pr; }
            const u32x2 wl = *(const u32x2*)(WL + m * 1024 + c), ar = *(const u32x2*)(AR + m * 1024 + c);
            scan_stage_write(lds, s_st, kg_st, K, r, k, vv, pr, pk, pv, wl, ar);
        }
        __syncthreads();
        float ykeep = 0.f;
        for (int ch = 0; ch < nch; ++ch) {
            const bool more = ch + 1 < nch;
            u32x2 cr, ck, cv, qr, qk, qv, wl, ar;
            cr = ck = cv = qr = qk = qv = wl = ar = (u32x2){0u, 0u};
            if (more) {
                const size_t m = (size_t)m0 + (ch + 1) * SC_STEPS + s_st; const bf16* base = PS + m * SHW + c;
                cr = *(const u32x2*)base; ck = *(const u32x2*)(base + 1024); cv = *(const u32x2*)(base + 2048);
                qr = *(const u32x2*)(base - SHW); qk = *(const u32x2*)(base - SHW + 1024); qv = *(const u32x2*)(base - SHW + 2048);
                wl = *(const u32x2*)(WL + m * 1024 + c); ar = *(const u32x2*)(AR + m * 1024 + c);
            }
            LAS unsigned char* buf = lds + (ch & 1) * SC_BUF;
            const int t0 = ch * SC_STEPS;
#pragma unroll 16
            for (int s = 0; s < SC_STEPS; ++s) {
                const LAS unsigned char* p = buf + (s * 16 + kg) * 48;
                const u32x4 q0 = *(const LAS u32x4*)p, q1 = *(const LAS u32x4*)(p + 16); const u32x2 q2 = *(const LAS u32x2*)(p + 32);
                const float vval = *(const LAS float*)(buf + SC_PK + (s * 64 + v) * 4);
                const h2 w01 = as_h2(q0.x), w23 = as_h2(q0.y), k01 = as_h2(q0.z), k23 = as_h2(q0.w);
                const h2 b01 = as_h2(q1.x), b23 = as_h2(q1.y), m01 = as_h2(q1.z), m23 = as_h2(q1.w);
                const h2 r01 = as_h2(q2.x), r23 = as_h2(q2.y);
                float sa = S[0] * (float)k01.x; sa = __builtin_fmaf(S[1], (float)k01.y, sa); sa = __builtin_fmaf(S[2], (float)k23.x, sa); sa = __builtin_fmaf(S[3], (float)k23.y, sa);
                sa = -row_sum16(sa);
                S[0] = __builtin_fmaf(S[0], (float)w01.x, __builtin_fmaf(sa, (float)b01.x, vval * (float)m01.x));
                S[1] = __builtin_fmaf(S[1], (float)w01.y, __builtin_fmaf(sa, (float)b01.y, vval * (float)m01.y));
                S[2] = __builtin_fmaf(S[2], (float)w23.x, __builtin_fmaf(sa, (float)b23.x, vval * (float)m23.x));
                S[3] = __builtin_fmaf(S[3], (float)w23.y, __builtin_fmaf(sa, (float)b23.y, vval * (float)m23.y));
                float y = S[0] * (float)r01.x; y = __builtin_fmaf(S[1], (float)r01.y, y); y = __builtin_fmaf(S[2], (float)r23.x, y); y = __builtin_fmaf(S[3], (float)r23.y, y);
                y = row_sum16(y);
                ykeep = ((s & 15) == kg) ? y : ykeep;
                if ((s & 15) == 15) Y[(size_t)(m0 + t0 + s - 15 + kg) * 1024 + h * 64 + v] = ykeep;
            }
            if (more) {
                scan_stage_write(lds + ((ch + 1) & 1) * SC_BUF, s_st, kg_st, K, dec4bf(cr), dec4bf(ck), dec4bf(cv), dec4bf(qr), dec4bf(qk), dec4bf(qv), wl, ar);
            }
            __syncthreads();
        }
        float* So = a.out + (samp ? OUT_WKV_S : OUT_WKV_P) + ((size_t)((b * 16 + h) * 64 + v)) * 64 + 4 * kg;
        *(f32x4*)So = S;
    }
}

__device__ __forceinline__ void ld16bf(const bf16* p, float (&o)[16]) {
    const u32x4 w0 = *(const u32x4*)p, w1 = *(const u32x4*)(p + 8); f32x4 a, b, c, d; dec8bf(w0, a, b); dec8bf(w1, c, d);
#pragma unroll
    for (int i = 0; i < 4; ++i) { o[i] = a[i]; o[4 + i] = b[i]; o[8 + i] = c[i]; o[12 + i] = d[i]; }
}
__device__ __forceinline__ void ld16h(const f16* p, float (&o)[16]) {
    const u32x4 w0 = *(const u32x4*)p, w1 = *(const u32x4*)(p + 8);
    const f32x4 a = dec4h((u32x2){w0.x, w0.y}), b = dec4h((u32x2){w0.z, w0.w}), c = dec4h((u32x2){w1.x, w1.y}), d = dec4h((u32x2){w1.z, w1.w});
#pragma unroll
    for (int i = 0; i < 4; ++i) { o[i] = a[i]; o[4 + i] = b[i]; o[8 + i] = c[i]; o[12 + i] = d[i]; }
}
__device__ __forceinline__ void ld16f(const float* p, float (&o)[16]) {
#pragma unroll
    for (int j = 0; j < 4; ++j) { const f32x4 x = ((const f32x4*)p)[j];
#pragma unroll
        for (int i = 0; i < 4; ++i) o[4 * j + i] = x[i]; }
}
__device__ __forceinline__ void tokshift16(float (&x)[16], const bf16* prevp, bool has_prev, bool samp, const float* ssrc, const float* mu) {
    float tmp[16], cst[16];
    if (has_prev) ld16bf(prevp, tmp);
    else if (samp) ld16f(ssrc, tmp);
    else {
#pragma unroll
        for (int i = 0; i < 16; ++i) tmp[i] = 0.f; }
    ld16f(mu, cst);
#pragma unroll
    for (int i = 0; i < 16; ++i) x[i] = x[i] + (tmp[i] - x[i]) * cst[i];
}
__device__ __forceinline__ void phase_gn(const Args& a, LAS unsigned char* lds) {
    PH_PROLOG
    const bf16* PS = (const bf16*)(a.ws + WS_PS); const f16* AR = (const f16*)(a.ws + WS_AR); f16* Gp = (f16*)(a.ws + WS_G);
    const float* Y = a.out + OUT_Y;
    const int c = 16 * lane;
    for (int m = gw; m < M; m += NGW) {
        const bool samp = m >= NPROMPT; const int t = samp ? ((m - NPROMPT) & 63) : (m & 4095);
        float xr[16], xk[16], xv[16], tmp[16], cst[16];
        const bf16* base = PS + (size_t)m * SHW + c;
        ld16bf(base, xr); ld16bf(base + 1024, xk); ld16bf(base + 2048, xv);
        tokshift16(xr, base - SHW, t > 0, samp, a.in[2] + (size_t)((m - NPROMPT) >> 6) * SHW + c, a.in[6] + c);
        tokshift16(xk, base - SHW + 1024, t > 0, samp, a.in[2] + (size_t)((m - NPROMPT) >> 6) * SHW + 1024 + c, a.in[6] + 1024 + c);
        tokshift16(xv, base - SHW + 2048, t > 0, samp, a.in[2] + (size_t)((m - NPROMPT) >> 6) * SHW + 2048 + c, a.in[6] + 2048 + c);
        ld16h(AR + (size_t)m * 1024 + c, tmp); ld16f(a.in[13] + c, cst);
#pragma unroll
        for (int i = 0; i < 16; ++i) xk[i] = xk[i] * (1.f + (tmp[i] - 1.f) * cst[i]);
        ld16f(a.in[14] + c, cst);
        float rk = 0.f;
#pragma unroll
        for (int i = 0; i < 16; ++i) rk += xr[i] * xk[i] * cst[i];
        rk = quad_sum(rk);
        float y[16]; ld16f(Y + (size_t)m * 1024 + c, y);
        float s = 0.f;
#pragma unroll
        for (int i = 0; i < 16; ++i) s += y[i];
        const float mean = quad_sum(s) * (1.f / 64.f);
        float q2 = 0.f;
#pragma unroll
        for (int i = 0; i < 16; ++i) { y[i] -= mean; q2 += y[i] * y[i]; }
        const float rstd = rsqrtf(quad_sum(q2) * (1.f / 64.f) + 64e-5f);
        ld16f(a.in[15] + c, cst); ld16f(a.in[16] + c, tmp);
#pragma unroll
        for (int i = 0; i < 16; ++i) y[i] = y[i] * rstd * cst[i] + tmp[i] + rk * xv[i];
        ld16h(Gp + (size_t)m * 1024 + c, tmp);
        u32x4 o0, o1;
        o0.x = pkbf(y[0] * tmp[0], y[1] * tmp[1]); o0.y = pkbf(y[2] * tmp[2], y[3] * tmp[3]); o0.z = pkbf(y[4] * tmp[4], y[5] * tmp[5]); o0.w = pkbf(y[6] * tmp[6], y[7] * tmp[7]);
        o1.x = pkbf(y[8] * tmp[8], y[9] * tmp[9]); o1.y = pkbf(y[10] * tmp[10], y[11] * tmp[11]); o1.z = pkbf(y[12] * tmp[12], y[13] * tmp[13]); o1.w = pkbf(y[14] * tmp[14], y[15] * tmp[15]);
        bf16* OA = (bf16*)Gp + (size_t)m * 1024 + c;
        *(u32x4*)OA = o0; *(u32x4*)(OA + 8) = o1;
    }
    bf16* XN2 = (bf16*)(a.ws + WS_XN2);
    for (int m = gw; m < M; m += NGW) rms_row_to_bf16(xrow_ptr(a, m), a.in[4], XN2 + (size_t)m * 1024, lane);
}

__device__ __forceinline__ int gm_swz(int row) { return (row & 3) | (((row >> 3) & 1) << 2); }
__device__ __forceinline__ void phase_gmlp(const Args& a, LAS unsigned char* lds) {
    PH_PROLOG
    const bf16* PU = (const bf16*)(a.ws + WS_P4); const bf16* PV = (const bf16*)(a.ws + WS_P4 + U); bf16* OB = (bf16*)(a.ws + WS_OB);
    const bf16* WSP = (const bf16*)(a.ws + WS_WSP);
    LAS float* stats = (LAS float*)lds;
    LAS unsigned char* img = lds + 4096;
    for (int unit = bid; unit < 272; unit += G) {
        const bool samp = unit >= 256; const int m0 = unit * 128;
        for (int i = 0; i < 16; ++i) {
            const int tk = wave * 16 + i; float x[16]; ld16bf(PV + (size_t)(m0 + tk) * 1024 + 16 * lane, x);
            float s = 0.f;
#pragma unroll
            for (int j = 0; j < 16; ++j) s += x[j];
            const float mean = wave_sum(s) * (1.f / 1024.f); float q2 = 0.f;
#pragma unroll
            for (int j = 0; j < 16; ++j) { x[j] -= mean; q2 += x[j] * x[j]; }
            const float rstd = rsqrtf(wave_sum(q2) * (1.f / 1024.f) + 1e-5f);
            if (lane == 0) { stats[2 * tk] = mean; stats[2 * tk + 1] = rstd; }
            if (samp) {
                float g[16], bb[16]; ld16f(a.in[17] + 16 * lane, g); ld16f(a.in[18] + 16 * lane, bb);
                float* o = a.out + OUT_VS + (size_t)(m0 + tk - NPROMPT) * 1024 + 16 * lane;
#pragma unroll
                for (int j = 0; j < 4; ++j) ((f32x4*)o)[j] = (f32x4){x[4 * j] * rstd * g[4 * j] + bb[4 * j], x[4 * j + 1] * rstd * g[4 * j + 1] + bb[4 * j + 1], x[4 * j + 2] * rstd * g[4 * j + 2] + bb[4 * j + 2], x[4 * j + 3] * rstd * g[4 * j + 3] + bb[4 * j + 3]};
            }
        }
        __syncthreads();
        const int trow_off = (samp && wave >= 4) ? 64 : 0, t0 = wave * 16;
        const int ks_lo = trow_off >> 5, ks_hi = (t0 + 15) >> 5;
        for (int g = 0; g < 8; ++g) {
#pragma unroll
            for (int i = 0; i < 4; ++i) {
                const int p = tid + 512 * i, row = p >> 4, c8 = p & 15, gc = g * 128 + 8 * c8;
                f32x4 x0, x1; dec8bf(*(const u32x4*)(PV + (size_t)(m0 + row) * 1024 + gc), x0, x1);
                const float mean = stats[2 * row], rstd = stats[2 * row + 1];
                const f32x4 g0 = *(const f32x4*)(a.in[17] + gc), g1 = *(const f32x4*)(a.in[17] + gc + 4), b0 = *(const f32x4*)(a.in[18] + gc), b1 = *(const f32x4*)(a.in[18] + gc + 4);
                x0 = (x0 - mean) * rstd * g0 + b0; x1 = (x1 - mean) * rstd * g1 + b1;
                *(LAS u32x4*)(img + row * 256 + (((c8 >> 1) ^ gm_swz(row)) << 5) + (c8 & 1) * 16) = pk8bf(x0, x1);
            }
            __syncthreads();
            f32x4 acc[8];
#pragma unroll
            for (int ct = 0; ct < 8; ++ct) acc[ct] = (f32x4){0.f, 0.f, 0.f, 0.f};
            for (int ks = ks_lo; ks <= ks_hi; ++ks) {
                const bf16x8 wf = *(const bf16x8*)(WSP + ((size_t)(g * 128 + t0 - trow_off + (lane & 15))) * 128 + 32 * ks - trow_off + 8 * (lane >> 4));
                const int row = 32 * ks + 8 * (lane >> 4) + ((lane & 15) >> 2);
                const int sw = gm_swz(row);
#pragma unroll
                for (int ct = 0; ct < 8; ++ct) {
                    LAS unsigned char* p = img + row * 256 + ((ct ^ sw) << 5) + (lane & 3) * 8;
                    const s16x4 lo = __builtin_amdgcn_ds_read_tr16_b64_v4i16((LAS s16x4*)p), hi = __builtin_amdgcn_ds_read_tr16_b64_v4i16((LAS s16x4*)(p + 1024));
                    bf16x8 vf; vf[0] = lo[0]; vf[1] = lo[1]; vf[2] = lo[2]; vf[3] = lo[3]; vf[4] = hi[0]; vf[5] = hi[1]; vf[6] = hi[2]; vf[7] = hi[3];
                    acc[ct] = __builtin_amdgcn_mfma_f32_16x16x32_bf16(vf, wf, acc[ct], 0, 0, 0);
                }
            }
            const int t = t0 + (lane & 15);
            const float bias = a.in[20][g * 128 + t - trow_off];
#pragma unroll
            for (int ct = 0; ct < 8; ++ct) {
                const size_t o = (size_t)(m0 + t) * 1024 + g * 128 + 16 * ct + 4 * (lane >> 4);
                const f32x4 pu = dec4bf(*(const u32x2*)(PU + o));
                *(u32x2*)(OB + o) = pk4bf(pu * (acc[ct] + bias));
            }
            __syncthreads();
        }
    }
}

__device__ __forceinline__ void phase_p5b(const Args& a, LAS unsigned char* lds) {
    PH_PROLOG
    const float* MO = (const float*)(a.ws + WS_MO); bf16* F = (bf16*)(a.ws + WS_F);
    for (int m = gw; m < M; m += NGW) {
        const float* xr = xrow_ptr(a, m); f32x4 v[4]; float ss = 0.f;
#pragma unroll
        for (int j = 0; j < 4; ++j) { v[j] = ((const f32x4*)(MO + (size_t)m * 1024))[lane + 64 * j]; ss += (v[j][0] * v[j][0] + v[j][1] * v[j][1]) + (v[j][2] * v[j][2] + v[j][3] * v[j][3]); }
        const float rs = rsqrtf(wave_sum(ss) * (1.f / 1024.f) + 1e-6f); float s2 = 0.f;
#pragma unroll
        for (int j = 0; j < 4; ++j) { const f32x4 g = ((const f32x4*)a.in[24])[lane + 64 * j], x = ((const f32x4*)xr)[lane + 64 * j];
            v[j] = x + v[j] * rs * g; ((f32x4*)(a.out + OUT_Y + (size_t)m * 1024))[lane + 64 * j] = v[j];
            s2 += (v[j][0] * v[j][0] + v[j][1] * v[j][1]) + (v[j][2] * v[j][2] + v[j][3] * v[j][3]); }
        const float rs2 = rsqrtf(wave_sum(s2) * (1.f / 1024.f) + 1e-6f);
#pragma unroll
        for (int j = 0; j < 4; ++j) { const f32x4 g = ((const f32x4*)a.in[25])[lane + 64 * j]; ((u32x2*)(F + (size_t)m * 1024))[lane + 64 * j] = pk4bf(v[j] * rs2 * g); }
    }
}
__device__ __forceinline__ void phase_p7b(const Args& a, LAS unsigned char* lds) {
    PH_PROLOG
    const float* F2 = (const float*)(a.ws + WS_F2);
    for (int m = gw; m < M; m += NGW) {
        f32x4 v[4]; float ss = 0.f;
#pragma unroll
        for (int j = 0; j < 4; ++j) { v[j] = ((const f32x4*)(F2 + (size_t)m * 1024))[lane + 64 * j]; ss += (v[j][0] * v[j][0] + v[j][1] * v[j][1]) + (v[j][2] * v[j][2] + v[j][3] * v[j][3]); }
        const float rs = rsqrtf(wave_sum(ss) * (1.f / 1024.f) + 1e-6f);
        f32x4* o = (f32x4*)(a.out + OUT_Y + (size_t)m * 1024);
#pragma unroll
        for (int j = 0; j < 4; ++j) { const f32x4 g = ((const f32x4*)a.in[29])[lane + 64 * j]; o[lane + 64 * j] = o[lane + 64 * j] + v[j] * rs * g; }
    }
}

template <class E> __device__ __forceinline__ void run_gemm(LAS unsigned char* lds, const bf16* A, const bf16* Bt, int N, int K, const E& e) {
    pg8::Gemm g{A, Bt, M, N, K}; pg8::StaticOrder S; S.init(M, N, (int)gridDim.x, (int)blockIdx.x);
    pg8::gemm_phase<E, pg8::StaticOrder, true, true>(lds, g, S, e);
}
__global__ void __launch_bounds__(512, 2) mk_fwd(Args a) {
    extern __shared__ __attribute__((aligned(16))) unsigned char lds_raw[];
    LAS unsigned char* lds = (LAS unsigned char*)lds_raw;
    unsigned char* ws = a.ws;
    const int lo = a.ph_lo, hi = a.ph_hi;
#define IN(k) (lo <= (k) && (k) < hi)
#define SEAM(k) do { if (IN(k) && IN((k) + 1)) { cg::this_grid().sync(); } } while (0)
    if (IN(0)) { phase_p0(a, lds); } SEAM(0);
    if (IN(1)) { Epi8<FStoreBf16> e{{(bf16*)(ws + WS_PS), SHW}}; run_gemm(lds, (const bf16*)(ws + WS_XN), (const bf16*)(ws + WS_WIN), SHW, 1024, e); } SEAM(1);
    if (IN(2)) { phase_p2a(a, lds); } SEAM(2);
    if (IN(3)) { Epi8<FLora> e{{(f16*)(ws + WS_WL), (f16*)(ws + WS_AR), (f16*)(ws + WS_G), a.in[7], a.in[9]}}; run_gemm(lds, (const bf16*)(ws + WS_LX), (const bf16*)(ws + WS_LORA), 3072, 256, e); } SEAM(3);
    if (IN(4)) { phase_scan(a, lds); } SEAM(4);
    if (IN(5)) { phase_gn(a, lds); } SEAM(5);
    if (IN(6)) { Epi8<FP1b> e{{(bf16*)(ws + WS_P4)}}; run_gemm(lds, (const bf16*)(ws + WS_XN2), (const bf16*)(ws + WS_WIN) + (size_t)SHW * 1024, 4096, 1024, e); } SEAM(6);
    if (IN(7)) { phase_gmlp(a, lds); } SEAM(7);
    if (IN(8)) { Epi8<FGateA> e{{(const bf16*)(ws + WS_P4 + 2 * U), (bf16*)(ws + WS_MM)}}; run_gemm(lds, (const bf16*)(ws + WS_OA), (const bf16*)(ws + WS_WA), 1024, 1024, e); } SEAM(8);
    if (IN(9)) { Epi8<FGateB> e{{(const bf16*)(ws + WS_P4 + 3 * U), (bf16*)(ws + WS_MM)}}; run_gemm(lds, (const bf16*)(ws + WS_OB), (const bf16*)(ws + WS_WB), 1024, 1024, e); } SEAM(9);
    if (IN(10)) { Epi4<FStoreF32> e{{(float*)(ws + WS_MO), 1024}}; run_gemm(lds, (const bf16*)(ws + WS_MM), (const bf16*)(ws + WS_WO), 1024, 1024, e); } SEAM(10);
    if (IN(11)) { phase_p5b(a, lds); } SEAM(11);
    if (IN(12)) { EpiGU e{(bf16*)(ws + WS_H)}; run_gemm(lds, (const bf16*)(ws + WS_F), (const bf16*)(ws + WS_GU), 2 * DFF, 1024, e); } SEAM(12);
    if (IN(13)) { Epi4<FStoreF32> e{{(float*)(ws + WS_F2), 1024}}; run_gemm(lds, (const bf16*)(ws + WS_H), (const bf16*)(ws + WS_WD), 1024, DFF, e); } SEAM(13);
    if (IN(14)) { phase_p7b(a, lds); }
#undef IN
#undef SEAM
}


#ifndef MK_DBG
#define MK_DBG 0
#endif
__global__ void dbg_zero(float* p, size_t n) { for (size_t i = (size_t)blockIdx.x * blockDim.x + threadIdx.x; i < n; i += (size_t)gridDim.x * blockDim.x) p[i] = 0.f; }
extern "C" void kernel_launch(void* const* d_in, const int* in_sizes, int n_in, void* d_out, int out_size, void* d_ws, size_t ws_size, hipStream_t stream) {
    static int grid = 0;
    if (grid == 0) {
        if (n_in != 30 || (size_t)out_size != OUT_END || ws_size < WS_END) { fprintf(stderr, "kernel_launch: unexpected shapes (n_in %d out %d ws %zu, need ws >= %zu)\n", n_in, out_size, ws_size, (size_t)WS_END); }
        int dev = 0, cus = 0, per_cu = 0;
        (void)hipGetDevice(&dev); (void)hipDeviceGetAttribute(&cus, hipDeviceAttributeMultiprocessorCount, dev);
        (void)hipFuncSetAttribute((const void*)mk_fwd, hipFuncAttributeMaxDynamicSharedMemorySize, LDS_BYTES);
        (void)hipOccupancyMaxActiveBlocksPerMultiprocessor(&per_cu, (const void*)mk_fwd, 512, LDS_BYTES);
        if (per_cu < 1) { fprintf(stderr, "kernel_launch: occupancy query says %d blocks per CU\n", per_cu); per_cu = 1; }
        grid = cus > 0 ? cus : 256;
        (void)hipGetLastError();
    }
    Args a{};
    for (int i = 0; i < 30; ++i) a.in[i] = (const float*)d_in[i];
    a.out = (float*)d_out; a.ws = (unsigned char*)d_ws;
#if MK_ONE_LAUNCH
    a.ph_lo = 0; a.ph_hi = NPHASE;
    void* args[] = {&a};
    hipError_t e = hipLaunchCooperativeKernel((const void*)mk_fwd, dim3(grid), dim3(512), args, LDS_BYTES, stream);
    if (e != hipSuccess) fprintf(stderr, "cooperative launch failed: %s (grid %d)\n", hipGetErrorString(e), grid);
#else
    const int nph = MK_DBG == 1 ? 5 : (MK_DBG == 2 ? 3 : (MK_DBG == 3 ? 8 : NPHASE));
    for (int p = 0; p < nph; ++p) { a.ph_lo = p; a.ph_hi = p + 1; hipLaunchKernelGGL(mk_fwd, dim3(grid), dim3(512), LDS_BYTES, stream, a); }
    float* o = (float*)d_out;
    if (MK_DBG >= 1) hipLaunchKernelGGL(dbg_zero, dim3(1024), dim3(256), 0, stream, o + OUT_Y, (size_t)M * 1024);
    if (MK_DBG == 1 || MK_DBG == 2) hipLaunchKernelGGL(dbg_zero, dim3(1024), dim3(256), 0, stream, o + OUT_VS, (size_t)32 * 64 * 1024);
    if (MK_DBG == 2) { hipLaunchKernelGGL(dbg_zero, dim3(1024), dim3(256), 0, stream, o + OUT_WKV_P, (size_t)8 * 16 * 4096); hipLaunchKernelGGL(dbg_zero, dim3(1024), dim3(256), 0, stream, o + OUT_WKV_S, (size_t)32 * 16 * 4096); }
#endif
}
```

```cpp
#include <hip/hip_runtime.h>
#include <hip/hip_cooperative_groups.h>
#include <cstdio>
#include <cstdint>
namespace cg = cooperative_groups;
namespace pg8 {
#define PG8_LAS __attribute__((address_space(3)))
typedef unsigned short bf16_t;
typedef short bf16x8 __attribute__((ext_vector_type(8)));
typedef float f32x4 __attribute__((ext_vector_type(4)));
typedef unsigned u32x4 __attribute__((ext_vector_type(4)));
constexpr int BM = 256, BK = 64, HALF = 128, HTB = HALF * BK * 2  , STAGE_BYTES = 8 * HTB, NXCD = 8, WGM = 8;

__host__ __device__ __forceinline__ int lds_byte(int r, int c) { const int st = (r >> 4) * 2 + (c >> 5), rr = r & 15, cc = c & 31, ob = rr * 64 + cc * 2; return st * 1024 + (ob ^ (((ob >> 9) & 1) << 5)); }
__host__ __device__ __forceinline__ void stage_rc(int b, int& R, int& C) { const int st = b / 1024, sb = b % 1024, swz = sb ^ (((sb >> 9) & 1) << 5); R = (st >> 1) * 16 + swz / 64; C = (st & 1) * 32 + (swz % 64) / 2; }
__host__ __device__ __forceinline__ int perm32(int rho) { const int n = rho >> 4, i = rho & 15; return 8 * (i >> 2) + 4 * n + (i & 3); }

struct Unit { int pm, pn; };
struct Gemm { const bf16_t* A; const bf16_t* Bt; int M, N, K; };

struct StaticOrder {
    int nM, nN, nwg, G, c;
    __host__ __device__ void init(int M, int N, int G_, int c_) { nM = M / BM; nN = N / BM; nwg = nM * nN; G = G_; c = c_; }
    __host__ __device__ bool next(int i, Unit& u) const {
        const long L = (long)i * G + c; if (L >= nwg) return false;
        int wgid = (int)L; { const int q = nwg / NXCD, r = nwg % NXCD, xcd = wgid % NXCD, off = wgid / NXCD; wgid = (xcd < r ? xcd * (q + 1) : r * (q + 1) + (xcd - r) * q) + off; }
        const int nig = WGM * nN, gid = wgid / nig, fm = gid * WGM, gsz = (nM - fm) < WGM ? (nM - fm) : WGM;
        u.pm = fm + ((wgid % nig) % gsz); u.pn = (wgid % nig) / gsz; return true;
    }
    __device__ __forceinline__ void a_ready(const Unit&) const {}
    __device__ __forceinline__ void done(const Unit&) const {}
};

__device__ __forceinline__ unsigned cvt_pk_bf16(float lo, float hi) { unsigned r; asm volatile("v_cvt_pk_bf16_f32 %0, %1, %2" : "=v"(r) : "v"(lo), "v"(hi)); return r; }
typedef float f32x2 __attribute__((ext_vector_type(2)));
template <class Epi, class Sched, bool ALIGN_EPI = false, bool SP2 = false>
__device__ __forceinline__ void gemm_phase(PG8_LAS unsigned char* lds, const Gemm g, const Sched& S, const Epi& E) {
    const int tid = threadIdx.x, wid = __builtin_amdgcn_readfirstlane(tid >> 6), lane = tid & 63, wr = wid >> 2, wc = wid & 3, fr = lane & 15, fq = lane >> 4;
    const int K = g.K, nt = K / BK;
    unsigned voffA[2], voffB[2];
#pragma unroll
    for (int i = 0; i < 2; ++i) { int R, C; stage_rc(tid * 16 + i * 8192, R, C); const int Rb = Epi::PERM ? ((R & ~31) + perm32(R & 31)) : R;
        voffA[i] = (unsigned)(R * K + C) * 2u; voffB[i] = (unsigned)(Rb * K + C) * 2u; }
    const size_t kstep = (size_t)(BK * 2);
    const size_t hstep = (size_t)HALF * K * 2;
    const size_t tstep = 2 * hstep;
    const unsigned ldsw = (unsigned)wid * 1024u;
    const int aoff = lds_byte(wr * 64 + fr, fq * 8), boff = lds_byte(wc * 32 + fr, fq * 8);
#define PG8_SA(b, h) (((b) * 2 + (h)) * HTB)
#define PG8_SB(b, h) ((4 + (b) * 2 + (h)) * HTB)
#define PG8_STAGE(bufoff, gbase, voff) do { _Pragma("unroll") for (int _i = 0; _i < 2; ++_i) \
        __builtin_amdgcn_global_load_lds((const unsigned*)((const char*)(gbase) + (voff)[_i]), (PG8_LAS unsigned*)(lds + (bufoff) + ldsw + _i * 8192), 16, 0, 0); } while (0)
#define PG8_LDA(dst, b, h) do { _Pragma("unroll") for (int m = 0; m < 4; ++m) _Pragma("unroll") for (int k = 0; k < 2; ++k) dst[m][k] = *(const PG8_LAS bf16x8*)(lds + PG8_SA(b, h) + aoff + m * 2048 + k * 1024); } while (0)
#define PG8_LDB(dst, b, h) do { _Pragma("unroll") for (int n = 0; n < 2; ++n) _Pragma("unroll") for (int k = 0; k < 2; ++k) dst[n][k] = *(const PG8_LAS bf16x8*)(lds + PG8_SB(b, h) + boff + n * 2048 + k * 1024); } while (0)
#define PG8_MMA(ai, bj, At, Bt) do { __builtin_amdgcn_s_setprio(1); _Pragma("unroll") for (int m = 0; m < 4; ++m) _Pragma("unroll") for (int n = 0; n < 2; ++n) _Pragma("unroll") for (int k = 0; k < 2; ++k) \
        acc[ai][bj][m][n] = __builtin_amdgcn_mfma_f32_16x16x32_bf16(Bt[n][k], At[m][k], acc[ai][bj][m][n], 0, 0, 0); __builtin_amdgcn_s_setprio(0); } while (0)
#define PG8_WAIT_V(n) asm volatile("s_waitcnt vmcnt(" #n ")" ::: "memory")
#define PG8_WAIT_L(n) asm volatile("s_waitcnt lgkmcnt(" #n ")" ::: "memory")
#define PG8_BAR __builtin_amdgcn_s_barrier()
#define PG8_SCHED __builtin_amdgcn_sched_barrier(0)
    Unit cur, nxt; int ui = 0;
    if (!S.next(0, cur)) return;
    f32x4 acc[2][2][4][2];
#pragma unroll
    for (int a = 0; a < 2; ++a)
#pragma unroll
        for (int b = 0; b < 2; ++b)
#pragma unroll
            for (int m = 0; m < 4; ++m)
#pragma unroll
                for (int n = 0; n < 2; ++n) acc[a][b][m][n] = (f32x4){0.f, 0.f, 0.f, 0.f};
    bf16x8 At[4][2], B0[2][2], B1[2][2];
    const char* cA = (const char*)g.A + (size_t)cur.pm * tstep; const char* cB = (const char*)g.Bt + (size_t)cur.pn * tstep;
    S.a_ready(cur);
    if constexpr (SP2) {
        PG8_STAGE(PG8_SB(0, 0), cB, voffB); PG8_STAGE(PG8_SB(0, 1), cB + hstep, voffB); PG8_STAGE(PG8_SA(0, 0), cA, voffA); PG8_STAGE(PG8_SA(0, 1), cA + hstep, voffA);
        if (wr == 1) PG8_BAR;
        PG8_WAIT_V(2); PG8_BAR;
        PG8_STAGE(PG8_SB(1, 0), cB + kstep, voffB); PG8_STAGE(PG8_SA(1, 0), cA + kstep, voffA); PG8_STAGE(PG8_SB(1, 1), cB + hstep + kstep, voffB);
        PG8_WAIT_V(6); PG8_BAR;
    } else {
        PG8_STAGE(PG8_SB(0, 0), cB, voffB); PG8_STAGE(PG8_SA(0, 0), cA, voffA); PG8_STAGE(PG8_SB(0, 1), cB + hstep, voffB); PG8_STAGE(PG8_SA(0, 1), cA + hstep, voffA);
        if (wr == 1) PG8_BAR;
        PG8_WAIT_V(4); PG8_BAR;
        PG8_STAGE(PG8_SB(1, 0), cB + kstep, voffB); PG8_STAGE(PG8_SA(1, 0), cA + kstep, voffA); PG8_STAGE(PG8_SB(1, 1), cB + hstep + kstep, voffB);
        PG8_WAIT_V(6); PG8_BAR;
    }
    for (;;) {
        const bool has_next = S.next(ui + 1, nxt);
        const char* nA = has_next ? (const char*)g.A + (size_t)nxt.pm * tstep : cA; const char* nB = has_next ? (const char*)g.Bt + (size_t)nxt.pn * tstep : cB;
        for (int t = 0; t < nt; t += 2) {
            const bool last = (t == nt - 2);
            const char* a1 = cA + (size_t)(t + 1) * kstep;
            const char* a2 = last ? nA : cA + (size_t)(t + 2) * kstep; const char* b2 = last ? nB : cB + (size_t)(t + 2) * kstep;
            const char* a3 = a2 + kstep; const char* b3 = b2 + kstep;
            if (last && has_next) S.a_ready(nxt);
            if constexpr (SP2) {
            PG8_LDB(B0, 0, 0); PG8_LDB(B1, 0, 1); PG8_SCHED; PG8_LDA(At, 0, 0); PG8_STAGE(PG8_SA(1, 1), a1 + hstep, voffA);
            PG8_WAIT_V(8); PG8_WAIT_L(0); PG8_BAR; PG8_MMA(0, 0, At, B0); PG8_MMA(0, 1, At, B1); PG8_BAR; PG8_SCHED;
            PG8_LDA(At, 0, 1); PG8_STAGE(PG8_SB(0, 0), b2, voffB); PG8_STAGE(PG8_SB(0, 1), b2 + hstep, voffB); PG8_STAGE(PG8_SA(0, 0), a2, voffA);
            PG8_WAIT_V(8); PG8_WAIT_L(0); PG8_BAR; PG8_MMA(1, 0, At, B0); PG8_MMA(1, 1, At, B1); PG8_BAR; PG8_SCHED;
            PG8_LDB(B0, 1, 0); PG8_LDB(B1, 1, 1); PG8_SCHED; PG8_LDA(At, 1, 0); PG8_STAGE(PG8_SA(0, 1), a2 + hstep, voffA);
            PG8_WAIT_V(8); PG8_WAIT_L(0); PG8_BAR; PG8_MMA(0, 0, At, B0); PG8_MMA(0, 1, At, B1); PG8_BAR; PG8_SCHED;
            PG8_LDA(At, 1, 1); PG8_STAGE(PG8_SB(1, 0), b3, voffB); PG8_STAGE(PG8_SB(1, 1), b3 + hstep, voffB); PG8_STAGE(PG8_SA(1, 0), a3, voffA);
            PG8_WAIT_V(8); PG8_WAIT_L(0); PG8_BAR; PG8_MMA(1, 0, At, B0); PG8_MMA(1, 1, At, B1); PG8_BAR; PG8_SCHED;
            } else {
            PG8_LDB(B0, 0, 0); PG8_SCHED; PG8_LDA(At, 0, 0); PG8_STAGE(PG8_SA(1, 1), a1 + hstep, voffA);
            PG8_WAIT_L(8); PG8_BAR; PG8_WAIT_L(0); PG8_MMA(0, 0, At, B0); PG8_BAR; PG8_SCHED;
            PG8_LDB(B1, 0, 1); PG8_STAGE(PG8_SB(0, 0), b2, voffB);
            PG8_BAR; PG8_WAIT_L(0); PG8_MMA(0, 1, At, B1); PG8_BAR;
            PG8_LDA(At, 0, 1); PG8_STAGE(PG8_SA(0, 0), a2, voffA);
            PG8_BAR; PG8_WAIT_L(0); PG8_MMA(1, 0, At, B0); PG8_BAR; PG8_SCHED;
            PG8_STAGE(PG8_SB(0, 1), b2 + hstep, voffB);
            PG8_WAIT_V(6); PG8_BAR; PG8_MMA(1, 1, At, B1); PG8_BAR;
            PG8_LDB(B0, 1, 0); PG8_SCHED; PG8_LDA(At, 1, 0); PG8_STAGE(PG8_SA(0, 1), a2 + hstep, voffA);
            PG8_WAIT_L(8); PG8_BAR; PG8_WAIT_L(0); PG8_MMA(0, 0, At, B0); PG8_BAR; PG8_SCHED;
            PG8_LDB(B1, 1, 1); PG8_STAGE(PG8_SB(1, 0), b3, voffB);
            PG8_BAR; PG8_WAIT_L(0); PG8_MMA(0, 1, At, B1); PG8_BAR;
            PG8_LDA(At, 1, 1); PG8_STAGE(PG8_SA(1, 0), a3, voffA);
            PG8_BAR; PG8_WAIT_L(0); PG8_MMA(1, 0, At, B0); PG8_BAR; PG8_SCHED;
            PG8_STAGE(PG8_SB(1, 1), b3 + hstep, voffB);
            PG8_WAIT_V(6); PG8_BAR; PG8_MMA(1, 1, At, B1); PG8_BAR;
            }
        }
        if constexpr (ALIGN_EPI) { if (wr == 0) PG8_BAR; }
        if constexpr (!Epi::AFTER_DRAIN) { E(acc, cur, wr, wc, fr, fq); S.done(cur); }
        if (!has_next) break;
#pragma unroll
        for (int a = 0; a < 2; ++a)
#pragma unroll
            for (int b = 0; b < 2; ++b)
#pragma unroll
                for (int m = 0; m < 4; ++m)
#pragma unroll
                    for (int n = 0; n < 2; ++n) acc[a][b][m][n] = (f32x4){0.f, 0.f, 0.f, 0.f};
        cur = nxt; cA = nA; cB = nB; ++ui;
        if constexpr (ALIGN_EPI) { if (wr == 1) PG8_BAR; }
    }
    PG8_WAIT_V(0);
    if constexpr (!ALIGN_EPI) { if (wr == 0) PG8_BAR; }
    PG8_BAR;
    if constexpr (Epi::AFTER_DRAIN) { E.fused(acc, cur, wr, wc, fr, fq, lds, wid, lane); S.done(cur); }
#undef PG8_SA
#undef PG8_SB
#undef PG8_STAGE
#undef PG8_LDA
#undef PG8_LDB
#undef PG8_MMA
#undef PG8_WAIT_V
#undef PG8_WAIT_L
#undef PG8_BAR
#undef PG8_SCHED
}
}
#define LAS __attribute__((address_space(3)))
typedef unsigned short bf16;
typedef _Float16 f16;
typedef float f32x4 __attribute__((ext_vector_type(4)));
typedef short bf16x8 __attribute__((ext_vector_type(8)));
typedef short s16x4 __attribute__((ext_vector_type(4)));
typedef unsigned u32x4 __attribute__((ext_vector_type(4)));
typedef unsigned u32x2 __attribute__((ext_vector_type(2)));
typedef _Float16 h2 __attribute__((ext_vector_type(2)));

#ifndef MK_ONE_LAUNCH
#define MK_ONE_LAUNCH 1
#endif

constexpr int NPROMPT = 8 * 4096, NSAMP = 32 * 64, M = NPROMPT + NSAMP;
constexpr int DM = 1024, SHW = 3328, DFF = 2816;
constexpr size_t MiB = 1u << 20;
constexpr size_t U = (size_t)M * 1024 * 2;
constexpr size_t WS_WIN = 1 * MiB;
constexpr size_t WS_WA = WS_WIN + (size_t)7424 * 1024 * 2;
constexpr size_t WS_WB = WS_WA + (size_t)1024 * 1024 * 2;
constexpr size_t WS_WO = WS_WB + (size_t)1024 * 1024 * 2;
constexpr size_t WS_GU = WS_WO + (size_t)1024 * 1024 * 2;
constexpr size_t WS_WD = WS_GU + (size_t)5632 * 1024 * 2;
constexpr size_t WS_LORA = WS_WD + (size_t)1024 * 2816 * 2;
constexpr size_t WS_WSP = WS_LORA + (size_t)3072 * 256 * 2;
constexpr size_t WS_R0 = 40 * MiB;
static_assert(WS_WSP + 8 * 128 * 128 * 2 <= WS_R0, "weights fit below R0");
constexpr size_t WS_XN = WS_R0;
constexpr size_t WS_WL = WS_R0;
constexpr size_t WS_PS = WS_R0 + U;
constexpr size_t WS_AR = WS_R0 + U * 17 / 4;
constexpr size_t WS_G = WS_R0 + U * 21 / 4;
constexpr size_t WS_LX = WS_R0 + U * 25 / 4;
constexpr size_t WS_END = WS_R0 + U * 26 / 4;
constexpr size_t WS_XN2 = WS_R0;
constexpr size_t WS_P4 = WS_R0 + U;
constexpr size_t WS_OA = WS_G;
constexpr size_t WS_OB = WS_R0;
constexpr size_t WS_MM = WS_R0 + U;
constexpr size_t WS_MO = WS_R0 + 2 * U;
constexpr size_t WS_F = WS_R0;
constexpr size_t WS_H = WS_R0 + U;
constexpr size_t WS_F2 = WS_R0 + 4 * U;
constexpr size_t OUT_Y = 0;
constexpr size_t OUT_SHIFT_P = (size_t)M * 1024;
constexpr size_t OUT_WKV_P = OUT_SHIFT_P + 8 * 3328;
constexpr size_t OUT_SHIFT_S = OUT_WKV_P + (size_t)8 * 16 * 4096;
constexpr size_t OUT_WKV_S = OUT_SHIFT_S + 32 * 3328;
constexpr size_t OUT_VS = OUT_WKV_S + (size_t)32 * 16 * 4096;
constexpr size_t OUT_END = OUT_VS + (size_t)32 * 64 * 1024;
static_assert(OUT_END == 40503296, "output size");

constexpr int LDS_BYTES = 147456;
constexpr int NPHASE = 15;

struct Args { const float* in[30]; float* out; unsigned char* ws; int ph_lo, ph_hi; };

__device__ __forceinline__ float bf_lo(unsigned u) { return __uint_as_float(u << 16); }
__device__ __forceinline__ float bf_hi(unsigned u) { return __uint_as_float(u & 0xffff0000u); }
__device__ __forceinline__ f32x4 dec4bf(u32x2 u) { return (f32x4){bf_lo(u.x), bf_hi(u.x), bf_lo(u.y), bf_hi(u.y)}; }
__device__ __forceinline__ unsigned pkbf(float lo, float hi) { return pg8::cvt_pk_bf16(lo, hi); }
__device__ __forceinline__ u32x2 pk4bf(f32x4 v) { u32x2 r; r.x = pkbf(v[0], v[1]); r.y = pkbf(v[2], v[3]); return r; }
__device__ __forceinline__ unsigned pkh(float lo, float hi) { h2 h; h.x = (f16)lo; h.y = (f16)hi; return __builtin_bit_cast(unsigned, h); }
__device__ __forceinline__ u32x2 pk4h(f32x4 v) { u32x2 r; r.x = pkh(v[0], v[1]); r.y = pkh(v[2], v[3]); return r; }
__device__ __forceinline__ h2 as_h2(unsigned u) { return __builtin_bit_cast(h2, u); }
__device__ __forceinline__ f32x4 dec4h(u32x2 u) { const h2 a = as_h2(u.x), b = as_h2(u.y); return (f32x4){(float)a.x, (float)a.y, (float)b.x, (float)b.y}; }
__device__ __forceinline__ float sigm(float x) { return __builtin_amdgcn_rcpf(1.f + __expf(-x)); }
__device__ __forceinline__ float wave_sum(float v) {
#pragma unroll
    for (int o = 1; o < 64; o <<= 1) v += __shfl_xor(v, o);
    return v;
}
template <int CTRL> __device__ __forceinline__ float dppf(float x) { return __int_as_float(__builtin_amdgcn_update_dpp(0, __float_as_int(x), CTRL, 0xF, 0xF, false)); }
__device__ __forceinline__ float row_sum16(float x) { x += dppf<0x128>(x); x += dppf<0x124>(x); x += dppf<0x122>(x); x += dppf<0x121>(x); return x; }
__device__ __forceinline__ float quad_sum(float x) { x += dppf<0xB1>(x); x += dppf<0x4E>(x); return x; }
__device__ __forceinline__ const float* xrow_ptr(const Args& a, int m) { return m < NPROMPT ? a.in[0] + (size_t)m * 1024 : a.in[1] + (size_t)(m - NPROMPT) * 1024; }

template <class F> struct Epi8 {
    static constexpr bool PERM = true, AFTER_DRAIN = false; F f;
    __device__ __forceinline__ void operator()(const f32x4 (&acc)[2][2][4][2], const pg8::Unit& u, int wr, int wc, int fr, int fq) const {
        const int row0 = u.pm * 256 + wr * 64 + fr, col0 = u.pn * 256 + wc * 32 + 8 * fq;
#pragma unroll
        for (int ai = 0; ai < 2; ++ai)
#pragma unroll
            for (int m = 0; m < 4; ++m)
#pragma unroll
                for (int bj = 0; bj < 2; ++bj) f(row0 + ai * 128 + m * 16, col0 + bj * 128, acc[ai][bj][m][0], acc[ai][bj][m][1]);
    }
};
template <class F> struct Epi4 {
    static constexpr bool PERM = false, AFTER_DRAIN = false; F f;
    __device__ __forceinline__ void operator()(const f32x4 (&acc)[2][2][4][2], const pg8::Unit& u, int wr, int wc, int fr, int fq) const {
        const int row0 = u.pm * 256 + wr * 64 + fr, col0 = u.pn * 256 + wc * 32 + 4 * fq;
#pragma unroll
        for (int ai = 0; ai < 2; ++ai)
#pragma unroll
            for (int m = 0; m < 4; ++m)
#pragma unroll
                for (int bj = 0; bj < 2; ++bj)
#pragma unroll
                    for (int n = 0; n < 2; ++n) f(row0 + ai * 128 + m * 16, col0 + bj * 128 + n * 16, acc[ai][bj][m][n]);
    }
};
__device__ __forceinline__ u32x4 pk8bf(f32x4 a, f32x4 b) { u32x4 w; w.x = pkbf(a[0], a[1]); w.y = pkbf(a[2], a[3]); w.z = pkbf(b[0], b[1]); w.w = pkbf(b[2], b[3]); return w; }
__device__ __forceinline__ u32x4 pk8h(f32x4 a, f32x4 b) { u32x4 w; w.x = pkh(a[0], a[1]); w.y = pkh(a[2], a[3]); w.z = pkh(b[0], b[1]); w.w = pkh(b[2], b[3]); return w; }
__device__ __forceinline__ void dec8bf(u32x4 w, f32x4& a, f32x4& b) { a = (f32x4){bf_lo(w.x), bf_hi(w.x), bf_lo(w.y), bf_hi(w.y)}; b = (f32x4){bf_lo(w.z), bf_hi(w.z), bf_lo(w.w), bf_hi(w.w)}; }

struct FStoreBf16 { bf16* O; int ldc;
    __device__ __forceinline__ void operator()(int r, int c, f32x4 v0, f32x4 v1) const { *(u32x4*)(O + (size_t)r * ldc + c) = pk8bf(v0, v1); } };
struct FStoreF32 { float* O; int ldc;
    __device__ __forceinline__ void operator()(int r, int c, f32x4 v) const { *(f32x4*)(O + (size_t)r * ldc + c) = v; } };
struct FLora { f16* WL; f16* AR; f16* G; const float* w0; const float* a0;
    __device__ __forceinline__ void operator()(int r, int c, f32x4 v0, f32x4 v1) const {
        const int t = c >> 10, cc = c & 1023;
        if (t == 0) { const f32x4 b0 = *(const f32x4*)(w0 + cc), b1 = *(const f32x4*)(w0 + cc + 4);
#pragma unroll
            for (int i = 0; i < 4; ++i) { v0[i] = __expf(-0.60653066f * sigm(v0[i] + b0[i])); v1[i] = __expf(-0.60653066f * sigm(v1[i] + b1[i])); }
            *(u32x4*)(WL + (size_t)r * 1024 + cc) = pk8h(v0, v1); }
        else if (t == 1) { const f32x4 b0 = *(const f32x4*)(a0 + cc), b1 = *(const f32x4*)(a0 + cc + 4);
#pragma unroll
            for (int i = 0; i < 4; ++i) { v0[i] = sigm(v0[i] + b0[i]); v1[i] = sigm(v1[i] + b1[i]); }
            *(u32x4*)(AR + (size_t)r * 1024 + cc) = pk8h(v0, v1); }
        else *(u32x4*)(G + (size_t)r * 1024 + cc) = pk8h(v0, v1);
    } };
struct FP1b { bf16* base;
    __device__ __forceinline__ void operator()(int r, int c, f32x4 v0, f32x4 v1) const {
        const int t = c >> 10, cc = c & 1023;
        if (t >= 2) {
#pragma unroll
            for (int i = 0; i < 4; ++i) { v0[i] = sigm(v0[i]); v1[i] = sigm(v1[i]); } }
        *(u32x4*)(base + (size_t)t * (U / 2) + (size_t)r * 1024 + cc) = pk8bf(v0, v1);
    } };
struct FGateA { const bf16* GA; bf16* M1;
    __device__ __forceinline__ void operator()(int r, int c, f32x4 v0, f32x4 v1) const {
        const size_t o = (size_t)r * 1024 + c; f32x4 g0, g1; dec8bf(*(const u32x4*)(GA + o), g0, g1);
        *(u32x4*)(M1 + o) = pk8bf(v0 * g0, v1 * g1);
    } };
struct FGateB { const bf16* GB; bf16* MMp;
    __device__ __forceinline__ void operator()(int r, int c, f32x4 v0, f32x4 v1) const {
        const size_t o = (size_t)r * 1024 + c; f32x4 g0, g1, m0, m1; dec8bf(*(const u32x4*)(GB + o), g0, g1); dec8bf(*(const u32x4*)(MMp + o), m0, m1);
        *(u32x4*)(MMp + o) = pk8bf(m0 + v0 * g0, m1 + v1 * g1);
    } };
struct EpiGU {
    static constexpr bool PERM = true, AFTER_DRAIN = false; bf16* H;
    __device__ __forceinline__ void operator()(const f32x4 (&acc)[2][2][4][2], const pg8::Unit& u, int wr, int wc, int fr, int fq) const {
        const int row0 = u.pm * 256 + wr * 64 + fr, h0 = u.pn * 128 + wc * 32 + 8 * fq;
#pragma unroll
        for (int ai = 0; ai < 2; ++ai)
#pragma unroll
            for (int m = 0; m < 4; ++m) {
                f32x4 o0, o1;
#pragma unroll
                for (int i = 0; i < 4; ++i) { const float g0 = acc[ai][0][m][0][i], g1 = acc[ai][1][m][0][i];
                    o0[i] = g0 * sigm(g0) * acc[ai][0][m][1][i]; o1[i] = g1 * sigm(g1) * acc[ai][1][m][1][i]; }
                *(u32x4*)(H + (size_t)(row0 + ai * 128 + m * 16) * DFF + h0) = pk8bf(o0, o1);
            }
    }
};

#define PH_PROLOG const int tid = threadIdx.x, lane = tid & 63, wave = __builtin_amdgcn_readfirstlane(tid >> 6); const int G = gridDim.x, bid = blockIdx.x; const int gw = bid * 8 + wave, NGW = G * 8; (void)lane; (void)gw; (void)NGW; (void)lds;

__device__ __forceinline__ float conv_src(const Args& a, int mat, int R, int k) {
    switch (mat) {
    case 0: return a.in[5][(size_t)k * 7424 + R];
    case 1: return a.in[21][(size_t)k * 1024 + R];
    case 2: return a.in[22][(size_t)k * 1024 + R];
    case 3: return a.in[23][(size_t)k * 1024 + R];
    case 4: { const int cl = R & 255, pn = R >> 8, bj = (cl >> 7) & 1, wc = (cl >> 5) & 3, fq = (cl >> 3) & 3, n = (cl >> 2) & 1, e = cl & 3;
              const int hcol = 128 * pn + 32 * wc + 8 * fq + 4 * bj + e; return (n ? a.in[27] : a.in[26])[(size_t)k * DFF + hcol]; }
    case 5: return a.in[28][(size_t)k * 1024 + R];
    case 6: { if (R < 1024) return k < 64 ? a.in[8][k * 1024 + R] : 0.f;
              if (R < 2048) return (k >= 64 && k < 128) ? a.in[10][(k - 64) * 1024 + R - 1024] : 0.f;
              return k >= 128 ? a.in[11][(k - 128) * 1024 + R - 2048] : 0.f; }
    default: { const int t = R & 127; return k <= t ? a.in[19][(size_t)R * 128 + k] : 0.f; }
    }
}
__device__ __forceinline__ void rms_row_to_bf16(const float* xrow, const float* gain, bf16* orow, int lane) {
    f32x4 v[4]; float ss = 0.f;
#pragma unroll
    for (int j = 0; j < 4; ++j) { v[j] = ((const f32x4*)xrow)[lane + 64 * j]; ss += (v[j][0] * v[j][0] + v[j][1] * v[j][1]) + (v[j][2] * v[j][2] + v[j][3] * v[j][3]); }
    const float rs = rsqrtf(wave_sum(ss) * (1.f / 1024.f) + 1e-6f);
#pragma unroll
    for (int j = 0; j < 4; ++j) { const f32x4 g = ((const f32x4*)gain)[lane + 64 * j]; ((u32x2*)orow)[lane + 64 * j] = pk4bf(v[j] * rs * g); }
}
__device__ __forceinline__ void phase_p0(const Args& a, LAS unsigned char* lds) {
    PH_PROLOG
    constexpr int NIT[8] = {928 * 16, 128 * 16, 128 * 16, 128 * 16, 704 * 16, 128 * 44, 384 * 4, 128 * 2};
    constexpr int KD[8] = {1024, 1024, 1024, 1024, 1024, 2816, 256, 128};
    constexpr size_t DST[8] = {WS_WIN, WS_WA, WS_WB, WS_WO, WS_GU, WS_WD, WS_LORA, WS_WSP};
    constexpr int NITEMS = NIT[0] + NIT[1] + NIT[2] + NIT[3] + NIT[4] + NIT[5] + NIT[6] + NIT[7];
    for (int it = gw; it < NITEMS; it += NGW) {
        int r = it, mat = 0;
#pragma unroll
        for (int q = 0; q < 7; ++q) { if (mat == q && r >= NIT[q]) { r -= NIT[q]; mat = q + 1; } }
        int Kd = 1024; size_t dst = WS_WIN;
#pragma unroll
        for (int q = 0; q < 8; ++q) if (mat == q) { Kd = KD[q]; dst = DST[q]; }
        const int kbn = Kd >> 6, rb = r / kbn, kb = r - rb * kbn;
        const int R = rb * 8 + (lane >> 3), k0 = kb * 64 + (lane & 7) * 8;
        float s[8];
#pragma unroll
        for (int j = 0; j < 8; ++j) s[j] = conv_src(a, mat, R, k0 + j);
        u32x4 w; w.x = pkbf(s[0], s[1]); w.y = pkbf(s[2], s[3]); w.z = pkbf(s[4], s[5]); w.w = pkbf(s[6], s[7]);
        *(u32x4*)(a.ws + dst + ((size_t)R * Kd + k0) * 2) = w;
    }
    bf16* XN = (bf16*)(a.ws + WS_XN);
    for (int m = gw; m < M; m += NGW) rms_row_to_bf16(xrow_ptr(a, m), a.in[4], XN + (size_t)m * 1024, lane);
}

__device__ __forceinline__ void phase_p2a(const Args& a, LAS unsigned char* lds) {
    PH_PROLOG
    const bf16* PS = (const bf16*)(a.ws + WS_PS); bf16* LX = (bf16*)(a.ws + WS_LX);
    const f32x4 mu = *(const f32x4*)(a.in[6] + 3072 + 4 * lane);
    for (int m = gw; m < M; m += NGW) {
        const bool samp = m >= NPROMPT; const int t = samp ? ((m - NPROMPT) & 63) : (m & 4095);
        const f32x4 p = dec4bf(*(const u32x2*)(PS + (size_t)m * SHW + 3072 + 4 * lane));
        f32x4 pp = (f32x4){0.f, 0.f, 0.f, 0.f};
        if (t > 0) pp = dec4bf(*(const u32x2*)(PS + (size_t)(m - 1) * SHW + 3072 + 4 * lane));
        else if (samp) pp = *(const f32x4*)(a.in[2] + (size_t)((m - NPROMPT) >> 6) * SHW + 3072 + 4 * lane);
        f32x4 x = p + (pp - p) * mu;
        if (lane < 16) {
#pragma unroll
            for (int i = 0; i < 4; ++i) x[i] = 1.f - 2.f * __builtin_amdgcn_rcpf(__expf(2.f * x[i]) + 1.f); }
        else if (lane >= 32) {
#pragma unroll
            for (int i = 0; i < 4; ++i) x[i] = sigm(x[i]); }
        *(u32x2*)(LX + (size_t)m * 256 + 4 * lane) = pk4bf(x);
    }
    if (gw < 40) {
        const int row = gw < 8 ? gw * 4096 + 4095 : NPROMPT + (gw - 8) * 64 + 63;
        float* dst = a.out + (gw < 8 ? OUT_SHIFT_P + (size_t)gw * SHW : OUT_SHIFT_S + (size_t)(gw - 8) * SHW);
        for (int c = lane; c < SHW; c += 64) dst[c] = bf_lo((unsigned)PS[(size_t)row * SHW + c]);
    }
}

constexpr int SC_STEPS = 32, SC_PK = SC_STEPS * 16 * 80, SC_BUF = SC_PK + SC_STEPS * 64 * 8;
struct ScanK { f32x4 mu_r, mu_k, mu_v, kk, ka; };
__device__ __forceinline__ void scan_stage_write(LAS unsigned char* buf, int s_st, int kg_st, const ScanK& K, f32x4 r, f32x4 k, f32x4 v, f32x4 pr, f32x4 pk, f32x4 pv, u32x2 wl, u32x2 ar) {
    const f32x4 xr = r + (pr - r) * K.mu_r, xk = k + (pk - k) * K.mu_k, xv = v + (pv - v) * K.mu_v;
    const f32x4 ar4 = dec4h(ar);
    const f32x4 kkr = xk * K.kk;
    float ssq = (kkr[0] * kkr[0] + kkr[1] * kkr[1]) + (kkr[2] * kkr[2] + kkr[3] * kkr[3]);
    ssq = row_sum16(ssq);
    const float inv = 1.f / fmaxf(sqrtf(ssq), 1e-12f);
    const f32x4 kkn = kkr * inv, bb = kkn * ar4, km = xk * (1.f + (ar4 - 1.f) * K.ka);
    LAS unsigned char* p = buf + (s_st * 16 + kg_st) * 80;
    *(LAS f32x4*)p = dec4h(wl); *(LAS f32x4*)(p + 16) = -kkn; *(LAS f32x4*)(p + 32) = bb; *(LAS f32x4*)(p + 48) = km; *(LAS f32x4*)(p + 64) = xr;
    LAS unsigned char* pvd = buf + SC_PK + (s_st * 64 + 4 * kg_st) * 8;
    *(LAS f32x4*)pvd = (f32x4){xv[0], xv[0], xv[1], xv[1]}; *(LAS f32x4*)(pvd + 16) = (f32x4){xv[2], xv[2], xv[3], xv[3]};
}
typedef float f32x2 __attribute__((ext_vector_type(2)));
struct SOps { f32x4 w, a, b, k, r; f32x2 vv; };
__device__ __forceinline__ void sc_load(SOps& o, const LAS unsigned char* buf, int kg, int v, int s) {
    const LAS unsigned char* p = buf + (s * 16 + kg) * 80;
    o.w = *(const LAS f32x4*)p; o.a = *(const LAS f32x4*)(p + 16); o.b = *(const LAS f32x4*)(p + 32); o.k = *(const LAS f32x4*)(p + 48); o.r = *(const LAS f32x4*)(p + 64);
    o.vv = *(const LAS f32x2*)(buf + SC_PK + (s * 64 + v) * 8);
}
#define LO2(q) __builtin_shufflevector(q, q, 0, 1)
#define HI2(q) __builtin_shufflevector(q, q, 2, 3)
#define DPPR(n) " row_ror:" #n " row_mask:0xf bank_mask:0xf\n\t"
__device__ __forceinline__ void dpp2_sum16(float& y, float& p) {
    asm volatile("s_nop 1\n\t"
        "v_add_f32_dpp %0, %0, %0" DPPR(8) "v_add_f32_dpp %1, %1, %1" DPPR(8) "s_nop 0\n\t"
        "v_add_f32_dpp %0, %0, %0" DPPR(4) "v_add_f32_dpp %1, %1, %1" DPPR(4) "s_nop 0\n\t"
        "v_add_f32_dpp %0, %0, %0" DPPR(2) "v_add_f32_dpp %1, %1, %1" DPPR(2) "s_nop 0\n\t"
        "v_add_f32_dpp %0, %0, %0" DPPR(1) "v_add_f32_dpp %1, %1, %1" DPPR(1)
        : "+v"(y), "+v"(p));
}
__device__ __forceinline__ float sc_step(f32x2& S01, f32x2& S23, const SOps& o, f32x2 rp01, f32x2 rp23) {
    f32x2 yy = S01 * rp01; yy = S23 * rp23 + yy;
    f32x2 pp = S01 * LO2(o.a); pp = S23 * HI2(o.a) + pp;
    float y = yy.x + yy.y, p = pp.x + pp.y;
    f32x2 t01 = o.vv * LO2(o.k), t23 = o.vv * HI2(o.k);
    dpp2_sum16(y, p);
    const f32x2 sa2 = (f32x2){p, p};
    t01 = sa2 * LO2(o.b) + t01; t23 = sa2 * HI2(o.b) + t23;
    S01 = S01 * LO2(o.w) + t01; S23 = S23 * HI2(o.w) + t23;
    return y;
}
__device__ __forceinline__ float sc_flush(f32x2 S01, f32x2 S23, f32x2 rp01, f32x2 rp23) {
    f32x2 yy = S01 * rp01; yy = S23 * rp23 + yy;
    return row_sum16(yy.x + yy.y);
}
__device__ __forceinline__ void phase_scan(const Args& a, LAS unsigned char* lds) {
    PH_PROLOG
    const bf16* PS = (const bf16*)(a.ws + WS_PS); const f16* WL = (const f16*)((const unsigned char*)a.out + U); const f16* AR = (const f16*)(a.ws + WS_AR);
    bf16* Y = (bf16*)a.out;
    const int s_st = tid >> 4, kg_st = tid & 15;
    const int rw = lane >> 4, kg = lane & 15;
    for (int task = bid; task < 1280; task += G) {
        const bool samp = task >= 256; const int q = samp ? task - 256 : task;
        const int b = q >> 5, h = (q >> 1) & 15, half = q & 1;
        const int m0 = samp ? NPROMPT + b * 64 : b * 4096, T = samp ? 64 : 4096, nch = T / SC_STEPS;
        const int v = half * 32 + wave * 4 + rw;
        f32x4 S = (f32x4){0.f, 0.f, 0.f, 0.f};
        if (samp) S = *(const f32x4*)(a.in[3] + ((size_t)((b * 16 + h) * 64 + v)) * 64 + 4 * kg);
        const int c = h * 64 + 4 * kg_st;
        ScanK K; K.mu_r = *(const f32x4*)(a.in[6] + c); K.mu_k = *(const f32x4*)(a.in[6] + 1024 + c); K.mu_v = *(const f32x4*)(a.in[6] + 2048 + c);
        K.kk = *(const f32x4*)(a.in[12] + c); K.ka = *(const f32x4*)(a.in[13] + c);
        {
            const size_t m = (size_t)m0 + s_st; const bf16* base = PS + m * SHW + c;
            const f32x4 r = dec4bf(*(const u32x2*)base), k = dec4bf(*(const u32x2*)(base + 1024)), vv = dec4bf(*(const u32x2*)(base + 2048));
            f32x4 pr, pk, pv;
            if (s_st > 0) { pr = dec4bf(*(const u32x2*)(base - SHW)); pk = dec4bf(*(const u32x2*)(base - SHW + 1024)); pv = dec4bf(*(const u32x2*)(base - SHW + 2048)); }
            else if (samp) { const float* ss = a.in[2] + (size_t)b * SHW + c; pr = *(const f32x4*)ss; pk = *(const f32x4*)(ss + 1024); pv = *(const f32x4*)(ss + 2048); }
            else { pr = (f32x4){0.f, 0.f, 0.f, 0.f}; pk = pr; pv = pr; }
            const u32x2 wl = *(const u32x2*)(WL + m * 1024 + c), ar = *(const u32x2*)(AR + m * 1024 + c);
            scan_stage_write(lds, s_st, kg_st, K, r, k, vv, pr, pk, pv, wl, ar);
        }
        __syncthreads();
        float ykeep = 0.f;
        for (int ch = 0; ch < nch; ++ch) {
            const bool more = ch + 1 < nch;
            u32x2 cr, ck, cv, qr, qk, qv, wl, ar;
            cr = ck = cv = qr = qk = qv = wl = ar = (u32x2){0u, 0u};
            if (more) {
                const size_t m = (size_t)m0 + (ch + 1) * SC_STEPS + s_st; const bf16* base = PS + m * SHW + c;
                cr = *(const u32x2*)base; ck = *(const u32x2*)(base + 1024); cv = *(const u32x2*)(base + 2048);
                qr = *(const u32x2*)(base - SHW); qk = *(const u32x2*)(base - SHW + 1024); qv = *(const u32x2*)(base - SHW + 2048);
                wl = *(const u32x2*)(WL + m * 1024 + c); ar = *(const u32x2*)(AR + m * 1024 + c);
            }
            LAS unsigned char* buf = lds + (ch & 1) * SC_BUF;
            const int t0 = ch * SC_STEPS;
            SOps o0, o1, o2, o3;
            sc_load(o0, buf, kg, v, 0); sc_load(o1, buf, kg, v, 1); sc_load(o2, buf, kg, v, 2);
            __builtin_amdgcn_sched_barrier(0);
            f32x2 S01 = LO2(S), S23 = HI2(S);
            f32x2 rp01 = (f32x2){0.f, 0.f}, rp23 = rp01;
#define SC_ONE(o, ss) do { const float yp = sc_step(S01, S23, o, rp01, rp23); rp01 = LO2(o.r); rp23 = HI2(o.r); \
                if ((ss) > 0) { ykeep = ((((ss) - 1) & 15) == kg) ? yp : ykeep; if ((((ss) - 1) & 15) == 15) Y[(size_t)(m0 + t0 + (ss) - 16 + kg) * 1024 + h * 64 + v] = (bf16)pkbf(ykeep, 0.f); } } while (0)
#pragma unroll
            for (int s = 0; s < SC_STEPS; s += 4) {
                sc_load(o3, buf, kg, v, s + 3); __builtin_amdgcn_sched_barrier(0);
                SC_ONE(o0, s);
                if (s + 4 < SC_STEPS) sc_load(o0, buf, kg, v, s + 4);
                __builtin_amdgcn_sched_barrier(0);
                SC_ONE(o1, s + 1);
                if (s + 5 < SC_STEPS) sc_load(o1, buf, kg, v, s + 5);
                __builtin_amdgcn_sched_barrier(0);
                SC_ONE(o2, s + 2);
                if (s + 6 < SC_STEPS) sc_load(o2, buf, kg, v, s + 6);
                __builtin_amdgcn_sched_barrier(0);
                SC_ONE(o3, s + 3);
            }
#undef SC_ONE
            { const float yl = sc_flush(S01, S23, rp01, rp23); ykeep = (15 == kg) ? yl : ykeep; Y[(size_t)(m0 + t0 + 16 + kg) * 1024 + h * 64 + v] = (bf16)pkbf(ykeep, 0.f); }
            S = (f32x4){S01.x, S01.y, S23.x, S23.y};
            if (more) {
                scan_stage_write(lds + ((ch + 1) & 1) * SC_BUF, s_st, kg_st, K, dec4bf(cr), dec4bf(ck), dec4bf(cv), dec4bf(qr), dec4bf(qk), dec4bf(qv), wl, ar);
            }
            __syncthreads();
        }
        float* So = a.out + (samp ? OUT_WKV_S : OUT_WKV_P) + ((size_t)((b * 16 + h) * 64 + v)) * 64 + 4 * kg;
        *(f32x4*)So = S;
    }
}

__device__ __forceinline__ void ld16bf(const bf16* p, float (&o)[16]) {
    const u32x4 w0 = *(const u32x4*)p, w1 = *(const u32x4*)(p + 8); f32x4 a, b, c, d; dec8bf(w0, a, b); dec8bf(w1, c, d);
#pragma unroll
    for (int i = 0; i < 4; ++i) { o[i] = a[i]; o[4 + i] = b[i]; o[8 + i] = c[i]; o[12 + i] = d[i]; }
}
__device__ __forceinline__ void ld16h(const f16* p, float (&o)[16]) {
    const u32x4 w0 = *(const u32x4*)p, w1 = *(const u32x4*)(p + 8);
    const f32x4 a = dec4h((u32x2){w0.x, w0.y}), b = dec4h((u32x2){w0.z, w0.w}), c = dec4h((u32x2){w1.x, w1.y}), d = dec4h((u32x2){w1.z, w1.w});
#pragma unroll
    for (int i = 0; i < 4; ++i) { o[i] = a[i]; o[4 + i] = b[i]; o[8 + i] = c[i]; o[12 + i] = d[i]; }
}
__device__ __forceinline__ void ld16f(const float* p, float (&o)[16]) {
#pragma unroll
    for (int j = 0; j < 4; ++j) { const f32x4 x = ((const f32x4*)p)[j];
#pragma unroll
        for (int i = 0; i < 4; ++i) o[4 * j + i] = x[i]; }
}
__device__ __forceinline__ void tokshift16(float (&x)[16], const bf16* prevp, bool has_prev, bool samp, const float* ssrc, const float* mu) {
    float tmp[16], cst[16];
    if (has_prev) ld16bf(prevp, tmp);
    else if (samp) ld16f(ssrc, tmp);
    else {
#pragma unroll
        for (int i = 0; i < 16; ++i) tmp[i] = 0.f; }
    ld16f(mu, cst);
#pragma unroll
    for (int i = 0; i < 16; ++i) x[i] = x[i] + (tmp[i] - x[i]) * cst[i];
}
__device__ __forceinline__ float oct_sum(float x) { x += dppf<0xB1>(x); x += dppf<0x4E>(x); x += dppf<0x141>(x); return x; }
__device__ __forceinline__ void ld8f(const float* p, float (&o)[8]) { const f32x4 a = *(const f32x4*)p, b = *(const f32x4*)(p + 4);
#pragma unroll
    for (int i = 0; i < 4; ++i) { o[i] = a[i]; o[4 + i] = b[i]; } }
__device__ __forceinline__ void ld8bf(const bf16* p, float (&o)[8]) { f32x4 a, b; dec8bf(*(const u32x4*)p, a, b);
#pragma unroll
    for (int i = 0; i < 4; ++i) { o[i] = a[i]; o[4 + i] = b[i]; } }
__device__ __forceinline__ void ld8h(const f16* p, float (&o)[8]) { const u32x4 w = *(const u32x4*)p; const f32x4 a = dec4h((u32x2){w.x, w.y}), b = dec4h((u32x2){w.z, w.w});
#pragma unroll
    for (int i = 0; i < 4; ++i) { o[i] = a[i]; o[4 + i] = b[i]; } }
__device__ __forceinline__ void phase_gn(const Args& a, LAS unsigned char* lds) {
    PH_PROLOG
    const bf16* PS = (const bf16*)(a.ws + WS_PS); const f16* AR = (const f16*)(a.ws + WS_AR); f16* Gp = (f16*)(a.ws + WS_G);
    const bf16* Y = (const bf16*)a.out;
    const int h = gw & 15, c = h * 64 + 8 * (lane & 7), r8 = lane >> 3;
    float mu_r[8], mu_k[8], mu_v[8], ka[8], rkc[8], gg[8], gb[8];
    ld8f(a.in[6] + c, mu_r); ld8f(a.in[6] + 1024 + c, mu_k); ld8f(a.in[6] + 2048 + c, mu_v); ld8f(a.in[13] + c, ka); ld8f(a.in[14] + c, rkc); ld8f(a.in[15] + c, gg); ld8f(a.in[16] + c, gb);
    for (int rg = gw >> 4; rg < M / 8; rg += NGW >> 4) {
        const int m = rg * 8 + r8; const bool samp = m >= NPROMPT; const int t = samp ? ((m - NPROMPT) & 63) : (m & 4095);
        const bf16* base = PS + (size_t)m * SHW + c;
        float xr[8], xk[8], xv[8], pr[8], pk[8], pv[8], ar[8], y[8], g[8];
        ld8bf(base, xr); ld8bf(base + 1024, xk); ld8bf(base + 2048, xv);
        if (t > 0) { ld8bf(base - SHW, pr); ld8bf(base - SHW + 1024, pk); ld8bf(base - SHW + 2048, pv); }
        else if (samp) { const float* ss = a.in[2] + (size_t)((m - NPROMPT) >> 6) * SHW + c; ld8f(ss, pr); ld8f(ss + 1024, pk); ld8f(ss + 2048, pv); }
        else {
#pragma unroll
            for (int i = 0; i < 8; ++i) { pr[i] = 0.f; pk[i] = 0.f; pv[i] = 0.f; } }
        ld8h(AR + (size_t)m * 1024 + c, ar); ld8bf(Y + (size_t)m * 1024 + c, y); ld8h(Gp + (size_t)m * 1024 + c, g);
        float rk = 0.f, s = 0.f;
#pragma unroll
        for (int i = 0; i < 8; ++i) {
            xr[i] = xr[i] + (pr[i] - xr[i]) * mu_r[i]; xk[i] = xk[i] + (pk[i] - xk[i]) * mu_k[i]; xv[i] = xv[i] + (pv[i] - xv[i]) * mu_v[i];
            xk[i] = xk[i] * (1.f + (ar[i] - 1.f) * ka[i]);
            rk += xr[i] * xk[i] * rkc[i]; s += y[i];
        }
        rk = oct_sum(rk);
        const float mean = oct_sum(s) * (1.f / 64.f); float q2 = 0.f;
#pragma unroll
        for (int i = 0; i < 8; ++i) { y[i] -= mean; q2 += y[i] * y[i]; }
        const float rstd = rsqrtf(oct_sum(q2) * (1.f / 64.f) + 64e-5f);
        float o[8];
#pragma unroll
        for (int i = 0; i < 8; ++i) o[i] = (y[i] * rstd * gg[i] + gb[i] + rk * xv[i]) * g[i];
        u32x4 w; w.x = pkbf(o[0], o[1]); w.y = pkbf(o[2], o[3]); w.z = pkbf(o[4], o[5]); w.w = pkbf(o[6], o[7]);
        *(u32x4*)((bf16*)Gp + (size_t)m * 1024 + c) = w;
    }
}

__device__ __forceinline__ int gm_swz(int row) { return (row & 3) | (((row >> 3) & 1) << 2); }
__device__ __forceinline__ void phase_gmlp(const Args& a, LAS unsigned char* lds) {
    PH_PROLOG
    const bf16* PU = (const bf16*)(a.ws + WS_P4); const bf16* PV = (const bf16*)(a.ws + WS_P4 + U); bf16* OB = (bf16*)(a.ws + WS_OB);
    const bf16* WSP = (const bf16*)(a.ws + WS_WSP);
    LAS float* stats = (LAS float*)lds;
    LAS unsigned char* img = lds + 4096;
    for (int unit = bid; unit < 272; unit += G) {
        const bool samp = unit >= 256; const int m0 = unit * 128;
        for (int i = 0; i < 16; ++i) {
            const int tk = wave * 16 + i; float x[16]; ld16bf(PV + (size_t)(m0 + tk) * 1024 + 16 * lane, x);
            float s = 0.f;
#pragma unroll
            for (int j = 0; j < 16; ++j) s += x[j];
            const float mean = wave_sum(s) * (1.f / 1024.f); float q2 = 0.f;
#pragma unroll
            for (int j = 0; j < 16; ++j) { x[j] -= mean; q2 += x[j] * x[j]; }
            const float rstd = rsqrtf(wave_sum(q2) * (1.f / 1024.f) + 1e-5f);
            if (lane == 0) { stats[2 * tk] = mean; stats[2 * tk + 1] = rstd; }
            if (samp) {
                float g[16], bb[16]; ld16f(a.in[17] + 16 * lane, g); ld16f(a.in[18] + 16 * lane, bb);
                float* o = a.out + OUT_VS + (size_t)(m0 + tk - NPROMPT) * 1024 + 16 * lane;
#pragma unroll
                for (int j = 0; j < 4; ++j) ((f32x4*)o)[j] = (f32x4){x[4 * j] * rstd * g[4 * j] + bb[4 * j], x[4 * j + 1] * rstd * g[4 * j + 1] + bb[4 * j + 1], x[4 * j + 2] * rstd * g[4 * j + 2] + bb[4 * j + 2], x[4 * j + 3] * rstd * g[4 * j + 3] + bb[4 * j + 3]};
            }
        }
        __syncthreads();
        const int trow_off = (samp && wave >= 4) ? 64 : 0, t0 = wave * 16;
        const int ks_lo = trow_off >> 5, ks_hi = (t0 + 15) >> 5;
        for (int g = 0; g < 8; ++g) {
#pragma unroll
            for (int i = 0; i < 4; ++i) {
                const int p = tid + 512 * i, row = p >> 4, c8 = p & 15, gc = g * 128 + 8 * c8;
                f32x4 x0, x1; dec8bf(*(const u32x4*)(PV + (size_t)(m0 + row) * 1024 + gc), x0, x1);
                const float mean = stats[2 * row], rstd = stats[2 * row + 1];
                const f32x4 g0 = *(const f32x4*)(a.in[17] + gc), g1 = *(const f32x4*)(a.in[17] + gc + 4), b0 = *(const f32x4*)(a.in[18] + gc), b1 = *(const f32x4*)(a.in[18] + gc + 4);
                x0 = (x0 - mean) * rstd * g0 + b0; x1 = (x1 - mean) * rstd * g1 + b1;
                *(LAS u32x4*)(img + row * 256 + (((c8 >> 1) ^ gm_swz(row)) << 5) + (c8 & 1) * 16) = pk8bf(x0, x1);
            }
            __syncthreads();
            f32x4 acc[8];
#pragma unroll
            for (int ct = 0; ct < 8; ++ct) acc[ct] = (f32x4){0.f, 0.f, 0.f, 0.f};
            for (int ks = ks_lo; ks <= ks_hi; ++ks) {
                const bf16x8 wf = *(const bf16x8*)(WSP + ((size_t)(g * 128 + t0 - trow_off + (lane & 15))) * 128 + 32 * ks - trow_off + 8 * (lane >> 4));
                const int row = 32 * ks + 8 * (lane >> 4) + ((lane & 15) >> 2);
                const int sw = gm_swz(row);
#pragma unroll
                for (int ct = 0; ct < 8; ++ct) {
                    LAS unsigned char* p = img + row * 256 + ((ct ^ sw) << 5) + (lane & 3) * 8;
                    const s16x4 lo = __builtin_amdgcn_ds_read_tr16_b64_v4i16((LAS s16x4*)p), hi = __builtin_amdgcn_ds_read_tr16_b64_v4i16((LAS s16x4*)(p + 1024));
                    bf16x8 vf; vf[0] = lo[0]; vf[1] = lo[1]; vf[2] = lo[2]; vf[3] = lo[3]; vf[4] = hi[0]; vf[5] = hi[1]; vf[6] = hi[2]; vf[7] = hi[3];
                    acc[ct] = __builtin_amdgcn_mfma_f32_16x16x32_bf16(vf, wf, acc[ct], 0, 0, 0);
                }
            }
            const int t = t0 + (lane & 15);
            const float bias = a.in[20][g * 128 + t - trow_off];
#pragma unroll
            for (int ct = 0; ct < 8; ++ct) {
                const size_t o = (size_t)(m0 + t) * 1024 + g * 128 + 16 * ct + 4 * (lane >> 4);
                const f32x4 pu = dec4bf(*(const u32x2*)(PU + o));
                *(u32x2*)(OB + o) = pk4bf(pu * (acc[ct] + bias));
            }
            __syncthreads();
        }
    }
}

__device__ __forceinline__ void phase_p5b(const Args& a, LAS unsigned char* lds) {
    PH_PROLOG
    const float* MO = (const float*)(a.ws + WS_MO); bf16* F = (bf16*)(a.ws + WS_F);
    for (int m = gw; m < M; m += NGW) {
        const float* xr = xrow_ptr(a, m); f32x4 v[4]; float ss = 0.f;
#pragma unroll
        for (int j = 0; j < 4; ++j) { v[j] = ((const f32x4*)(MO + (size_t)m * 1024))[lane + 64 * j]; ss += (v[j][0] * v[j][0] + v[j][1] * v[j][1]) + (v[j][2] * v[j][2] + v[j][3] * v[j][3]); }
        const float rs = rsqrtf(wave_sum(ss) * (1.f / 1024.f) + 1e-6f); float s2 = 0.f;
#pragma unroll
        for (int j = 0; j < 4; ++j) { const f32x4 g = ((const f32x4*)a.in[24])[lane + 64 * j], x = ((const f32x4*)xr)[lane + 64 * j];
            v[j] = x + v[j] * rs * g; ((f32x4*)(a.out + OUT_Y + (size_t)m * 1024))[lane + 64 * j] = v[j];
            s2 += (v[j][0] * v[j][0] + v[j][1] * v[j][1]) + (v[j][2] * v[j][2] + v[j][3] * v[j][3]); }
        const float rs2 = rsqrtf(wave_sum(s2) * (1.f / 1024.f) + 1e-6f);
#pragma unroll
        for (int j = 0; j < 4; ++j) { const f32x4 g = ((const f32x4*)a.in[25])[lane + 64 * j]; ((u32x2*)(F + (size_t)m * 1024))[lane + 64 * j] = pk4bf(v[j] * rs2 * g); }
    }
}
__device__ __forceinline__ void phase_p7b(const Args& a, LAS unsigned char* lds) {
    PH_PROLOG
    const float* F2 = (const float*)(a.ws + WS_F2);
    for (int m = gw; m < M; m += NGW) {
        f32x4 v[4]; float ss = 0.f;
#pragma unroll
        for (int j = 0; j < 4; ++j) { v[j] = ((const f32x4*)(F2 + (size_t)m * 1024))[lane + 64 * j]; ss += (v[j][0] * v[j][0] + v[j][1] * v[j][1]) + (v[j][2] * v[j][2] + v[j][3] * v[j][3]); }
        const float rs = rsqrtf(wave_sum(ss) * (1.f / 1024.f) + 1e-6f);
        f32x4* o = (f32x4*)(a.out + OUT_Y + (size_t)m * 1024);
#pragma unroll
        for (int j = 0; j < 4; ++j) { const f32x4 g = ((const f32x4*)a.in[29])[lane + 64 * j]; o[lane + 64 * j] = o[lane + 64 * j] + v[j] * rs * g; }
    }
}

#define XB_TMO      128
#define XB_XCNT(j)  (256  + 64 * (j))
#define XB_XSUB(j)  (1280 + 64 * (j))
#define XB_XGEN(j)  (2304 + 64 * (j))
#define XB_TOP      3328
#define XB_TOPGEN   3392
#define XCD_BAR_WORDS 3456
#define XB_SPIN_CAP (1u << 18)

__device__ __forceinline__ unsigned xb_ld(unsigned* p)              { return __hip_atomic_load(p, __ATOMIC_RELAXED, __HIP_MEMORY_SCOPE_AGENT); }
__device__ __forceinline__ unsigned xb_add(unsigned* p, unsigned v) { return __hip_atomic_fetch_add(p, v, __ATOMIC_RELAXED, __HIP_MEMORY_SCOPE_AGENT); }
__device__ __forceinline__ unsigned xb_xcc_id() { return (unsigned)__builtin_amdgcn_s_getreg((3 << 11) | 20) & 0xFu; }
#define XB_SPIN(cond, bar) do { unsigned _sp = 0; while (cond) { __builtin_amdgcn_s_sleep(1); \
    if ((++_sp & 255u) == 0u) { if (xb_ld(&(bar)[XB_TMO])) break; if (_sp > XB_SPIN_CAP) { atomicAdd(&(bar)[XB_TMO], 1u); break; } } } } while (0)

struct XcdBarrier {
    unsigned* bar; unsigned x;
    volatile LAS unsigned* st;
};

__device__ __forceinline__ XcdBarrier xcd_barrier_post(unsigned* bar, volatile LAS unsigned* st) {
    XcdBarrier b; b.bar = bar; b.x = xb_xcc_id(); b.st = st;
    if (threadIdx.x == 0) (void)xb_add(&bar[XB_XCNT(b.x)], 1u);
    return b;
}
__device__ __forceinline__ void xcd_barrier_complete(unsigned* bar, unsigned x, unsigned& nloc, unsigned& nx) {
    const unsigned G = gridDim.x * gridDim.y * gridDim.z;
    unsigned sum, cnt, mine, sp = 0u;
    for (;;) {
        sum = 0u; cnt = 0u; mine = 0u;
#pragma unroll
        for (unsigned j = 0; j < 16; ++j) { const unsigned c = xb_ld(&bar[XB_XCNT(j)]); sum += c; cnt += (c > 0u) ? 1u : 0u; mine = (j == x) ? c : mine; }
        if (sum == G) break;
        __builtin_amdgcn_s_sleep(1);
        if ((++sp & 255u) == 0u) { if (xb_ld(&bar[XB_TMO])) break; if (sp > XB_SPIN_CAP) { atomicAdd(&bar[XB_TMO], 1u); break; } }
    }
    nloc = mine > 0u ? mine : 1u; nx = cnt > 0u ? cnt : 1u;
}

__device__ __forceinline__ void xcd_barrier(const XcdBarrier& b) {
    asm volatile("s_waitcnt vmcnt(0)" ::: "memory");
    __syncthreads();
    if (threadIdx.x == 0) {
        unsigned* bar = b.bar;
        __builtin_amdgcn_s_waitcnt(0);
        unsigned nloc = b.st[0], nx = b.st[1];
        if (nloc == 0u) { xcd_barrier_complete(bar, b.x, nloc, nx); b.st[0] = nloc; b.st[1] = nx; }
        const unsigned old = xb_add(&bar[XB_XSUB(b.x)], 1u);
        const unsigned gen = old / nloc;
        if (old + 1u == (gen + 1u) * nloc) {
            __builtin_amdgcn_fence(__ATOMIC_RELEASE, "agent");
            asm volatile("s_waitcnt vmcnt(0)" ::: "memory");
            const unsigned og = xb_add(&bar[XB_TOP], 1u);
            const unsigned tg = og / nx;
            if (og + 1u == (tg + 1u) * nx) xb_add(&bar[XB_TOPGEN], 1u);
            else XB_SPIN(xb_ld(&bar[XB_TOPGEN]) == tg, bar);
            __builtin_amdgcn_fence(__ATOMIC_ACQUIRE, "agent");
            xb_add(&bar[XB_XGEN(b.x)], 1u);
            asm volatile("s_waitcnt vmcnt(0)" ::: "memory");
        } else {
            XB_SPIN(xb_ld(&bar[XB_XGEN(b.x)]) == gen, bar);
            __builtin_amdgcn_fence(__ATOMIC_ACQUIRE, "agent");
            asm volatile("s_waitcnt vmcnt(0)" ::: "memory");
        }
    }
    __syncthreads();
}

template <class E> __device__ __forceinline__ void run_gemm(LAS unsigned char* lds, const bf16* A, const bf16* Bt, int N, int K, const E& e) {
    pg8::Gemm g{A, Bt, M, N, K}; pg8::StaticOrder S; S.init(M, N, (int)gridDim.x, (int)blockIdx.x);
    pg8::gemm_phase<E, pg8::StaticOrder, true, true>(lds, g, S, e);
}
__global__ void __launch_bounds__(512, 2) mk_fwd(Args a) {
    extern __shared__ __attribute__((aligned(16))) unsigned char lds_raw[];
    LAS unsigned char* lds = (LAS unsigned char*)lds_raw;
    unsigned char* ws = a.ws;
    const int lo = a.ph_lo, hi = a.ph_hi;
    volatile LAS unsigned* MISC = (volatile LAS unsigned*)(lds + 131072);
    if (threadIdx.x < 64) MISC[threadIdx.x] = 0u;
    __syncthreads();
#define IN(k) (lo <= (k) && (k) < hi)
#ifndef MK_REP
#define MK_REP -1
#endif
#define XBAR() do { XcdBarrier b_; b_.bar = (unsigned*)a.ws; b_.x = xb_xcc_id(); b_.st = (volatile LAS unsigned*)(lds + 131072) + 8; xcd_barrier(b_); } while (0)
#define SEAM(k) do { if (IN(k) && IN((k) + 1)) { if ((k) == 0) { cg::this_grid().sync(); if (threadIdx.x == 0) (void)xb_add((unsigned*)a.ws + XB_XCNT(xb_xcc_id()), 1u); } else XBAR(); } } while (0)
#define REP(k, ...) do { if (MK_REP == (k)) { XBAR(); __VA_ARGS__; } } while (0)
    if (IN(0)) { phase_p0(a, lds); REP(0, phase_p0(a, lds)); } SEAM(0);
    if (IN(1)) { Epi8<FStoreBf16> e{{(bf16*)(ws + WS_PS), SHW}}; run_gemm(lds, (const bf16*)(ws + WS_XN), (const bf16*)(ws + WS_WIN), SHW, 1024, e); REP(1, Epi8<FStoreBf16> e{{(bf16*)(ws + WS_PS), SHW}}; run_gemm(lds, (const bf16*)(ws + WS_XN), (const bf16*)(ws + WS_WIN), SHW, 1024, e)); } SEAM(1);
    if (IN(2)) { phase_p2a(a, lds); REP(2, phase_p2a(a, lds)); } SEAM(2);
    if (IN(3)) { Epi8<FLora> e{{(f16*)((unsigned char*)a.out + U), (f16*)(ws + WS_AR), (f16*)(ws + WS_G), a.in[7], a.in[9]}}; run_gemm(lds, (const bf16*)(ws + WS_LX), (const bf16*)(ws + WS_LORA), 3072, 256, e); REP(3, Epi8<FLora> e{{(f16*)((unsigned char*)a.out + U), (f16*)(ws + WS_AR), (f16*)(ws + WS_G), a.in[7], a.in[9]}}; run_gemm(lds, (const bf16*)(ws + WS_LX), (const bf16*)(ws + WS_LORA), 3072, 256, e)); } SEAM(3);
    if (IN(4)) { phase_scan(a, lds); REP(4, phase_scan(a, lds)); } SEAM(4);
    if (IN(5)) { phase_gn(a, lds); REP(5, phase_gn(a, lds)); } SEAM(5);
    if (IN(6)) { Epi8<FP1b> e{{(bf16*)(ws + WS_P4)}}; run_gemm(lds, (const bf16*)(ws + WS_XN), (const bf16*)(ws + WS_WIN) + (size_t)SHW * 1024, 4096, 1024, e); REP(6, Epi8<FP1b> e{{(bf16*)(ws + WS_P4)}}; run_gemm(lds, (const bf16*)(ws + WS_XN), (const bf16*)(ws + WS_WIN) + (size_t)SHW * 1024, 4096, 1024, e)); } SEAM(6);
    if (IN(7)) { phase_gmlp(a, lds); REP(7, phase_gmlp(a, lds)); } SEAM(7);
    if (IN(8)) { Epi8<FGateA> e{{(const bf16*)(ws + WS_P4 + 2 * U), (bf16*)(ws + WS_MM)}}; run_gemm(lds, (const bf16*)(ws + WS_OA), (const bf16*)(ws + WS_WA), 1024, 1024, e); REP(8, Epi8<FGateA> e{{(const bf16*)(ws + WS_P4 + 2 * U), (bf16*)(ws + WS_MM)}}; run_gemm(lds, (const bf16*)(ws + WS_OA), (const bf16*)(ws + WS_WA), 1024, 1024, e)); } SEAM(8);
    if (IN(9)) { Epi8<FGateB> e{{(const bf16*)(ws + WS_P4 + 3 * U), (bf16*)(ws + WS_MM)}}; run_gemm(lds, (const bf16*)(ws + WS_OB), (const bf16*)(ws + WS_WB), 1024, 1024, e); REP(9, Epi8<FGateB> e{{(const bf16*)(ws + WS_P4 + 3 * U), (bf16*)(ws + WS_MM)}}; run_gemm(lds, (const bf16*)(ws + WS_OB), (const bf16*)(ws + WS_WB), 1024, 1024, e)); } SEAM(9);
    if (IN(10)) { Epi4<FStoreF32> e{{(float*)(ws + WS_MO), 1024}}; run_gemm(lds, (const bf16*)(ws + WS_MM), (const bf16*)(ws + WS_WO), 1024, 1024, e); REP(10, Epi4<FStoreF32> e{{(float*)(ws + WS_MO), 1024}}; run_gemm(lds, (const bf16*)(ws + WS_MM), (const bf16*)(ws + WS_WO), 1024, 1024, e)); } SEAM(10);
    if (IN(11)) { phase_p5b(a, lds); REP(11, phase_p5b(a, lds)); } SEAM(11);
    if (IN(12)) { EpiGU e{(bf16*)(ws + WS_H)}; run_gemm(lds, (const bf16*)(ws + WS_F), (const bf16*)(ws + WS_GU), 2 * DFF, 1024, e); REP(12, EpiGU e{(bf16*)(ws + WS_H)}; run_gemm(lds, (const bf16*)(ws + WS_F), (const bf16*)(ws + WS_GU), 2 * DFF, 1024, e)); } SEAM(12);
    if (IN(13)) { Epi4<FStoreF32> e{{(float*)(ws + WS_F2), 1024}}; run_gemm(lds, (const bf16*)(ws + WS_H), (const bf16*)(ws + WS_WD), 1024, DFF, e); REP(13, Epi4<FStoreF32> e{{(float*)(ws + WS_F2), 1024}}; run_gemm(lds, (const bf16*)(ws + WS_H), (const bf16*)(ws + WS_WD), 1024, DFF, e)); } SEAM(13);
    if (MK_REP == 100) { for (int i = 0; i < 14; ++i) XBAR(); }
    if (IN(14)) { phase_p7b(a, lds); }
#undef IN
#undef SEAM
}


#ifndef MK_DBG
#define MK_DBG 0
#endif
__global__ void dbg_zero(float* p, size_t n) { for (size_t i = (size_t)blockIdx.x * blockDim.x + threadIdx.x; i < n; i += (size_t)gridDim.x * blockDim.x) p[i] = 0.f; }
extern "C" void kernel_launch(void* const* d_in, const int* in_sizes, int n_in, void* d_out, int out_size, void* d_ws, size_t ws_size, hipStream_t stream) {
    static int grid = 0;
    if (grid == 0) {
        if (n_in != 30 || (size_t)out_size != OUT_END || ws_size < WS_END) { fprintf(stderr, "kernel_launch: unexpected shapes (n_in %d out %d ws %zu, need ws >= %zu)\n", n_in, out_size, ws_size, (size_t)WS_END); }
        int dev = 0, cus = 0, per_cu = 0;
        (void)hipGetDevice(&dev); (void)hipDeviceGetAttribute(&cus, hipDeviceAttributeMultiprocessorCount, dev);
        (void)hipFuncSetAttribute((const void*)mk_fwd, hipFuncAttributeMaxDynamicSharedMemorySize, LDS_BYTES);
        (void)hipOccupancyMaxActiveBlocksPerMultiprocessor(&per_cu, (const void*)mk_fwd, 512, LDS_BYTES);
        if (per_cu < 1) { fprintf(stderr, "kernel_launch: occupancy query says %d blocks per CU\n", per_cu); per_cu = 1; }
        grid = cus > 0 ? cus : 256;
        (void)hipGetLastError();
    }
    Args a{};
    for (int i = 0; i < 30; ++i) a.in[i] = (const float*)d_in[i];
    a.out = (float*)d_out; a.ws = (unsigned char*)d_ws;
#if MK_ONE_LAUNCH
    (void)hipMemsetAsync(d_ws, 0, 65536, stream);
    a.ph_lo = 0; a.ph_hi = NPHASE;
    void* args[] = {&a};
    hipError_t e = hipLaunchCooperativeKernel((const void*)mk_fwd, dim3(grid), dim3(512), args, LDS_BYTES, stream);
    if (e != hipSuccess) fprintf(stderr, "cooperative launch failed: %s (grid %d)\n", hipGetErrorString(e), grid);
#else
    const int nph = MK_DBG == 1 ? 5 : (MK_DBG == 2 ? 3 : (MK_DBG == 3 ? 8 : NPHASE));
    for (int p = 0; p < nph; ++p) { a.ph_lo = p; a.ph_hi = p + 1; hipLaunchKernelGGL(mk_fwd, dim3(grid), dim3(512), LDS_BYTES, stream, a); }
    float* o = (float*)d_out;
    if (MK_DBG >= 1) hipLaunchKernelGGL(dbg_zero, dim3(1024), dim3(256), 0, stream, o + OUT_Y, (size_t)M * 1024);
    if (MK_DBG == 1 || MK_DBG == 2) hipLaunchKernelGGL(dbg_zero, dim3(1024), dim3(256), 0, stream, o + OUT_VS, (size_t)32 * 64 * 1024);
    if (MK_DBG == 2) { hipLaunchKernelGGL(dbg_zero, dim3(1024), dim3(256), 0, stream, o + OUT_WKV_P, (size_t)8 * 16 * 4096); hipLaunchKernelGGL(dbg_zero, dim3(1024), dim3(256), 0, stream, o + OUT_WKV_S, (size_t)32 * 16 * 4096); }
#endif
}
```

```cpp
#include <hip/hip_runtime.h>
#include <hip/hip_cooperative_groups.h>
#include <cstdio>
#include <cstdint>
namespace cg = cooperative_groups;
namespace pg8 {
#define PG8_LAS __attribute__((address_space(3)))
typedef unsigned short bf16_t;
typedef short bf16x8 __attribute__((ext_vector_type(8)));
typedef float f32x4 __attribute__((ext_vector_type(4)));
typedef unsigned u32x4 __attribute__((ext_vector_type(4)));
constexpr int BM = 256, BK = 64, HALF = 128, HTB = HALF * BK * 2  , STAGE_BYTES = 8 * HTB, NXCD = 8, WGM = 8;

__host__ __device__ __forceinline__ int lds_byte(int r, int c) { const int st = (r >> 4) * 2 + (c >> 5), rr = r & 15, cc = c & 31, ob = rr * 64 + cc * 2; return st * 1024 + (ob ^ (((ob >> 9) & 1) << 5)); }
__host__ __device__ __forceinline__ void stage_rc(int b, int& R, int& C) { const int st = b / 1024, sb = b % 1024, swz = sb ^ (((sb >> 9) & 1) << 5); R = (st >> 1) * 16 + swz / 64; C = (st & 1) * 32 + (swz % 64) / 2; }
__host__ __device__ __forceinline__ int perm32(int rho) { const int n = rho >> 4, i = rho & 15; return 8 * (i >> 2) + 4 * n + (i & 3); }

struct Unit { int pm, pn; };
struct Gemm { const bf16_t* A; const bf16_t* Bt; int M, N, K; };

struct StaticOrder {
    int nM, nN, nwg, G, c;
    __host__ __device__ void init(int M, int N, int G_, int c_) { nM = M / BM; nN = N / BM; nwg = nM * nN; G = G_; c = c_; }
    __host__ __device__ bool next(int i, Unit& u) const {
        const long L = (long)i * G + c; if (L >= nwg) return false;
        int wgid = (int)L; { const int q = nwg / NXCD, r = nwg % NXCD, xcd = wgid % NXCD, off = wgid / NXCD; wgid = (xcd < r ? xcd * (q + 1) : r * (q + 1) + (xcd - r) * q) + off; }
        const int nig = WGM * nN, gid = wgid / nig, fm = gid * WGM, gsz = (nM - fm) < WGM ? (nM - fm) : WGM;
        u.pm = fm + ((wgid % nig) % gsz); u.pn = (wgid % nig) / gsz; return true;
    }
    __device__ __forceinline__ void a_ready(const Unit&) const {}
    __device__ __forceinline__ void done(const Unit&) const {}
};

__device__ __forceinline__ unsigned cvt_pk_bf16(float lo, float hi) { unsigned r; asm volatile("v_cvt_pk_bf16_f32 %0, %1, %2" : "=v"(r) : "v"(lo), "v"(hi)); return r; }
typedef float f32x2 __attribute__((ext_vector_type(2)));
template <class Epi, class Sched, bool ALIGN_EPI = false, bool SP2 = false>
__device__ __forceinline__ void gemm_phase(PG8_LAS unsigned char* lds, const Gemm g, const Sched& S, const Epi& E) {
    const int tid = threadIdx.x, wid = __builtin_amdgcn_readfirstlane(tid >> 6), lane = tid & 63, wr = wid >> 2, wc = wid & 3, fr = lane & 15, fq = lane >> 4;
    const int K = g.K, nt = K / BK;
    unsigned voffA[2], voffB[2];
#pragma unroll
    for (int i = 0; i < 2; ++i) { int R, C; stage_rc(tid * 16 + i * 8192, R, C); const int Rb = Epi::PERM ? ((R & ~31) + perm32(R & 31)) : R;
        voffA[i] = (unsigned)(R * K + C) * 2u; voffB[i] = (unsigned)(Rb * K + C) * 2u; }
    const size_t kstep = (size_t)(BK * 2);
    const size_t hstep = (size_t)HALF * K * 2;
    const size_t tstep = 2 * hstep;
    const unsigned ldsw = (unsigned)wid * 1024u;
    const int aoff = lds_byte(wr * 64 + fr, fq * 8), boff = lds_byte(wc * 32 + fr, fq * 8);
#define PG8_SA(b, h) (((b) * 2 + (h)) * HTB)
#define PG8_SB(b, h) ((4 + (b) * 2 + (h)) * HTB)
#define PG8_STAGE(bufoff, gbase, voff) do { _Pragma("unroll") for (int _i = 0; _i < 2; ++_i) \
        __builtin_amdgcn_global_load_lds((const unsigned*)((const char*)(gbase) + (voff)[_i]), (PG8_LAS unsigned*)(lds + (bufoff) + ldsw + _i * 8192), 16, 0, 0); } while (0)
#define PG8_LDA(dst, b, h) do { _Pragma("unroll") for (int m = 0; m < 4; ++m) _Pragma("unroll") for (int k = 0; k < 2; ++k) dst[m][k] = *(const PG8_LAS bf16x8*)(lds + PG8_SA(b, h) + aoff + m * 2048 + k * 1024); } while (0)
#define PG8_LDB(dst, b, h) do { _Pragma("unroll") for (int n = 0; n < 2; ++n) _Pragma("unroll") for (int k = 0; k < 2; ++k) dst[n][k] = *(const PG8_LAS bf16x8*)(lds + PG8_SB(b, h) + boff + n * 2048 + k * 1024); } while (0)
#define PG8_MMA(ai, bj, At, Bt) do { __builtin_amdgcn_s_setprio(1); _Pragma("unroll") for (int m = 0; m < 4; ++m) _Pragma("unroll") for (int n = 0; n < 2; ++n) _Pragma("unroll") for (int k = 0; k < 2; ++k) \
        acc[ai][bj][m][n] = __builtin_amdgcn_mfma_f32_16x16x32_bf16(Bt[n][k], At[m][k], acc[ai][bj][m][n], 0, 0, 0); __builtin_amdgcn_s_setprio(0); } while (0)
#define PG8_WAIT_V(n) asm volatile("s_waitcnt vmcnt(" #n ")" ::: "memory")
#define PG8_WAIT_L(n) asm volatile("s_waitcnt lgkmcnt(" #n ")" ::: "memory")
#define PG8_BAR __builtin_amdgcn_s_barrier()
#define PG8_SCHED __builtin_amdgcn_sched_barrier(0)
    Unit cur, nxt; int ui = 0;
    if (!S.next(0, cur)) return;
    f32x4 acc[2][2][4][2];
#pragma unroll
    for (int a = 0; a < 2; ++a)
#pragma unroll
        for (int b = 0; b < 2; ++b)
#pragma unroll
            for (int m = 0; m < 4; ++m)
#pragma unroll
                for (int n = 0; n < 2; ++n) acc[a][b][m][n] = (f32x4){0.f, 0.f, 0.f, 0.f};
    bf16x8 At[4][2], B0[2][2], B1[2][2];
    const char* cA = (const char*)g.A + (size_t)cur.pm * tstep; const char* cB = (const char*)g.Bt + (size_t)cur.pn * tstep;
    S.a_ready(cur);
    if constexpr (SP2) {
        PG8_STAGE(PG8_SB(0, 0), cB, voffB); PG8_STAGE(PG8_SB(0, 1), cB + hstep, voffB); PG8_STAGE(PG8_SA(0, 0), cA, voffA); PG8_STAGE(PG8_SA(0, 1), cA + hstep, voffA);
        if (wr == 1) PG8_BAR;
        PG8_WAIT_V(2); PG8_BAR;
        PG8_STAGE(PG8_SB(1, 0), cB + kstep, voffB); PG8_STAGE(PG8_SA(1, 0), cA + kstep, voffA); PG8_STAGE(PG8_SB(1, 1), cB + hstep + kstep, voffB);
        PG8_WAIT_V(6); PG8_BAR;
    } else {
        PG8_STAGE(PG8_SB(0, 0), cB, voffB); PG8_STAGE(PG8_SA(0, 0), cA, voffA); PG8_STAGE(PG8_SB(0, 1), cB + hstep, voffB); PG8_STAGE(PG8_SA(0, 1), cA + hstep, voffA);
        if (wr == 1) PG8_BAR;
        PG8_WAIT_V(4); PG8_BAR;
        PG8_STAGE(PG8_SB(1, 0), cB + kstep, voffB); PG8_STAGE(PG8_SA(1, 0), cA + kstep, voffA); PG8_STAGE(PG8_SB(1, 1), cB + hstep + kstep, voffB);
        PG8_WAIT_V(6); PG8_BAR;
    }
    for (;;) {
        const bool has_next = S.next(ui + 1, nxt);
        const char* nA = has_next ? (const char*)g.A + (size_t)nxt.pm * tstep : cA; const char* nB = has_next ? (const char*)g.Bt + (size_t)nxt.pn * tstep : cB;
        for (int t = 0; t < nt; t += 2) {
            const bool last = (t == nt - 2);
            const char* a1 = cA + (size_t)(t + 1) * kstep;
            const char* a2 = last ? nA : cA + (size_t)(t + 2) * kstep; const char* b2 = last ? nB : cB + (size_t)(t + 2) * kstep;
            const char* a3 = a2 + kstep; const char* b3 = b2 + kstep;
            if (last && has_next) S.a_ready(nxt);
            if constexpr (SP2) {
            PG8_LDB(B0, 0, 0); PG8_LDB(B1, 0, 1); PG8_SCHED; PG8_LDA(At, 0, 0); PG8_STAGE(PG8_SA(1, 1), a1 + hstep, voffA);
            PG8_WAIT_V(8); PG8_WAIT_L(0); PG8_BAR; PG8_MMA(0, 0, At, B0); PG8_MMA(0, 1, At, B1); PG8_BAR; PG8_SCHED;
            PG8_LDA(At, 0, 1); PG8_STAGE(PG8_SB(0, 0), b2, voffB); PG8_STAGE(PG8_SB(0, 1), b2 + hstep, voffB); PG8_STAGE(PG8_SA(0, 0), a2, voffA);
            PG8_WAIT_V(8); PG8_WAIT_L(0); PG8_BAR; PG8_MMA(1, 0, At, B0); PG8_MMA(1, 1, At, B1); PG8_BAR; PG8_SCHED;
            PG8_LDB(B0, 1, 0); PG8_LDB(B1, 1, 1); PG8_SCHED; PG8_LDA(At, 1, 0); PG8_STAGE(PG8_SA(0, 1), a2 + hstep, voffA);
            PG8_WAIT_V(8); PG8_WAIT_L(0); PG8_BAR; PG8_MMA(0, 0, At, B0); PG8_MMA(0, 1, At, B1); PG8_BAR; PG8_SCHED;
            PG8_LDA(At, 1, 1); PG8_STAGE(PG8_SB(1, 0), b3, voffB); PG8_STAGE(PG8_SB(1, 1), b3 + hstep, voffB); PG8_STAGE(PG8_SA(1, 0), a3, voffA);
            PG8_WAIT_V(8); PG8_WAIT_L(0); PG8_BAR; PG8_MMA(1, 0, At, B0); PG8_MMA(1, 1, At, B1); PG8_BAR; PG8_SCHED;
            } else {
            PG8_LDB(B0, 0, 0); PG8_SCHED; PG8_LDA(At, 0, 0); PG8_STAGE(PG8_SA(1, 1), a1 + hstep, voffA);
            PG8_WAIT_L(8); PG8_BAR; PG8_WAIT_L(0); PG8_MMA(0, 0, At, B0); PG8_BAR; PG8_SCHED;
            PG8_LDB(B1, 0, 1); PG8_STAGE(PG8_SB(0, 0), b2, voffB);
            PG8_BAR; PG8_WAIT_L(0); PG8_MMA(0, 1, At, B1); PG8_BAR;
            PG8_LDA(At, 0, 1); PG8_STAGE(PG8_SA(0, 0), a2, voffA);
            PG8_BAR; PG8_WAIT_L(0); PG8_MMA(1, 0, At, B0); PG8_BAR; PG8_SCHED;
            PG8_STAGE(PG8_SB(0, 1), b2 + hstep, voffB);
            PG8_WAIT_V(6); PG8_BAR; PG8_MMA(1, 1, At, B1); PG8_BAR;
            PG8_LDB(B0, 1, 0); PG8_SCHED; PG8_LDA(At, 1, 0); PG8_STAGE(PG8_SA(0, 1), a2 + hstep, voffA);
            PG8_WAIT_L(8); PG8_BAR; PG8_WAIT_L(0); PG8_MMA(0, 0, At, B0); PG8_BAR; PG8_SCHED;
            PG8_LDB(B1, 1, 1); PG8_STAGE(PG8_SB(1, 0), b3, voffB);
            PG8_BAR; PG8_WAIT_L(0); PG8_MMA(0, 1, At, B1); PG8_BAR;
            PG8_LDA(At, 1, 1); PG8_STAGE(PG8_SA(1, 0), a3, voffA);
            PG8_BAR; PG8_WAIT_L(0); PG8_MMA(1, 0, At, B0); PG8_BAR; PG8_SCHED;
            PG8_STAGE(PG8_SB(1, 1), b3 + hstep, voffB);
            PG8_WAIT_V(6); PG8_BAR; PG8_MMA(1, 1, At, B1); PG8_BAR;
            }
        }
        if constexpr (ALIGN_EPI) { if (wr == 0) PG8_BAR; }
        if constexpr (!Epi::AFTER_DRAIN) { E(acc, cur, wr, wc, fr, fq); S.done(cur); }
        if (!has_next) break;
#pragma unroll
        for (int a = 0; a < 2; ++a)
#pragma unroll
            for (int b = 0; b < 2; ++b)
#pragma unroll
                for (int m = 0; m < 4; ++m)
#pragma unroll
                    for (int n = 0; n < 2; ++n) acc[a][b][m][n] = (f32x4){0.f, 0.f, 0.f, 0.f};
        cur = nxt; cA = nA; cB = nB; ++ui;
        if constexpr (ALIGN_EPI) { if (wr == 1) PG8_BAR; }
    }
    PG8_WAIT_V(0);
    if constexpr (!ALIGN_EPI) { if (wr == 0) PG8_BAR; }
    PG8_BAR;
    if constexpr (Epi::AFTER_DRAIN) { E.fused(acc, cur, wr, wc, fr, fq, lds, wid, lane); S.done(cur); }
#undef PG8_SA
#undef PG8_SB
#undef PG8_STAGE
#undef PG8_LDA
#undef PG8_LDB
#undef PG8_MMA
#undef PG8_WAIT_V
#undef PG8_WAIT_L
#undef PG8_BAR
#undef PG8_SCHED
}
}
#define LAS __attribute__((address_space(3)))
typedef unsigned short bf16;
typedef _Float16 f16;
typedef float f32x4 __attribute__((ext_vector_type(4)));
typedef short bf16x8 __attribute__((ext_vector_type(8)));
typedef short s16x4 __attribute__((ext_vector_type(4)));
typedef unsigned u32x4 __attribute__((ext_vector_type(4)));
typedef unsigned u32x2 __attribute__((ext_vector_type(2)));
typedef _Float16 h2 __attribute__((ext_vector_type(2)));

#ifndef MK_ONE_LAUNCH
#define MK_ONE_LAUNCH 1
#endif

constexpr int NPROMPT = 8 * 4096, NSAMP = 32 * 64, M = NPROMPT + NSAMP;
constexpr int DM = 1024, SHW = 3328, DFF = 2816;
constexpr size_t MiB = 1u << 20;
constexpr size_t U = (size_t)M * 1024 * 2;
constexpr size_t WS_WIN = 1 * MiB;
constexpr size_t WS_WA = WS_WIN + (size_t)7424 * 1024 * 2;
constexpr size_t WS_WB = WS_WA + (size_t)1024 * 1024 * 2;
constexpr size_t WS_WO = WS_WB + (size_t)1024 * 1024 * 2;
constexpr size_t WS_GU = WS_WO + (size_t)1024 * 1024 * 2;
constexpr size_t WS_WD = WS_GU + (size_t)5632 * 1024 * 2;
constexpr size_t WS_LORA = WS_WD + (size_t)1024 * 2816 * 2;
constexpr size_t WS_WSP = WS_LORA + (size_t)3072 * 256 * 2;
constexpr size_t WS_R0 = 40 * MiB;
static_assert(WS_WSP + 8 * 128 * 128 * 2 <= WS_R0, "weights fit below R0");
constexpr size_t WS_XN = WS_R0;
constexpr size_t WS_WL = WS_R0;
constexpr size_t WS_PS = WS_R0 + U;
constexpr size_t WS_AR = WS_R0 + U * 17 / 4;
constexpr size_t WS_G = WS_R0 + U * 21 / 4;
constexpr size_t WS_LX = WS_R0 + U * 25 / 4;
constexpr size_t WS_END = WS_R0 + U * 26 / 4;
constexpr size_t WS_XN2 = WS_R0;
constexpr size_t WS_P4 = WS_R0 + U;
constexpr size_t WS_OA = WS_G;
constexpr size_t WS_OB = WS_R0;
constexpr size_t WS_MM = WS_R0 + U;
constexpr size_t WS_MO = WS_R0 + 2 * U;
constexpr size_t WS_F = WS_R0;
constexpr size_t WS_H = WS_R0 + U;
constexpr size_t WS_F2 = WS_R0 + 4 * U;
constexpr size_t OUT_Y = 0;
constexpr size_t OUT_SHIFT_P = (size_t)M * 1024;
constexpr size_t OUT_WKV_P = OUT_SHIFT_P + 8 * 3328;
constexpr size_t OUT_SHIFT_S = OUT_WKV_P + (size_t)8 * 16 * 4096;
constexpr size_t OUT_WKV_S = OUT_SHIFT_S + 32 * 3328;
constexpr size_t OUT_VS = OUT_WKV_S + (size_t)32 * 16 * 4096;
constexpr size_t OUT_END = OUT_VS + (size_t)32 * 64 * 1024;
static_assert(OUT_END == 40503296, "output size");

constexpr int LDS_BYTES = 147456;
constexpr int NPHASE = 15;

struct Args { const float* in[30]; float* out; unsigned char* ws; int ph_lo, ph_hi; };

__device__ __forceinline__ float bf_lo(unsigned u) { return __uint_as_float(u << 16); }
__device__ __forceinline__ float bf_hi(unsigned u) { return __uint_as_float(u & 0xffff0000u); }
__device__ __forceinline__ f32x4 dec4bf(u32x2 u) { return (f32x4){bf_lo(u.x), bf_hi(u.x), bf_lo(u.y), bf_hi(u.y)}; }
__device__ __forceinline__ unsigned pkbf(float lo, float hi) { return pg8::cvt_pk_bf16(lo, hi); }
__device__ __forceinline__ u32x2 pk4bf(f32x4 v) { u32x2 r; r.x = pkbf(v[0], v[1]); r.y = pkbf(v[2], v[3]); return r; }
__device__ __forceinline__ unsigned pkh(float lo, float hi) { h2 h; h.x = (f16)lo; h.y = (f16)hi; return __builtin_bit_cast(unsigned, h); }
__device__ __forceinline__ u32x2 pk4h(f32x4 v) { u32x2 r; r.x = pkh(v[0], v[1]); r.y = pkh(v[2], v[3]); return r; }
__device__ __forceinline__ h2 as_h2(unsigned u) { return __builtin_bit_cast(h2, u); }
__device__ __forceinline__ f32x4 dec4h(u32x2 u) { const h2 a = as_h2(u.x), b = as_h2(u.y); return (f32x4){(float)a.x, (float)a.y, (float)b.x, (float)b.y}; }
__device__ __forceinline__ float sigm(float x) { return __builtin_amdgcn_rcpf(1.f + __expf(-x)); }
__device__ __forceinline__ float wave_sum(float v) {
#pragma unroll
    for (int o = 1; o < 64; o <<= 1) v += __shfl_xor(v, o);
    return v;
}
template <int CTRL> __device__ __forceinline__ float dppf(float x) { return __int_as_float(__builtin_amdgcn_update_dpp(0, __float_as_int(x), CTRL, 0xF, 0xF, false)); }
__device__ __forceinline__ float row_sum16(float x) { x += dppf<0x128>(x); x += dppf<0x124>(x); x += dppf<0x122>(x); x += dppf<0x121>(x); return x; }
__device__ __forceinline__ float quad_sum(float x) { x += dppf<0xB1>(x); x += dppf<0x4E>(x); return x; }
__device__ __forceinline__ const float* xrow_ptr(const Args& a, int m) { return m < NPROMPT ? a.in[0] + (size_t)m * 1024 : a.in[1] + (size_t)(m - NPROMPT) * 1024; }

template <class F> struct Epi8 {
    static constexpr bool PERM = true, AFTER_DRAIN = false; F f;
    __device__ __forceinline__ void operator()(const f32x4 (&acc)[2][2][4][2], const pg8::Unit& u, int wr, int wc, int fr, int fq) const {
        const int row0 = u.pm * 256 + wr * 64 + fr, col0 = u.pn * 256 + wc * 32 + 8 * fq;
#pragma unroll
        for (int ai = 0; ai < 2; ++ai)
#pragma unroll
            for (int m = 0; m < 4; ++m)
#pragma unroll
                for (int bj = 0; bj < 2; ++bj) f(row0 + ai * 128 + m * 16, col0 + bj * 128, acc[ai][bj][m][0], acc[ai][bj][m][1]);
    }
};
template <class F> struct Epi4 {
    static constexpr bool PERM = false, AFTER_DRAIN = false; F f;
    __device__ __forceinline__ void operator()(const f32x4 (&acc)[2][2][4][2], const pg8::Unit& u, int wr, int wc, int fr, int fq) const {
        const int row0 = u.pm * 256 + wr * 64 + fr, col0 = u.pn * 256 + wc * 32 + 4 * fq;
#pragma unroll
        for (int ai = 0; ai < 2; ++ai)
#pragma unroll
            for (int m = 0; m < 4; ++m)
#pragma unroll
                for (int bj = 0; bj < 2; ++bj)
#pragma unroll
                    for (int n = 0; n < 2; ++n) f(row0 + ai * 128 + m * 16, col0 + bj * 128 + n * 16, acc[ai][bj][m][n]);
    }
};
__device__ __forceinline__ u32x4 pk8bf(f32x4 a, f32x4 b) { u32x4 w; w.x = pkbf(a[0], a[1]); w.y = pkbf(a[2], a[3]); w.z = pkbf(b[0], b[1]); w.w = pkbf(b[2], b[3]); return w; }
__device__ __forceinline__ u32x4 pk8h(f32x4 a, f32x4 b) { u32x4 w; w.x = pkh(a[0], a[1]); w.y = pkh(a[2], a[3]); w.z = pkh(b[0], b[1]); w.w = pkh(b[2], b[3]); return w; }
__device__ __forceinline__ void dec8bf(u32x4 w, f32x4& a, f32x4& b) { a = (f32x4){bf_lo(w.x), bf_hi(w.x), bf_lo(w.y), bf_hi(w.y)}; b = (f32x4){bf_lo(w.z), bf_hi(w.z), bf_lo(w.w), bf_hi(w.w)}; }

struct FStoreBf16 { bf16* O; int ldc;
    __device__ __forceinline__ void operator()(int r, int c, f32x4 v0, f32x4 v1) const { *(u32x4*)(O + (size_t)r * ldc + c) = pk8bf(v0, v1); } };
struct FStoreF32 { float* O; int ldc;
    __device__ __forceinline__ void operator()(int r, int c, f32x4 v) const { *(f32x4*)(O + (size_t)r * ldc + c) = v; } };
struct FLora { f16* WL; f16* AR; f16* G; const float* w0; const float* a0;
    __device__ __forceinline__ void operator()(int r, int c, f32x4 v0, f32x4 v1) const {
        const int t = c >> 10, cc = c & 1023;
        if (t == 0) { const f32x4 b0 = *(const f32x4*)(w0 + cc), b1 = *(const f32x4*)(w0 + cc + 4);
#pragma unroll
            for (int i = 0; i < 4; ++i) { v0[i] = -0.60653066f * sigm(v0[i] + b0[i]); v1[i] = -0.60653066f * sigm(v1[i] + b1[i]); }
            *(u32x4*)(WL + (size_t)r * 1024 + cc) = pk8h(v0, v1); }
        else if (t == 1) { const f32x4 b0 = *(const f32x4*)(a0 + cc), b1 = *(const f32x4*)(a0 + cc + 4);
#pragma unroll
            for (int i = 0; i < 4; ++i) { v0[i] = sigm(v0[i] + b0[i]); v1[i] = sigm(v1[i] + b1[i]); }
            *(u32x4*)(AR + (size_t)r * 1024 + cc) = pk8h(v0, v1); }
        else *(u32x4*)(G + (size_t)r * 1024 + cc) = pk8h(v0, v1);
    } };
struct FP1b { bf16* base;
    __device__ __forceinline__ void operator()(int r, int c, f32x4 v0, f32x4 v1) const {
        const int t = c >> 10, cc = c & 1023;
        if (t >= 2) {
#pragma unroll
            for (int i = 0; i < 4; ++i) { v0[i] = sigm(v0[i]); v1[i] = sigm(v1[i]); } }
        *(u32x4*)(base + (size_t)t * (U / 2) + (size_t)r * 1024 + cc) = pk8bf(v0, v1);
    } };
struct FGateA { const bf16* GA; bf16* M1;
    __device__ __forceinline__ void operator()(int r, int c, f32x4 v0, f32x4 v1) const {
        const size_t o = (size_t)r * 1024 + c; f32x4 g0, g1; dec8bf(*(const u32x4*)(GA + o), g0, g1);
        *(u32x4*)(M1 + o) = pk8bf(v0 * g0, v1 * g1);
    } };
struct FGateB { const bf16* GB; bf16* MMp;
    __device__ __forceinline__ void operator()(int r, int c, f32x4 v0, f32x4 v1) const {
        const size_t o = (size_t)r * 1024 + c; f32x4 g0, g1, m0, m1; dec8bf(*(const u32x4*)(GB + o), g0, g1); dec8bf(*(const u32x4*)(MMp + o), m0, m1);
        *(u32x4*)(MMp + o) = pk8bf(m0 + v0 * g0, m1 + v1 * g1);
    } };
struct EpiGU {
    static constexpr bool PERM = true, AFTER_DRAIN = false; bf16* H;
    __device__ __forceinline__ void operator()(const f32x4 (&acc)[2][2][4][2], const pg8::Unit& u, int wr, int wc, int fr, int fq) const {
        const int row0 = u.pm * 256 + wr * 64 + fr, h0 = u.pn * 128 + wc * 32 + 8 * fq;
#pragma unroll
        for (int ai = 0; ai < 2; ++ai)
#pragma unroll
            for (int m = 0; m < 4; ++m) {
                f32x4 o0, o1;
#pragma unroll
                for (int i = 0; i < 4; ++i) { const float g0 = acc[ai][0][m][0][i], g1 = acc[ai][1][m][0][i];
                    o0[i] = g0 * sigm(g0) * acc[ai][0][m][1][i]; o1[i] = g1 * sigm(g1) * acc[ai][1][m][1][i]; }
                *(u32x4*)(H + (size_t)(row0 + ai * 128 + m * 16) * DFF + h0) = pk8bf(o0, o1);
            }
    }
};

#define PH_PROLOG const int tid = threadIdx.x, lane = tid & 63, wave = __builtin_amdgcn_readfirstlane(tid >> 6); const int G = gridDim.x, bid = blockIdx.x; const int gw = bid * 8 + wave, NGW = G * 8; (void)lane; (void)gw; (void)NGW; (void)lds;

__device__ __forceinline__ float conv_src(const Args& a, int mat, int R, int k) {
    switch (mat) {
    case 0: return a.in[5][(size_t)k * 7424 + R];
    case 1: return a.in[21][(size_t)k * 1024 + R];
    case 2: return a.in[22][(size_t)k * 1024 + R];
    case 3: return a.in[23][(size_t)k * 1024 + R];
    case 4: { const int cl = R & 255, pn = R >> 8, bj = (cl >> 7) & 1, wc = (cl >> 5) & 3, fq = (cl >> 3) & 3, n = (cl >> 2) & 1, e = cl & 3;
              const int hcol = 128 * pn + 32 * wc + 8 * fq + 4 * bj + e; return (n ? a.in[27] : a.in[26])[(size_t)k * DFF + hcol]; }
    case 5: return a.in[28][(size_t)k * 1024 + R];
    case 6: { if (R < 1024) return k < 64 ? a.in[8][k * 1024 + R] : 0.f;
              if (R < 2048) return (k >= 64 && k < 128) ? a.in[10][(k - 64) * 1024 + R - 1024] : 0.f;
              return k >= 128 ? a.in[11][(k - 128) * 1024 + R - 2048] : 0.f; }
    default: { const int t = R & 127; return k <= t ? a.in[19][(size_t)R * 128 + k] : 0.f; }
    }
}
__device__ __forceinline__ void rms_row_to_bf16(const float* xrow, const float* gain, bf16* orow, int lane) {
    f32x4 v[4]; float ss = 0.f;
#pragma unroll
    for (int j = 0; j < 4; ++j) { v[j] = ((const f32x4*)xrow)[lane + 64 * j]; ss += (v[j][0] * v[j][0] + v[j][1] * v[j][1]) + (v[j][2] * v[j][2] + v[j][3] * v[j][3]); }
    const float rs = rsqrtf(wave_sum(ss) * (1.f / 1024.f) + 1e-6f);
#pragma unroll
    for (int j = 0; j < 4; ++j) { const f32x4 g = ((const f32x4*)gain)[lane + 64 * j]; ((u32x2*)orow)[lane + 64 * j] = pk4bf(v[j] * rs * g); }
}
__device__ __forceinline__ void phase_p0(const Args& a, LAS unsigned char* lds) {
    PH_PROLOG
    constexpr int NIT[8] = {928 * 16, 128 * 16, 128 * 16, 128 * 16, 704 * 16, 128 * 44, 384 * 4, 128 * 2};
    constexpr int KD[8] = {1024, 1024, 1024, 1024, 1024, 2816, 256, 128};
    constexpr size_t DST[8] = {WS_WIN, WS_WA, WS_WB, WS_WO, WS_GU, WS_WD, WS_LORA, WS_WSP};
    constexpr int NITEMS = NIT[0] + NIT[1] + NIT[2] + NIT[3] + NIT[4] + NIT[5] + NIT[6] + NIT[7];
    for (int it = gw; it < NITEMS; it += NGW) {
        int r = it, mat = 0;
#pragma unroll
        for (int q = 0; q < 7; ++q) { if (mat == q && r >= NIT[q]) { r -= NIT[q]; mat = q + 1; } }
        int Kd = 1024; size_t dst = WS_WIN;
#pragma unroll
        for (int q = 0; q < 8; ++q) if (mat == q) { Kd = KD[q]; dst = DST[q]; }
        const int kbn = Kd >> 6, rb = r / kbn, kb = r - rb * kbn;
        const int R = rb * 8 + (lane >> 3), k0 = kb * 64 + (lane & 7) * 8;
        float s[8];
#pragma unroll
        for (int j = 0; j < 8; ++j) s[j] = conv_src(a, mat, R, k0 + j);
        u32x4 w; w.x = pkbf(s[0], s[1]); w.y = pkbf(s[2], s[3]); w.z = pkbf(s[4], s[5]); w.w = pkbf(s[6], s[7]);
        *(u32x4*)(a.ws + dst + ((size_t)R * Kd + k0) * 2) = w;
    }
    bf16* XN = (bf16*)(a.ws + WS_XN);
    for (int m = gw; m < M; m += NGW) rms_row_to_bf16(xrow_ptr(a, m), a.in[4], XN + (size_t)m * 1024, lane);
}

__device__ __forceinline__ void phase_p2a(const Args& a, LAS unsigned char* lds) {
    PH_PROLOG
    const bf16* PS = (const bf16*)(a.ws + WS_PS); bf16* LX = (bf16*)(a.ws + WS_LX);
    const f32x4 mu = *(const f32x4*)(a.in[6] + 3072 + 4 * lane);
    for (int m = gw; m < M; m += NGW) {
        const bool samp = m >= NPROMPT; const int t = samp ? ((m - NPROMPT) & 63) : (m & 4095);
        const f32x4 p = dec4bf(*(const u32x2*)(PS + (size_t)m * SHW + 3072 + 4 * lane));
        f32x4 pp = (f32x4){0.f, 0.f, 0.f, 0.f};
        if (t > 0) pp = dec4bf(*(const u32x2*)(PS + (size_t)(m - 1) * SHW + 3072 + 4 * lane));
        else if (samp) pp = *(const f32x4*)(a.in[2] + (size_t)((m - NPROMPT) >> 6) * SHW + 3072 + 4 * lane);
        f32x4 x = p + (pp - p) * mu;
        if (lane < 16) {
#pragma unroll
            for (int i = 0; i < 4; ++i) x[i] = 1.f - 2.f * __builtin_amdgcn_rcpf(__expf(2.f * x[i]) + 1.f); }
        else if (lane >= 32) {
#pragma unroll
            for (int i = 0; i < 4; ++i) x[i] = sigm(x[i]); }
        *(u32x2*)(LX + (size_t)m * 256 + 4 * lane) = pk4bf(x);
    }
    if (gw < 40) {
        const int row = gw < 8 ? gw * 4096 + 4095 : NPROMPT + (gw - 8) * 64 + 63;
        float* dst = a.out + (gw < 8 ? OUT_SHIFT_P + (size_t)gw * SHW : OUT_SHIFT_S + (size_t)(gw - 8) * SHW);
        for (int c = lane; c < SHW; c += 64) dst[c] = bf_lo((unsigned)PS[(size_t)row * SHW + c]);
    }
}

typedef _Float16 h4 __attribute__((ext_vector_type(4)));
typedef _Float16 h8 __attribute__((ext_vector_type(8)));
#define MFMA16(a, b, c) __builtin_amdgcn_mfma_f32_16x16x16f16(a, b, c, 0, 0, 0)
#define MFMA32(a, b, c) __builtin_amdgcn_mfma_f32_16x16x32_f16(a, b, c, 0, 0, 0)
__device__ __forceinline__ h4 cvt_h4(f32x4 v) { h4 r; r[0] = (f16)v[0]; r[1] = (f16)v[1]; r[2] = (f16)v[2]; r[3] = (f16)v[3]; return r; }
__device__ __forceinline__ f32x4 h4_f32(h4 v) { return (f32x4){(float)v[0], (float)v[1], (float)v[2], (float)v[3]}; }
constexpr int CK_NPROD = 6, CK_NCONS = 2, CK_NVB = 4 / CK_NCONS, CK_NSLOT = 5;
constexpr int CKS_ET = 0, CKS_GY = 2048, CKS_BK = 4096, CKS_XV = 8192, CKS_U0 = 10240, CKS_Y0 = 12288, CKS_LC = 14336, CKS_SIZE = 14848;
constexpr int CKP_AT = 0, CKP_BT = 2048, CKP_KT = 4096, CKP_RT = 6144, CKP_ATT = 8192, CKP_EX = 10240, CKP_LR = 11264, CKP_SIZE = 11520;
constexpr int CK_SLOTS = 0, CK_SCR = CK_NSLOT * CKS_SIZE, CK_FLAGS = CK_SCR + CK_NPROD * CKP_SIZE, CK_END = CK_FLAGS + 256;
static_assert(CK_END <= LDS_BYTES - 256, "chunked scan LDS map");
__device__ __forceinline__ int ck_img8(int row, int e4) { return row * 128 + ((((e4 >> 1) ^ (row & 7))) << 4) + ((e4 & 1) << 3); }
__device__ __forceinline__ int ck_img16(int row, int c16) { return row * 128 + ((c16 ^ (row & 7)) << 4); }
__device__ __forceinline__ bf16 f2bf_c(float f) { const unsigned u = __float_as_uint(f); return (bf16)((u + 0x7fffu + ((u >> 16) & 1u)) >> 16); }
__device__ __forceinline__ void ck_wait_ge(volatile LAS unsigned* flag, unsigned target) { while (*flag < target) __builtin_amdgcn_s_sleep(1); asm volatile("" ::: "memory"); }

struct CkRaw { u32x2 r[4], k[4], v[4], lw[4], ar[4], pr, pk, pv; };
__device__ __forceinline__ void ck_load(CkRaw& R, const bf16* PS, const f16* LW, const f16* AR, int mq, int cidx, int m_lo) {
#pragma unroll
    for (int i = 0; i < 4; ++i) { const bf16* base = PS + (size_t)(mq + i) * SHW + cidx;
        R.r[i] = *(const u32x2*)base; R.k[i] = *(const u32x2*)(base + 1024); R.v[i] = *(const u32x2*)(base + 2048);
        R.lw[i] = *(const u32x2*)(LW + (size_t)(mq + i) * 1024 + cidx); R.ar[i] = *(const u32x2*)(AR + (size_t)(mq + i) * 1024 + cidx); }
    const int mp = mq - 1 < m_lo ? m_lo : mq - 1; const bf16* pb = PS + (size_t)mp * SHW + cidx;
    R.pr = *(const u32x2*)pb; R.pk = *(const u32x2*)(pb + 1024); R.pv = *(const u32x2*)(pb + 2048);
}
struct CkK { f32x4 mu_r, mu_k, mu_v, kk, ka; };
__device__ __forceinline__ void ck_prep(LAS unsigned char* slot, LAS unsigned char* scr, const CkRaw& R, const float* const* in, int cidx, bool first, const float* ssrc, int lane) {
    const int q = lane >> 4, kg = lane & 15;
    f32x4 lv[4];
    lv[0] = dec4h(R.lw[0]); lv[1] = dec4h(R.lw[1]) + lv[0]; lv[2] = dec4h(R.lw[2]) + lv[1]; lv[3] = dec4h(R.lw[3]) + lv[2];
    *(LAS f32x4*)(scr + CKP_EX + lane * 16) = lv[3];
    const f32x4 zero4 = (f32x4){0.f, 0.f, 0.f, 0.f};
    f32x4 pre, lref, l15;
    { const f32x4 Q0 = *(const LAS f32x4*)(scr + CKP_EX + kg * 16), Q1 = *(const LAS f32x4*)(scr + CKP_EX + (16 + kg) * 16), Q2 = *(const LAS f32x4*)(scr + CKP_EX + (32 + kg) * 16), Q3 = *(const LAS f32x4*)(scr + CKP_EX + (48 + kg) * 16);
      pre = (q > 0 ? Q0 : zero4) + (q > 1 ? Q1 : zero4) + (q > 2 ? Q2 : zero4); lref = Q0 + Q1; l15 = (Q0 + Q1) + (Q2 + Q3); }
    f32x4 eC, eprev;
    { f32x4 lamref, lamC;
#pragma unroll
      for (int j = 0; j < 4; ++j) { eC[j] = __expf(l15[j] - lref[j]); lamref[j] = __expf(lref[j]); lamC[j] = __expf(l15[j]); eprev[j] = __expf(pre[j] - lref[j]); }
      if (q == 0) { *(LAS f32x4*)(slot + CKS_LC + kg * 16) = lamC; *(LAS f32x4*)(scr + CKP_LR + kg * 16) = lamref; } }
    pre = pre - lref;
    const f32x4 mu_r = *(const f32x4*)(in[6] + cidx), mu_k = *(const f32x4*)(in[6] + 1024 + cidx), mu_v = *(const f32x4*)(in[6] + 2048 + cidx), c_kk = *(const f32x4*)(in[12] + cidx), c_ka = *(const f32x4*)(in[13] + cidx);
    f32x4 pr = dec4bf(R.pr), pk = dec4bf(R.pk), pv = dec4bf(R.pv);
    if (first) { pr = zero4; pk = zero4; pv = zero4; if (ssrc) { pr = *(const f32x4*)ssrc; pk = *(const f32x4*)(ssrc + 1024); pv = *(const f32x4*)(ssrc + 2048); } }
    h4 att[4], bbt[4], kbt[4], xt[4];
#pragma unroll
    for (int i = 0; i < 4; ++i) {
        const f32x4 r = dec4bf(R.r[i]), k = dec4bf(R.k[i]), v = dec4bf(R.v[i]), ar = dec4h(R.ar[i]);
        const f32x4 xr = r + (pr - r) * mu_r, xk = k + (pk - k) * mu_k, xv = v + (pv - v) * mu_v;
        pr = r; pk = k; pv = v;
        const f32x4 kkr = xk * c_kk;
        float ssq = (kkr[0] * kkr[0] + kkr[1] * kkr[1]) + (kkr[2] * kkr[2] + kkr[3] * kkr[3]);
        ssq = row_sum16(ssq);
        const float inv = 1.f / fmaxf(sqrtf(ssq), 1e-12f);
        const f32x4 kkn = kkr * inv;
        f32x4 e, rc;
#pragma unroll
        for (int j = 0; j < 4; ++j) { const float d = lv[i][j] + pre[j]; e[j] = __expf(d); rc[j] = __expf(-d); }
        const f32x4 at = -kkn * eprev, bt = kkn * ar * rc, kt = xk * (1.f + (ar - 1.f) * c_ka) * rc, rt = xr * e, bb = bt * eC, kb = kt * eC;
        eprev = e;
        const int o = ck_img8(4 * q + i, kg);
        *(LAS h4*)(scr + CKP_AT + o) = cvt_h4(at); *(LAS h4*)(scr + CKP_BT + o) = cvt_h4(bt); *(LAS h4*)(scr + CKP_KT + o) = cvt_h4(kt); *(LAS h4*)(scr + CKP_RT + o) = cvt_h4(rt);
#pragma unroll
        for (int j = 0; j < 4; ++j) { att[j][i] = (f16)at[j]; bbt[j][i] = (f16)bb[j]; kbt[j][i] = (f16)kb[j]; xt[j][i] = (f16)xv[j]; }
    }
#pragma unroll
    for (int j = 0; j < 4; ++j) {
        const int key = 4 * kg + j;
        *(LAS h4*)(scr + CKP_ATT + key * 32 + q * 8) = att[j];
        *(LAS h4*)(slot + CKS_BK + key * 64 + q * 16) = bbt[j]; *(LAS h4*)(slot + CKS_BK + key * 64 + q * 16 + 8) = kbt[j];
        *(LAS h4*)(slot + CKS_XV + key * 32 + q * 8) = xt[j];
    }
}
__device__ __forceinline__ void ck_mfma(LAS unsigned char* slot, LAS unsigned char* scr, int lane) {
    const int n = lane & 15, q = lane >> 4;
    const f32x4 z4 = (f32x4){0.f, 0.f, 0.f, 0.f};
    f32x4 Nab = z4, NabT = z4, NakT = z4, Nbr = z4, Nkr = z4;
#pragma unroll
    for (int ks = 0; ks < 2; ++ks) {
        const int o = ck_img16(n, 4 * ks + q);
        const h8 fa = *(const LAS h8*)(scr + CKP_AT + o), fb = *(const LAS h8*)(scr + CKP_BT + o), fk = *(const LAS h8*)(scr + CKP_KT + o), fr8 = *(const LAS h8*)(scr + CKP_RT + o);
        Nab = MFMA32(fb, fa, Nab); NabT = MFMA32(fa, fb, NabT); NakT = MFMA32(fa, fk, NakT); Nbr = MFMA32(fb, fr8, Nbr); Nkr = MFMA32(fk, fr8, Nkr);
    }
    f32x4 P, Qm, MakT, Mbr, Mkr, Tm, Tt;
#pragma unroll
    for (int ii = 0; ii < 4; ++ii) { const int row = 4 * q + ii;
        P[ii] = row < n ? Nab[ii] : 0.f; Qm[ii] = n < row ? NabT[ii] : 0.f; MakT[ii] = n < row ? NakT[ii] : 0.f;
        Mbr[ii] = row <= n ? Nbr[ii] : 0.f; Mkr[ii] = row <= n ? Nkr[ii] : 0.f;
        const float id = row == n ? 1.f : 0.f; Tm[ii] = id + P[ii]; Tt[ii] = id + Qm[ii]; }
#pragma unroll
    for (int lev = 0; lev < 3; ++lev) {
        const h4 hp = cvt_h4(P), hq = cvt_h4(Qm);
        const f32x4 P2 = MFMA16(hq, hp, z4), Q2 = MFMA16(hp, hq, z4);
        const h4 hp2 = cvt_h4(P2), hq2 = cvt_h4(Q2), ht = cvt_h4(Tm), htt = cvt_h4(Tt);
        const f32x4 Tn = MFMA16(htt, hp2, Tm), Ttn = MFMA16(hp2, htt, Tt);
        P = P2; Qm = Q2; Tm = Tn; Tt = Ttn; (void)ht; (void)hq2;
    }
    const h4 hT = cvt_h4(Tm), hMbr = cvt_h4(Mbr), hMakT = cvt_h4(MakT);
    const f32x4 F = MFMA16(hMakT, hT, z4);
    const f32x4 Ft = MFMA16(hT, hMakT, z4);
    const h4 hF = cvt_h4(F), hFt = cvt_h4(Ft);
    const f32x4 Hy = MFMA16(hFt, hMbr, Mkr);
    const h4 hHy = cvt_h4(Hy);
#pragma unroll
    for (int kb = 0; kb < 4; ++kb) {
        const h4 fat = *(const LAS h4*)(scr + CKP_ATT + (16 * kb + n) * 32 + q * 8);
        const f32x4 lam = *(const LAS f32x4*)(scr + CKP_LR + (16 * kb + 4 * q) * 4);
        const f32x4 E = MFMA16(fat, hT, z4);
        const f32x4 Et = MFMA16(hT, fat, z4);
        const int oe = ck_img8(n, 8 * (kb >> 1) + 2 * q + (kb & 1));
        *(LAS h4*)(slot + CKS_ET + oe) = cvt_h4(E * lam);
        const f32x4 rt = h4_f32(*(const LAS h4*)(scr + CKP_RT + ck_img8(n, 4 * kb + q)));
        const f32x4 Gy = MFMA16(cvt_h4(Et), hMbr, rt);
        *(LAS h4*)(slot + CKS_GY + oe) = cvt_h4(Gy * lam);
        const h4 fx = *(const LAS h4*)(slot + CKS_XV + (16 * kb + n) * 32 + q * 8);
        const f32x4 U0 = MFMA16(hF, fx, z4), Y0 = MFMA16(hHy, fx, z4);
        *(LAS h4*)(slot + CKS_U0 + kb * 512 + lane * 8) = cvt_h4(U0); *(LAS h4*)(slot + CKS_Y0 + kb * 512 + lane * 8) = cvt_h4(Y0);
    }
}
__device__ __forceinline__ void ck_consume(const LAS unsigned char* slot, f32x4 (&Sb)[4], int vb, int lane, bf16* Yrow  ) {
    const int n = lane & 15, q = lane >> 4;
    f32x4 U = h4_f32(*(const LAS h4*)(slot + CKS_U0 + vb * 512 + lane * 8)), Yv = h4_f32(*(const LAS h4*)(slot + CKS_Y0 + vb * 512 + lane * 8));
#pragma unroll
    for (int ks = 0; ks < 2; ++ks) {
        const int o = ck_img16(n, 4 * ks + q);
        const h8 fe = *(const LAS h8*)(slot + CKS_ET + o), fg = *(const LAS h8*)(slot + CKS_GY + o);
        h8 fs;
#pragma unroll
        for (int j = 0; j < 8; ++j) fs[j] = (f16)Sb[2 * ks + (j >> 2)][j & 3];
        U = MFMA32(fe, fs, U); Yv = MFMA32(fg, fs, Yv);
    }
#pragma unroll
    for (int ii = 0; ii < 4; ++ii) Yrow[(size_t)(4 * q + ii) * 1024 + 16 * vb + n] = f2bf_c(Yv[ii]);
    const h4 fx = *(const LAS h4*)(slot + CKS_XV + (16 * vb + n) * 32 + q * 8);
    h8 fuv;
#pragma unroll
    for (int j = 0; j < 4; ++j) { fuv[j] = (f16)U[j]; fuv[4 + j] = fx[j]; }
#pragma unroll
    for (int kb = 0; kb < 4; ++kb) {
        const h8 fbk = *(const LAS h8*)(slot + CKS_BK + (16 * kb + n) * 64 + q * 16);
        const f32x4 lam = *(const LAS f32x4*)(slot + CKS_LC + (16 * kb + 4 * q) * 4);
        Sb[kb] = MFMA32(fbk, fuv, Sb[kb] * lam);
    }
}
__device__ __forceinline__ void phase_scan(const Args& a, LAS unsigned char* lds) {
    PH_PROLOG
    const bf16* PS = (const bf16*)(a.ws + WS_PS); const f16* LW = (const f16*)((const unsigned char*)a.out + U); const f16* AR = (const f16*)(a.ws + WS_AR);
    bf16* Y = (bf16*)a.out;
    volatile LAS unsigned* ready = (volatile LAS unsigned*)(lds + CK_FLAGS); volatile LAS unsigned* done = ready + 8;
    const int nsw = G > 128 ? G - 128 : G, sw0 = G > 128 ? 128 : 0;
    for (int pass = 0;; ++pass) {
        int task;
        if (G > 128) { if (bid < 128) { if (pass > 0) break; task = bid; } else { task = 128 + (bid - 128) + pass * nsw; if (task >= 640) break; } }
        else { task = bid + pass * G; if (task >= 640) break; }
        (void)sw0;
        const bool samp = task >= 128; const int tq = samp ? task - 128 : task;
        const int b = tq >> 4, h = tq & 15;
        const int m0 = samp ? NPROMPT + b * 64 : b * 4096, nch = samp ? 4 : 256;
        if (tid < 16) ready[tid] = 0u;
        __syncthreads();
        if (wave < CK_NPROD) {
            const int q = lane >> 4, kg = lane & 15, cidx = h * 64 + 4 * kg;
            const float* ssrc = samp ? a.in[2] + (size_t)b * SHW + cidx : nullptr;
            LAS unsigned char* scr = lds + CK_SCR + wave * CKP_SIZE;
            CkRaw R;
            if (wave < nch) ck_load(R, PS, LW, AR, m0 + 16 * wave + 4 * q, cidx, m0);
            for (int c = wave; c < nch; c += CK_NPROD) {
                LAS unsigned char* slot = lds + CK_SLOTS + (c % CK_NSLOT) * CKS_SIZE;
                if (c >= CK_NSLOT) {
#pragma unroll
                    for (int j = 0; j < CK_NCONS; ++j) ck_wait_ge(done + j, (unsigned)(c - CK_NSLOT + 1));
                }
                ck_prep(slot, scr, R, a.in, cidx, c == 0 && q == 0, ssrc, lane);
                if (c + CK_NPROD < nch) ck_load(R, PS, LW, AR, m0 + 16 * (c + CK_NPROD) + 4 * q, cidx, m0);
                ck_mfma(slot, scr, lane);
                asm volatile("s_waitcnt lgkmcnt(0)" ::: "memory");
                if (lane == 0) ready[c % CK_NSLOT] = (unsigned)(c + 1);
            }
        } else if (wave < CK_NPROD + CK_NCONS) {
            const int cj = wave - CK_NPROD, n = lane & 15, q = lane >> 4;
            f32x4 Sb[CK_NVB][4];
#pragma unroll
            for (int v = 0; v < CK_NVB; ++v)
#pragma unroll
                for (int kb = 0; kb < 4; ++kb) {
                    Sb[v][kb] = (f32x4){0.f, 0.f, 0.f, 0.f};
                    if (samp) Sb[v][kb] = *(const f32x4*)(a.in[3] + ((size_t)((b * 16 + h) * 64 + 16 * (cj * CK_NVB + v) + n)) * 64 + 16 * kb + 4 * q);
                }
            for (int c = 0; c < nch; ++c) {
                const LAS unsigned char* slot = lds + CK_SLOTS + (c % CK_NSLOT) * CKS_SIZE;
                ck_wait_ge(ready + (c % CK_NSLOT), (unsigned)(c + 1));
                asm volatile("" ::: "memory");
#pragma unroll
                for (int v = 0; v < CK_NVB; ++v) ck_consume(slot, Sb[v], cj * CK_NVB + v, lane, Y + (size_t)(m0 + 16 * c) * 1024 + h * 64);
                asm volatile("s_waitcnt lgkmcnt(0)" ::: "memory");
                if (lane == 0) done[cj] = (unsigned)(c + 1);
            }
            float* So = a.out + (samp ? OUT_WKV_S : OUT_WKV_P);
#pragma unroll
            for (int v = 0; v < CK_NVB; ++v)
#pragma unroll
                for (int kb = 0; kb < 4; ++kb) *(f32x4*)(So + ((size_t)((b * 16 + h) * 64 + 16 * (cj * CK_NVB + v) + n)) * 64 + 16 * kb + 4 * q) = Sb[v][kb];
        }
        __syncthreads();
    }
}

__device__ __forceinline__ void ld16bf(const bf16* p, float (&o)[16]) {
    const u32x4 w0 = *(const u32x4*)p, w1 = *(const u32x4*)(p + 8); f32x4 a, b, c, d; dec8bf(w0, a, b); dec8bf(w1, c, d);
#pragma unroll
    for (int i = 0; i < 4; ++i) { o[i] = a[i]; o[4 + i] = b[i]; o[8 + i] = c[i]; o[12 + i] = d[i]; }
}
__device__ __forceinline__ void ld16h(const f16* p, float (&o)[16]) {
    const u32x4 w0 = *(const u32x4*)p, w1 = *(const u32x4*)(p + 8);
    const f32x4 a = dec4h((u32x2){w0.x, w0.y}), b = dec4h((u32x2){w0.z, w0.w}), c = dec4h((u32x2){w1.x, w1.y}), d = dec4h((u32x2){w1.z, w1.w});
#pragma unroll
    for (int i = 0; i < 4; ++i) { o[i] = a[i]; o[4 + i] = b[i]; o[8 + i] = c[i]; o[12 + i] = d[i]; }
}
__device__ __forceinline__ void ld16f(const float* p, float (&o)[16]) {
#pragma unroll
    for (int j = 0; j < 4; ++j) { const f32x4 x = ((const f32x4*)p)[j];
#pragma unroll
        for (int i = 0; i < 4; ++i) o[4 * j + i] = x[i]; }
}
__device__ __forceinline__ void tokshift16(float (&x)[16], const bf16* prevp, bool has_prev, bool samp, const float* ssrc, const float* mu) {
    float tmp[16], cst[16];
    if (has_prev) ld16bf(prevp, tmp);
    else if (samp) ld16f(ssrc, tmp);
    else {
#pragma unroll
        for (int i = 0; i < 16; ++i) tmp[i] = 0.f; }
    ld16f(mu, cst);
#pragma unroll
    for (int i = 0; i < 16; ++i) x[i] = x[i] + (tmp[i] - x[i]) * cst[i];
}
__device__ __forceinline__ float oct_sum(float x) { x += dppf<0xB1>(x); x += dppf<0x4E>(x); x += dppf<0x141>(x); return x; }
__device__ __forceinline__ void ld8f(const float* p, float (&o)[8]) { const f32x4 a = *(const f32x4*)p, b = *(const f32x4*)(p + 4);
#pragma unroll
    for (int i = 0; i < 4; ++i) { o[i] = a[i]; o[4 + i] = b[i]; } }
__device__ __forceinline__ void ld8bf(const bf16* p, float (&o)[8]) { f32x4 a, b; dec8bf(*(const u32x4*)p, a, b);
#pragma unroll
    for (int i = 0; i < 4; ++i) { o[i] = a[i]; o[4 + i] = b[i]; } }
__device__ __forceinline__ void ld8h(const f16* p, float (&o)[8]) { const u32x4 w = *(const u32x4*)p; const f32x4 a = dec4h((u32x2){w.x, w.y}), b = dec4h((u32x2){w.z, w.w});
#pragma unroll
    for (int i = 0; i < 4; ++i) { o[i] = a[i]; o[4 + i] = b[i]; } }
template <bool DRY> __device__ __forceinline__ void phase_gn(const Args& a, LAS unsigned char* lds) {
    PH_PROLOG
    const bf16* PS = (const bf16*)(a.ws + WS_PS); const f16* AR = (const f16*)(a.ws + WS_AR); f16* Gp = (f16*)(a.ws + WS_G);
    const bf16* Y = (const bf16*)a.out;
    const int h = gw & 15, c = h * 64 + 8 * (lane & 7), r8 = lane >> 3;
    float mu_r[8], mu_k[8], mu_v[8], ka[8], rkc[8], gg[8], gb[8];
    ld8f(a.in[6] + c, mu_r); ld8f(a.in[6] + 1024 + c, mu_k); ld8f(a.in[6] + 2048 + c, mu_v); ld8f(a.in[13] + c, ka); ld8f(a.in[14] + c, rkc); ld8f(a.in[15] + c, gg); ld8f(a.in[16] + c, gb);
    for (int rg = gw >> 4; rg < M / 8; rg += NGW >> 4) {
        const int m = rg * 8 + r8; const bool samp = m >= NPROMPT; const int t = samp ? ((m - NPROMPT) & 63) : (m & 4095);
        const bf16* base = PS + (size_t)m * SHW + c;
        float xr[8], xk[8], xv[8], pr[8], pk[8], pv[8], ar[8], y[8], g[8];
        ld8bf(base, xr); ld8bf(base + 1024, xk); ld8bf(base + 2048, xv);
        if (t > 0) { ld8bf(base - SHW, pr); ld8bf(base - SHW + 1024, pk); ld8bf(base - SHW + 2048, pv); }
        else if (samp) { const float* ss = a.in[2] + (size_t)((m - NPROMPT) >> 6) * SHW + c; ld8f(ss, pr); ld8f(ss + 1024, pk); ld8f(ss + 2048, pv); }
        else {
#pragma unroll
            for (int i = 0; i < 8; ++i) { pr[i] = 0.f; pk[i] = 0.f; pv[i] = 0.f; } }
        ld8h(AR + (size_t)m * 1024 + c, ar); ld8bf(Y + (size_t)m * 1024 + c, y); ld8h(Gp + (size_t)m * 1024 + c, g);
        float rk = 0.f, s = 0.f;
#pragma unroll
        for (int i = 0; i < 8; ++i) {
            xr[i] = xr[i] + (pr[i] - xr[i]) * mu_r[i]; xk[i] = xk[i] + (pk[i] - xk[i]) * mu_k[i]; xv[i] = xv[i] + (pv[i] - xv[i]) * mu_v[i];
            xk[i] = xk[i] * (1.f + (ar[i] - 1.f) * ka[i]);
            rk += xr[i] * xk[i] * rkc[i]; s += y[i];
        }
        rk = oct_sum(rk);
        const float mean = oct_sum(s) * (1.f / 64.f); float q2 = 0.f;
#pragma unroll
        for (int i = 0; i < 8; ++i) { y[i] -= mean; q2 += y[i] * y[i]; }
        const float rstd = rsqrtf(oct_sum(q2) * (1.f / 64.f) + 64e-5f);
        float o[8];
#pragma unroll
        for (int i = 0; i < 8; ++i) o[i] = (y[i] * rstd * gg[i] + gb[i] + rk * xv[i]) * g[i];
        u32x4 w; w.x = pkbf(o[0], o[1]); w.y = pkbf(o[2], o[3]); w.z = pkbf(o[4], o[5]); w.w = pkbf(o[6], o[7]);
        if (!DRY || rk == 1.2345e30f) *(u32x4*)((bf16*)Gp + (size_t)m * 1024 + c) = w;
    }
}

__device__ __forceinline__ int gm_swz(int row) { return (row & 3) | (((row >> 3) & 1) << 2); }
__device__ __forceinline__ void phase_gmlp(const Args& a, LAS unsigned char* lds) {
    PH_PROLOG
    const bf16* PU = (const bf16*)(a.ws + WS_P4); const bf16* PV = (const bf16*)(a.ws + WS_P4 + U); bf16* OB = (bf16*)(a.ws + WS_OB);
    const bf16* WSP = (const bf16*)(a.ws + WS_WSP);
    LAS float* stats = (LAS float*)lds;
    LAS unsigned char* img = lds + 4096;
    for (int unit = bid; unit < 272; unit += G) {
        const bool samp = unit >= 256; const int m0 = unit * 128;
        for (int i = 0; i < 16; ++i) {
            const int tk = wave * 16 + i; float x[16]; ld16bf(PV + (size_t)(m0 + tk) * 1024 + 16 * lane, x);
            float s = 0.f;
#pragma unroll
            for (int j = 0; j < 16; ++j) s += x[j];
            const float mean = wave_sum(s) * (1.f / 1024.f); float q2 = 0.f;
#pragma unroll
            for (int j = 0; j < 16; ++j) { x[j] -= mean; q2 += x[j] * x[j]; }
            const float rstd = rsqrtf(wave_sum(q2) * (1.f / 1024.f) + 1e-5f);
            if (lane == 0) { stats[2 * tk] = mean; stats[2 * tk + 1] = rstd; }
            if (samp) {
                float g[16], bb[16]; ld16f(a.in[17] + 16 * lane, g); ld16f(a.in[18] + 16 * lane, bb);
                float* o = a.out + OUT_VS + (size_t)(m0 + tk - NPROMPT) * 1024 + 16 * lane;
#pragma unroll
                for (int j = 0; j < 4; ++j) ((f32x4*)o)[j] = (f32x4){x[4 * j] * rstd * g[4 * j] + bb[4 * j], x[4 * j + 1] * rstd * g[4 * j + 1] + bb[4 * j + 1], x[4 * j + 2] * rstd * g[4 * j + 2] + bb[4 * j + 2], x[4 * j + 3] * rstd * g[4 * j + 3] + bb[4 * j + 3]};
            }
        }
        __syncthreads();
        const int trow_off = (samp && wave >= 4) ? 64 : 0, t0 = wave * 16;
        const int ks_lo = trow_off >> 5, ks_hi = (t0 + 15) >> 5;
        for (int g = 0; g < 8; ++g) {
#pragma unroll
            for (int i = 0; i < 4; ++i) {
                const int p = tid + 512 * i, row = p >> 4, c8 = p & 15, gc = g * 128 + 8 * c8;
                f32x4 x0, x1; dec8bf(*(const u32x4*)(PV + (size_t)(m0 + row) * 1024 + gc), x0, x1);
                const float mean = stats[2 * row], rstd = stats[2 * row + 1];
                const f32x4 g0 = *(const f32x4*)(a.in[17] + gc), g1 = *(const f32x4*)(a.in[17] + gc + 4), b0 = *(const f32x4*)(a.in[18] + gc), b1 = *(const f32x4*)(a.in[18] + gc + 4);
                x0 = (x0 - mean) * rstd * g0 + b0; x1 = (x1 - mean) * rstd * g1 + b1;
                *(LAS u32x4*)(img + row * 256 + (((c8 >> 1) ^ gm_swz(row)) << 5) + (c8 & 1) * 16) = pk8bf(x0, x1);
            }
            __syncthreads();
            f32x4 acc[8];
#pragma unroll
            for (int ct = 0; ct < 8; ++ct) acc[ct] = (f32x4){0.f, 0.f, 0.f, 0.f};
            for (int ks = ks_lo; ks <= ks_hi; ++ks) {
                const bf16x8 wf = *(const bf16x8*)(WSP + ((size_t)(g * 128 + t0 - trow_off + (lane & 15))) * 128 + 32 * ks - trow_off + 8 * (lane >> 4));
                const int row = 32 * ks + 8 * (lane >> 4) + ((lane & 15) >> 2);
                const int sw = gm_swz(row);
#pragma unroll
                for (int ct = 0; ct < 8; ++ct) {
                    LAS unsigned char* p = img + row * 256 + ((ct ^ sw) << 5) + (lane & 3) * 8;
                    const s16x4 lo = __builtin_amdgcn_ds_read_tr16_b64_v4i16((LAS s16x4*)p), hi = __builtin_amdgcn_ds_read_tr16_b64_v4i16((LAS s16x4*)(p + 1024));
                    bf16x8 vf; vf[0] = lo[0]; vf[1] = lo[1]; vf[2] = lo[2]; vf[3] = lo[3]; vf[4] = hi[0]; vf[5] = hi[1]; vf[6] = hi[2]; vf[7] = hi[3];
                    acc[ct] = __builtin_amdgcn_mfma_f32_16x16x32_bf16(vf, wf, acc[ct], 0, 0, 0);
                }
            }
            const int t = t0 + (lane & 15);
            const float bias = a.in[20][g * 128 + t - trow_off];
#pragma unroll
            for (int ct = 0; ct < 8; ++ct) {
                const size_t o = (size_t)(m0 + t) * 1024 + g * 128 + 16 * ct + 4 * (lane >> 4);
                const f32x4 pu = dec4bf(*(const u32x2*)(PU + o));
                *(u32x2*)(OB + o) = pk4bf(pu * (acc[ct] + bias));
            }
            __syncthreads();
        }
    }
}

__device__ __forceinline__ void phase_p5b(const Args& a, LAS unsigned char* lds) {
    PH_PROLOG
    const float* MO = (const float*)(a.ws + WS_MO); bf16* F = (bf16*)(a.ws + WS_F);
    for (int m = gw; m < M; m += NGW) {
        const float* xr = xrow_ptr(a, m); f32x4 v[4]; float ss = 0.f;
#pragma unroll
        for (int j = 0; j < 4; ++j) { v[j] = ((const f32x4*)(MO + (size_t)m * 1024))[lane + 64 * j]; ss += (v[j][0] * v[j][0] + v[j][1] * v[j][1]) + (v[j][2] * v[j][2] + v[j][3] * v[j][3]); }
        const float rs = rsqrtf(wave_sum(ss) * (1.f / 1024.f) + 1e-6f); float s2 = 0.f;
#pragma unroll
        for (int j = 0; j < 4; ++j) { const f32x4 g = ((const f32x4*)a.in[24])[lane + 64 * j], x = ((const f32x4*)xr)[lane + 64 * j];
            v[j] = x + v[j] * rs * g; ((f32x4*)(a.out + OUT_Y + (size_t)m * 1024))[lane + 64 * j] = v[j];
            s2 += (v[j][0] * v[j][0] + v[j][1] * v[j][1]) + (v[j][2] * v[j][2] + v[j][3] * v[j][3]); }
        const float rs2 = rsqrtf(wave_sum(s2) * (1.f / 1024.f) + 1e-6f);
#pragma unroll
        for (int j = 0; j < 4; ++j) { const f32x4 g = ((const f32x4*)a.in[25])[lane + 64 * j]; ((u32x2*)(F + (size_t)m * 1024))[lane + 64 * j] = pk4bf(v[j] * rs2 * g); }
    }
}
__device__ __forceinline__ void phase_p7b(const Args& a, LAS unsigned char* lds) {
    PH_PROLOG
    const float* F2 = (const float*)(a.ws + WS_F2);
    for (int m = gw; m < M; m += NGW) {
        f32x4 v[4]; float ss = 0.f;
#pragma unroll
        for (int j = 0; j < 4; ++j) { v[j] = ((const f32x4*)(F2 + (size_t)m * 1024))[lane + 64 * j]; ss += (v[j][0] * v[j][0] + v[j][1] * v[j][1]) + (v[j][2] * v[j][2] + v[j][3] * v[j][3]); }
        const float rs = rsqrtf(wave_sum(ss) * (1.f / 1024.f) + 1e-6f);
        f32x4* o = (f32x4*)(a.out + OUT_Y + (size_t)m * 1024);
#pragma unroll
        for (int j = 0; j < 4; ++j) { const f32x4 g = ((const f32x4*)a.in[29])[lane + 64 * j]; o[lane + 64 * j] = o[lane + 64 * j] + v[j] * rs * g; }
    }
}

#define XB_TMO      128
#define XB_XCNT(j)  (256  + 64 * (j))
#define XB_XSUB(j)  (1280 + 64 * (j))
#define XB_XGEN(j)  (2304 + 64 * (j))
#define XB_TOP      3328
#define XB_TOPGEN   3392
#define XCD_BAR_WORDS 3456
#define XB_SPIN_CAP (1u << 18)

__device__ __forceinline__ unsigned xb_ld(unsigned* p)              { return __hip_atomic_load(p, __ATOMIC_RELAXED, __HIP_MEMORY_SCOPE_AGENT); }
__device__ __forceinline__ unsigned xb_add(unsigned* p, unsigned v) { return __hip_atomic_fetch_add(p, v, __ATOMIC_RELAXED, __HIP_MEMORY_SCOPE_AGENT); }
__device__ __forceinline__ unsigned xb_xcc_id() { return (unsigned)__builtin_amdgcn_s_getreg((3 << 11) | 20) & 0xFu; }
#define XB_SPIN(cond, bar) do { unsigned _sp = 0; while (cond) { __builtin_amdgcn_s_sleep(1); \
    if ((++_sp & 255u) == 0u) { if (xb_ld(&(bar)[XB_TMO])) break; if (_sp > XB_SPIN_CAP) { atomicAdd(&(bar)[XB_TMO], 1u); break; } } } } while (0)

struct XcdBarrier {
    unsigned* bar; unsigned x;
    volatile LAS unsigned* st;
};

__device__ __forceinline__ XcdBarrier xcd_barrier_post(unsigned* bar, volatile LAS unsigned* st) {
    XcdBarrier b; b.bar = bar; b.x = xb_xcc_id(); b.st = st;
    if (threadIdx.x == 0) (void)xb_add(&bar[XB_XCNT(b.x)], 1u);
    return b;
}
__device__ __forceinline__ void xcd_barrier_complete(unsigned* bar, unsigned x, unsigned& nloc, unsigned& nx) {
    const unsigned G = gridDim.x * gridDim.y * gridDim.z;
    unsigned sum, cnt, mine, sp = 0u;
    for (;;) {
        sum = 0u; cnt = 0u; mine = 0u;
#pragma unroll
        for (unsigned j = 0; j < 16; ++j) { const unsigned c = xb_ld(&bar[XB_XCNT(j)]); sum += c; cnt += (c > 0u) ? 1u : 0u; mine = (j == x) ? c : mine; }
        if (sum == G) break;
        __builtin_amdgcn_s_sleep(1);
        if ((++sp & 255u) == 0u) { if (xb_ld(&bar[XB_TMO])) break; if (sp > XB_SPIN_CAP) { atomicAdd(&bar[XB_TMO], 1u); break; } }
    }
    nloc = mine > 0u ? mine : 1u; nx = cnt > 0u ? cnt : 1u;
}

__device__ __forceinline__ void xcd_barrier(const XcdBarrier& b) {
    asm volatile("s_waitcnt vmcnt(0)" ::: "memory");
    __syncthreads();
    if (threadIdx.x == 0) {
        unsigned* bar = b.bar;
        __builtin_amdgcn_s_waitcnt(0);
        unsigned nloc = b.st[0], nx = b.st[1];
        if (nloc == 0u) { xcd_barrier_complete(bar, b.x, nloc, nx); b.st[0] = nloc; b.st[1] = nx; }
        const unsigned old = xb_add(&bar[XB_XSUB(b.x)], 1u);
        const unsigned gen = old / nloc;
        if (old + 1u == (gen + 1u) * nloc) {
            __builtin_amdgcn_fence(__ATOMIC_RELEASE, "agent");
            asm volatile("s_waitcnt vmcnt(0)" ::: "memory");
            const unsigned og = xb_add(&bar[XB_TOP], 1u);
            const unsigned tg = og / nx;
            if (og + 1u == (tg + 1u) * nx) xb_add(&bar[XB_TOPGEN], 1u);
            else XB_SPIN(xb_ld(&bar[XB_TOPGEN]) == tg, bar);
            __builtin_amdgcn_fence(__ATOMIC_ACQUIRE, "agent");
            xb_add(&bar[XB_XGEN(b.x)], 1u);
            asm volatile("s_waitcnt vmcnt(0)" ::: "memory");
        } else {
            XB_SPIN(xb_ld(&bar[XB_XGEN(b.x)]) == gen, bar);
            __builtin_amdgcn_fence(__ATOMIC_ACQUIRE, "agent");
            asm volatile("s_waitcnt vmcnt(0)" ::: "memory");
        }
    }
    __syncthreads();
}

template <class E> __device__ __forceinline__ void run_gemm(LAS unsigned char* lds, const bf16* A, const bf16* Bt, int N, int K, const E& e) {
    pg8::Gemm g{A, Bt, M, N, K}; pg8::StaticOrder S; S.init(M, N, (int)gridDim.x, (int)blockIdx.x);
    pg8::gemm_phase<E, pg8::StaticOrder, true, true>(lds, g, S, e);
}
__global__ void __launch_bounds__(512, 2) mk_fwd(Args a) {
    extern __shared__ __attribute__((aligned(16))) unsigned char lds_raw[];
    LAS unsigned char* lds = (LAS unsigned char*)lds_raw;
    unsigned char* ws = a.ws;
    const int lo = a.ph_lo, hi = a.ph_hi;
    volatile LAS unsigned* MISC = (volatile LAS unsigned*)(lds + LDS_BYTES - 256);
    if (threadIdx.x < 64) MISC[threadIdx.x] = 0u;
    __syncthreads();
#define IN(k) (lo <= (k) && (k) < hi)
#ifndef MK_REP
#define MK_REP -1
#endif
#define XBAR() do { XcdBarrier b_; b_.bar = (unsigned*)a.ws; b_.x = xb_xcc_id(); b_.st = (volatile LAS unsigned*)(lds + LDS_BYTES - 256) + 8; xcd_barrier(b_); } while (0)
#define SEAM(k) do { if (IN(k) && IN((k) + 1)) { if ((k) == 0) { cg::this_grid().sync(); if (threadIdx.x == 0) (void)xb_add((unsigned*)a.ws + XB_XCNT(xb_xcc_id()), 1u); } else XBAR(); } } while (0)
#define REP(k, ...) do { if (MK_REP == (k)) { XBAR(); __VA_ARGS__; } } while (0)
    if (IN(0)) { phase_p0(a, lds); REP(0, phase_p0(a, lds)); } SEAM(0);
    if (IN(1)) { Epi8<FStoreBf16> e{{(bf16*)(ws + WS_PS), SHW}}; run_gemm(lds, (const bf16*)(ws + WS_XN), (const bf16*)(ws + WS_WIN), SHW, 1024, e); REP(1, Epi8<FStoreBf16> e{{(bf16*)(ws + WS_PS), SHW}}; run_gemm(lds, (const bf16*)(ws + WS_XN), (const bf16*)(ws + WS_WIN), SHW, 1024, e)); } SEAM(1);
    if (IN(2)) { phase_p2a(a, lds); REP(2, phase_p2a(a, lds)); } SEAM(2);
    if (IN(3)) { Epi8<FLora> e{{(f16*)((unsigned char*)a.out + U), (f16*)(ws + WS_AR), (f16*)(ws + WS_G), a.in[7], a.in[9]}}; run_gemm(lds, (const bf16*)(ws + WS_LX), (const bf16*)(ws + WS_LORA), 3072, 256, e); REP(3, Epi8<FLora> e{{(f16*)((unsigned char*)a.out + U), (f16*)(ws + WS_AR), (f16*)(ws + WS_G), a.in[7], a.in[9]}}; run_gemm(lds, (const bf16*)(ws + WS_LX), (const bf16*)(ws + WS_LORA), 3072, 256, e)); } SEAM(3);
    if (IN(4)) { phase_scan(a, lds); REP(4, phase_scan(a, lds)); } SEAM(4);
    if (IN(5)) { phase_gn<false>(a, lds); REP(5, phase_gn<true>(a, lds)); } SEAM(5);
    if (IN(6)) { Epi8<FP1b> e{{(bf16*)(ws + WS_P4)}}; run_gemm(lds, (const bf16*)(ws + WS_XN), (const bf16*)(ws + WS_WIN) + (size_t)SHW * 1024, 4096, 1024, e); REP(6, Epi8<FP1b> e{{(bf16*)(ws + WS_P4)}}; run_gemm(lds, (const bf16*)(ws + WS_XN), (const bf16*)(ws + WS_WIN) + (size_t)SHW * 1024, 4096, 1024, e)); } SEAM(6);
    if (IN(7)) { phase_gmlp(a, lds); REP(7, phase_gmlp(a, lds)); } SEAM(7);
    if (IN(8)) { Epi8<FGateA> e{{(const bf16*)(ws + WS_P4 + 2 * U), (bf16*)(ws + WS_MM)}}; run_gemm(lds, (const bf16*)(ws + WS_OA), (const bf16*)(ws + WS_WA), 1024, 1024, e); REP(8, Epi8<FGateA> e{{(const bf16*)(ws + WS_P4 + 2 * U), (bf16*)(ws + WS_MM)}}; run_gemm(lds, (const bf16*)(ws + WS_OA), (const bf16*)(ws + WS_WA), 1024, 1024, e)); } SEAM(8);
    if (IN(9)) { Epi8<FGateB> e{{(const bf16*)(ws + WS_P4 + 3 * U), (bf16*)(ws + WS_MM)}}; run_gemm(lds, (const bf16*)(ws + WS_OB), (const bf16*)(ws + WS_WB), 1024, 1024, e); REP(9, Epi8<FGateB> e{{(const bf16*)(ws + WS_P4 + 3 * U), (bf16*)(ws + WS_MM)}}; run_gemm(lds, (const bf16*)(ws + WS_OB), (const bf16*)(ws + WS_WB), 1024, 1024, e)); } SEAM(9);
    if (IN(10)) { Epi4<FStoreF32> e{{(float*)(ws + WS_MO), 1024}}; run_gemm(lds, (const bf16*)(ws + WS_MM), (const bf16*)(ws + WS_WO), 1024, 1024, e); REP(10, Epi4<FStoreF32> e{{(float*)(ws + WS_MO), 1024}}; run_gemm(lds, (const bf16*)(ws + WS_MM), (const bf16*)(ws + WS_WO), 1024, 1024, e)); } SEAM(10);
    if (IN(11)) { phase_p5b(a, lds); REP(11, phase_p5b(a, lds)); } SEAM(11);
    if (IN(12)) { EpiGU e{(bf16*)(ws + WS_H)}; run_gemm(lds, (const bf16*)(ws + WS_F), (const bf16*)(ws + WS_GU), 2 * DFF, 1024, e); REP(12, EpiGU e{(bf16*)(ws + WS_H)}; run_gemm(lds, (const bf16*)(ws + WS_F), (const bf16*)(ws + WS_GU), 2 * DFF, 1024, e)); } SEAM(12);
    if (IN(13)) { Epi4<FStoreF32> e{{(float*)(ws + WS_F2), 1024}}; run_gemm(lds, (const bf16*)(ws + WS_H), (const bf16*)(ws + WS_WD), 1024, DFF, e); REP(13, Epi4<FStoreF32> e{{(float*)(ws + WS_F2), 1024}}; run_gemm(lds, (const bf16*)(ws + WS_H), (const bf16*)(ws + WS_WD), 1024, DFF, e)); } SEAM(13);
    if (MK_REP == 100) { for (int i = 0; i < 14; ++i) XBAR(); }
    if (IN(14)) { phase_p7b(a, lds); }
#undef IN
#undef SEAM
}


#ifndef MK_DBG
#define MK_DBG 0
#endif
__global__ void dbg_zero(float* p, size_t n) { for (size_t i = (size_t)blockIdx.x * blockDim.x + threadIdx.x; i < n; i += (size_t)gridDim.x * blockDim.x) p[i] = 0.f; }
extern "C" void kernel_launch(void* const* d_in, const int* in_sizes, int n_in, void* d_out, int out_size, void* d_ws, size_t ws_size, hipStream_t stream) {
    static int grid = 0;
    if (grid == 0) {
        if (n_in != 30 || (size_t)out_size != OUT_END || ws_size < WS_END) { fprintf(stderr, "kernel_launch: unexpected shapes (n_in %d out %d ws %zu, need ws >= %zu)\n", n_in, out_size, ws_size, (size_t)WS_END); }
        int dev = 0, cus = 0, per_cu = 0;
        (void)hipGetDevice(&dev); (void)hipDeviceGetAttribute(&cus, hipDeviceAttributeMultiprocessorCount, dev);
        (void)hipFuncSetAttribute((const void*)mk_fwd, hipFuncAttributeMaxDynamicSharedMemorySize, LDS_BYTES);
        (void)hipOccupancyMaxActiveBlocksPerMultiprocessor(&per_cu, (const void*)mk_fwd, 512, LDS_BYTES);
        if (per_cu < 1) { fprintf(stderr, "kernel_launch: occupancy query says %d blocks per CU\n", per_cu); per_cu = 1; }
        grid = cus > 0 ? cus : 256;
        (void)hipGetLastError();
    }
    Args a{};
    for (int i = 0; i < 30; ++i) a.in[i] = (const float*)d_in[i];
    a.out = (float*)d_out; a.ws = (unsigned char*)d_ws;
#if MK_ONE_LAUNCH
    (void)hipMemsetAsync(d_ws, 0, 65536, stream);
    a.ph_lo = 0; a.ph_hi = NPHASE;
    void* args[] = {&a};
    hipError_t e = hipLaunchCooperativeKernel((const void*)mk_fwd, dim3(grid), dim3(512), args, LDS_BYTES, stream);
    if (e != hipSuccess) fprintf(stderr, "cooperative launch failed: %s (grid %d)\n", hipGetErrorString(e), grid);
#else
    const int nph = MK_DBG == 1 ? 5 : (MK_DBG == 2 ? 3 : (MK_DBG == 3 ? 8 : NPHASE));
    for (int p = 0; p < nph; ++p) { a.ph_lo = p; a.ph_hi = p + 1; hipLaunchKernelGGL(mk_fwd, dim3(grid), dim3(512), LDS_BYTES, stream, a); }
    float* o = (float*)d_out;
    if (MK_DBG >= 1) hipLaunchKernelGGL(dbg_zero, dim3(1024), dim3(256), 0, stream, o + OUT_Y, (size_t)M * 1024);
    if (MK_DBG == 1 || MK_DBG == 2) hipLaunchKernelGGL(dbg_zero, dim3(1024), dim3(256), 0, stream, o + OUT_VS, (size_t)32 * 64 * 1024);
    if (MK_DBG == 2) { hipLaunchKernelGGL(dbg_zero, dim3(1024), dim3(256), 0, stream, o + OUT_WKV_P, (size_t)8 * 16 * 4096); hipLaunchKernelGGL(dbg_zero, dim3(1024), dim3(256), 0, stream, o + OUT_WKV_S, (size_t)32 * 16 * 4096); }
#endif
}
```

```cpp
#include <hip/hip_runtime.h>
#include <hip/hip_cooperative_groups.h>
#include <cstdio>
#include <cstdint>
namespace cg = cooperative_groups;
namespace pg8 {
#define PG8_LAS __attribute__((address_space(3)))
typedef unsigned short bf16_t;
typedef short bf16x8 __attribute__((ext_vector_type(8)));
typedef float f32x4 __attribute__((ext_vector_type(4)));
typedef unsigned u32x4 __attribute__((ext_vector_type(4)));
constexpr int BM = 256, BK = 64, HALF = 128, HTB = HALF * BK * 2  , STAGE_BYTES = 8 * HTB, NXCD = 8, WGM = 8;

__host__ __device__ __forceinline__ int lds_byte(int r, int c) { const int st = (r >> 4) * 2 + (c >> 5), rr = r & 15, cc = c & 31, ob = rr * 64 + cc * 2; return st * 1024 + (ob ^ (((ob >> 9) & 1) << 5)); }
__host__ __device__ __forceinline__ void stage_rc(int b, int& R, int& C) { const int st = b / 1024, sb = b % 1024, swz = sb ^ (((sb >> 9) & 1) << 5); R = (st >> 1) * 16 + swz / 64; C = (st & 1) * 32 + (swz % 64) / 2; }
__host__ __device__ __forceinline__ int perm32(int rho) { const int n = rho >> 4, i = rho & 15; return 8 * (i >> 2) + 4 * n + (i & 3); }

struct Unit { int pm, pn; };
struct Gemm { const bf16_t* A; const bf16_t* Bt; int M, N, K; };

struct StaticOrder {
    int nM, nN, nwg, G, c;
    __host__ __device__ void init(int M, int N, int G_, int c_) { nM = M / BM; nN = N / BM; nwg = nM * nN; G = G_; c = c_; }
    __host__ __device__ bool next(int i, Unit& u) const {
        const long L = (long)i * G + c; if (L >= nwg) return false;
        int wgid = (int)L; { const int q = nwg / NXCD, r = nwg % NXCD, xcd = wgid % NXCD, off = wgid / NXCD; wgid = (xcd < r ? xcd * (q + 1) : r * (q + 1) + (xcd - r) * q) + off; }
        const int nig = WGM * nN, gid = wgid / nig, fm = gid * WGM, gsz = (nM - fm) < WGM ? (nM - fm) : WGM;
        u.pm = fm + ((wgid % nig) % gsz); u.pn = (wgid % nig) / gsz; return true;
    }
    __device__ __forceinline__ void a_ready(const Unit&) const {}
    __device__ __forceinline__ void done(const Unit&) const {}
};

__device__ __forceinline__ unsigned cvt_pk_bf16(float lo, float hi) { unsigned r; asm volatile("v_cvt_pk_bf16_f32 %0, %1, %2" : "=v"(r) : "v"(lo), "v"(hi)); return r; }
typedef float f32x2 __attribute__((ext_vector_type(2)));
template <class Epi, class Sched, bool ALIGN_EPI = false, bool SP2 = false>
__device__ __forceinline__ void gemm_phase(PG8_LAS unsigned char* lds, const Gemm g, const Sched& S, const Epi& E) {
    const int tid = threadIdx.x, wid = __builtin_amdgcn_readfirstlane(tid >> 6), lane = tid & 63, wr = wid >> 2, wc = wid & 3, fr = lane & 15, fq = lane >> 4;
    const int K = g.K, nt = K / BK;
    unsigned voffA[2], voffB[2];
#pragma unroll
    for (int i = 0; i < 2; ++i) { int R, C; stage_rc(tid * 16 + i * 8192, R, C); const int Rb = Epi::PERM ? ((R & ~31) + perm32(R & 31)) : R;
        voffA[i] = (unsigned)(R * K + C) * 2u; voffB[i] = (unsigned)(Rb * K + C) * 2u; }
    const size_t kstep = (size_t)(BK * 2);
    const size_t hstep = (size_t)HALF * K * 2;
    const size_t tstep = 2 * hstep;
    const unsigned ldsw = (unsigned)wid * 1024u;
    const int aoff = lds_byte(wr * 64 + fr, fq * 8), boff = lds_byte(wc * 32 + fr, fq * 8);
#define PG8_SA(b, h) (((b) * 2 + (h)) * HTB)
#define PG8_SB(b, h) ((4 + (b) * 2 + (h)) * HTB)
#define PG8_STAGE(bufoff, gbase, voff) do { _Pragma("unroll") for (int _i = 0; _i < 2; ++_i) \
        __builtin_amdgcn_global_load_lds((const unsigned*)((const char*)(gbase) + (voff)[_i]), (PG8_LAS unsigned*)(lds + (bufoff) + ldsw + _i * 8192), 16, 0, 0); } while (0)
#define PG8_LDA(dst, b, h) do { _Pragma("unroll") for (int m = 0; m < 4; ++m) _Pragma("unroll") for (int k = 0; k < 2; ++k) dst[m][k] = *(const PG8_LAS bf16x8*)(lds + PG8_SA(b, h) + aoff + m * 2048 + k * 1024); } while (0)
#define PG8_LDB(dst, b, h) do { _Pragma("unroll") for (int n = 0; n < 2; ++n) _Pragma("unroll") for (int k = 0; k < 2; ++k) dst[n][k] = *(const PG8_LAS bf16x8*)(lds + PG8_SB(b, h) + boff + n * 2048 + k * 1024); } while (0)
#define PG8_MMA(ai, bj, At, Bt) do { __builtin_amdgcn_s_setprio(1); _Pragma("unroll") for (int m = 0; m < 4; ++m) _Pragma("unroll") for (int n = 0; n < 2; ++n) _Pragma("unroll") for (int k = 0; k < 2; ++k) \
        acc[ai][bj][m][n] = __builtin_amdgcn_mfma_f32_16x16x32_bf16(Bt[n][k], At[m][k], acc[ai][bj][m][n], 0, 0, 0); __builtin_amdgcn_s_setprio(0); } while (0)
#define PG8_WAIT_V(n) asm volatile("s_waitcnt vmcnt(" #n ")" ::: "memory")
#define PG8_WAIT_L(n) asm volatile("s_waitcnt lgkmcnt(" #n ")" ::: "memory")
#define PG8_BAR __builtin_amdgcn_s_barrier()
#define PG8_SCHED __builtin_amdgcn_sched_barrier(0)
    Unit cur, nxt; int ui = 0;
    if (!S.next(0, cur)) return;
    f32x4 acc[2][2][4][2];
#pragma unroll
    for (int a = 0; a < 2; ++a)
#pragma unroll
        for (int b = 0; b < 2; ++b)
#pragma unroll
            for (int m = 0; m < 4; ++m)
#pragma unroll
                for (int n = 0; n < 2; ++n) acc[a][b][m][n] = (f32x4){0.f, 0.f, 0.f, 0.f};
    bf16x8 At[4][2], B0[2][2], B1[2][2];
    const char* cA = (const char*)g.A + (size_t)cur.pm * tstep; const char* cB = (const char*)g.Bt + (size_t)cur.pn * tstep;
    S.a_ready(cur);
    if constexpr (SP2) {
        PG8_STAGE(PG8_SB(0, 0), cB, voffB); PG8_STAGE(PG8_SB(0, 1), cB + hstep, voffB); PG8_STAGE(PG8_SA(0, 0), cA, voffA); PG8_STAGE(PG8_SA(0, 1), cA + hstep, voffA);
        if (wr == 1) PG8_BAR;
        PG8_WAIT_V(2); PG8_BAR;
        PG8_STAGE(PG8_SB(1, 0), cB + kstep, voffB); PG8_STAGE(PG8_SA(1, 0), cA + kstep, voffA); PG8_STAGE(PG8_SB(1, 1), cB + hstep + kstep, voffB);
        PG8_WAIT_V(6); PG8_BAR;
    } else {
        PG8_STAGE(PG8_SB(0, 0), cB, voffB); PG8_STAGE(PG8_SA(0, 0), cA, voffA); PG8_STAGE(PG8_SB(0, 1), cB + hstep, voffB); PG8_STAGE(PG8_SA(0, 1), cA + hstep, voffA);
        if (wr == 1) PG8_BAR;
        PG8_WAIT_V(4); PG8_BAR;
        PG8_STAGE(PG8_SB(1, 0), cB + kstep, voffB); PG8_STAGE(PG8_SA(1, 0), cA + kstep, voffA); PG8_STAGE(PG8_SB(1, 1), cB + hstep + kstep, voffB);
        PG8_WAIT_V(6); PG8_BAR;
    }
    for (;;) {
        const bool has_next = S.next(ui + 1, nxt);
        const char* nA = has_next ? (const char*)g.A + (size_t)nxt.pm * tstep : cA; const char* nB = has_next ? (const char*)g.Bt + (size_t)nxt.pn * tstep : cB;
        for (int t = 0; t < nt; t += 2) {
            const bool last = (t == nt - 2);
            const char* a1 = cA + (size_t)(t + 1) * kstep;
            const char* a2 = last ? nA : cA + (size_t)(t + 2) * kstep; const char* b2 = last ? nB : cB + (size_t)(t + 2) * kstep;
            const char* a3 = a2 + kstep; const char* b3 = b2 + kstep;
            if (last && has_next) S.a_ready(nxt);
            if constexpr (SP2) {
            PG8_LDB(B0, 0, 0); PG8_LDB(B1, 0, 1); PG8_SCHED; PG8_LDA(At, 0, 0); PG8_STAGE(PG8_SA(1, 1), a1 + hstep, voffA);
            PG8_WAIT_V(8); PG8_WAIT_L(0); PG8_BAR; PG8_MMA(0, 0, At, B0); PG8_MMA(0, 1, At, B1); PG8_BAR; PG8_SCHED;
            PG8_LDA(At, 0, 1); PG8_STAGE(PG8_SB(0, 0), b2, voffB); PG8_STAGE(PG8_SB(0, 1), b2 + hstep, voffB); PG8_STAGE(PG8_SA(0, 0), a2, voffA);
            PG8_WAIT_V(8); PG8_WAIT_L(0); PG8_BAR; PG8_MMA(1, 0, At, B0); PG8_MMA(1, 1, At, B1); PG8_BAR; PG8_SCHED;
            PG8_LDB(B0, 1, 0); PG8_LDB(B1, 1, 1); PG8_SCHED; PG8_LDA(At, 1, 0); PG8_STAGE(PG8_SA(0, 1), a2 + hstep, voffA);
            PG8_WAIT_V(8); PG8_WAIT_L(0); PG8_BAR; PG8_MMA(0, 0, At, B0); PG8_MMA(0, 1, At, B1); PG8_BAR; PG8_SCHED;
            PG8_LDA(At, 1, 1); PG8_STAGE(PG8_SB(1, 0), b3, voffB); PG8_STAGE(PG8_SB(1, 1), b3 + hstep, voffB); PG8_STAGE(PG8_SA(1, 0), a3, voffA);
            PG8_WAIT_V(8); PG8_WAIT_L(0); PG8_BAR; PG8_MMA(1, 0, At, B0); PG8_MMA(1, 1, At, B1); PG8_BAR; PG8_SCHED;
            } else {
            PG8_LDB(B0, 0, 0); PG8_SCHED; PG8_LDA(At, 0, 0); PG8_STAGE(PG8_SA(1, 1), a1 + hstep, voffA);
            PG8_WAIT_L(8); PG8_BAR; PG8_WAIT_L(0); PG8_MMA(0, 0, At, B0); PG8_BAR; PG8_SCHED;
            PG8_LDB(B1, 0, 1); PG8_STAGE(PG8_SB(0, 0), b2, voffB);
            PG8_BAR; PG8_WAIT_L(0); PG8_MMA(0, 1, At, B1); PG8_BAR;
            PG8_LDA(At, 0, 1); PG8_STAGE(PG8_SA(0, 0), a2, voffA);
            PG8_BAR; PG8_WAIT_L(0); PG8_MMA(1, 0, At, B0); PG8_BAR; PG8_SCHED;
            PG8_STAGE(PG8_SB(0, 1), b2 + hstep, voffB);
            PG8_WAIT_V(6); PG8_BAR; PG8_MMA(1, 1, At, B1); PG8_BAR;
            PG8_LDB(B0, 1, 0); PG8_SCHED; PG8_LDA(At, 1, 0); PG8_STAGE(PG8_SA(0, 1), a2 + hstep, voffA);
            PG8_WAIT_L(8); PG8_BAR; PG8_WAIT_L(0); PG8_MMA(0, 0, At, B0); PG8_BAR; PG8_SCHED;
            PG8_LDB(B1, 1, 1); PG8_STAGE(PG8_SB(1, 0), b3, voffB);
            PG8_BAR; PG8_WAIT_L(0); PG8_MMA(0, 1, At, B1); PG8_BAR;
            PG8_LDA(At, 1, 1); PG8_STAGE(PG8_SA(1, 0), a3, voffA);
            PG8_BAR; PG8_WAIT_L(0); PG8_MMA(1, 0, At, B0); PG8_BAR; PG8_SCHED;
            PG8_STAGE(PG8_SB(1, 1), b3 + hstep, voffB);
            PG8_WAIT_V(6); PG8_BAR; PG8_MMA(1, 1, At, B1); PG8_BAR;
            }
        }
        if constexpr (ALIGN_EPI) { if (wr == 0) PG8_BAR; }
        if constexpr (!Epi::AFTER_DRAIN) { E(acc, cur, wr, wc, fr, fq); S.done(cur); }
        if (!has_next) break;
#pragma unroll
        for (int a = 0; a < 2; ++a)
#pragma unroll
            for (int b = 0; b < 2; ++b)
#pragma unroll
                for (int m = 0; m < 4; ++m)
#pragma unroll
                    for (int n = 0; n < 2; ++n) acc[a][b][m][n] = (f32x4){0.f, 0.f, 0.f, 0.f};
        cur = nxt; cA = nA; cB = nB; ++ui;
        if constexpr (ALIGN_EPI) { if (wr == 1) PG8_BAR; }
    }
    PG8_WAIT_V(0);
    if constexpr (!ALIGN_EPI) { if (wr == 0) PG8_BAR; }
    PG8_BAR;
    if constexpr (Epi::AFTER_DRAIN) { E.fused(acc, cur, wr, wc, fr, fq, lds, wid, lane); S.done(cur); }
#undef PG8_SA
#undef PG8_SB
#undef PG8_STAGE
#undef PG8_LDA
#undef PG8_LDB
#undef PG8_MMA
#undef PG8_WAIT_V
#undef PG8_WAIT_L
#undef PG8_BAR
#undef PG8_SCHED
}
}
#define LAS __attribute__((address_space(3)))
typedef unsigned short bf16;
typedef _Float16 f16;
typedef float f32x4 __attribute__((ext_vector_type(4)));
typedef short bf16x8 __attribute__((ext_vector_type(8)));
typedef short s16x4 __attribute__((ext_vector_type(4)));
typedef unsigned u32x4 __attribute__((ext_vector_type(4)));
typedef unsigned u32x2 __attribute__((ext_vector_type(2)));
typedef _Float16 h2 __attribute__((ext_vector_type(2)));

#ifndef MK_ONE_LAUNCH
#define MK_ONE_LAUNCH 1
#endif

constexpr int NPROMPT = 8 * 4096, NSAMP = 32 * 64, M = NPROMPT + NSAMP;
constexpr int DM = 1024, SHW = 3328, DFF = 2816;
constexpr size_t MiB = 1u << 20;
constexpr size_t U = (size_t)M * 1024 * 2;
constexpr size_t WS_WIN = 1 * MiB;
constexpr size_t WS_WA = WS_WIN + (size_t)7424 * 1024 * 2;
constexpr size_t WS_WB = WS_WA + (size_t)1024 * 1024 * 2;
constexpr size_t WS_WO = WS_WB + (size_t)1024 * 1024 * 2;
constexpr size_t WS_GU = WS_WO + (size_t)1024 * 1024 * 2;
constexpr size_t WS_WD = WS_GU + (size_t)5632 * 1024 * 2;
constexpr size_t WS_LORA = WS_WD + (size_t)1024 * 2816 * 2;
constexpr size_t WS_WSP = WS_LORA + (size_t)3072 * 256 * 2;
constexpr size_t WS_R0 = 40 * MiB;
static_assert(WS_WSP + 8 * 128 * 128 * 2 <= WS_R0, "weights fit below R0");
constexpr size_t WS_XN = WS_R0;
constexpr size_t WS_WL = WS_R0;
constexpr size_t WS_PS = WS_R0 + U;
constexpr size_t WS_AR = WS_R0 + U * 17 / 4;
constexpr size_t WS_G = WS_R0 + U * 21 / 4;
constexpr size_t WS_LX = WS_R0 + U * 25 / 4;
constexpr size_t WS_END = WS_R0 + U * 26 / 4;
constexpr size_t WS_XN2 = WS_R0;
constexpr size_t WS_P4 = WS_R0 + U;
constexpr size_t WS_OA = WS_G;
constexpr size_t WS_OB = WS_R0;
constexpr size_t WS_MM = WS_R0 + U;
constexpr size_t WS_MO = WS_R0 + 2 * U;
constexpr size_t WS_F = WS_R0;
constexpr size_t WS_H = WS_R0 + U;
constexpr size_t WS_F2 = WS_R0 + 4 * U;
constexpr size_t OUT_Y = 0;
constexpr size_t OUT_SHIFT_P = (size_t)M * 1024;
constexpr size_t OUT_WKV_P = OUT_SHIFT_P + 8 * 3328;
constexpr size_t OUT_SHIFT_S = OUT_WKV_P + (size_t)8 * 16 * 4096;
constexpr size_t OUT_WKV_S = OUT_SHIFT_S + 32 * 3328;
constexpr size_t OUT_VS = OUT_WKV_S + (size_t)32 * 16 * 4096;
constexpr size_t OUT_END = OUT_VS + (size_t)32 * 64 * 1024;
static_assert(OUT_END == 40503296, "output size");

constexpr int LDS_BYTES = 147456;
constexpr int NPHASE = 15;

struct Args { const float* in[30]; float* out; unsigned char* ws; int ph_lo, ph_hi; };

__device__ __forceinline__ float bf_lo(unsigned u) { return __uint_as_float(u << 16); }
__device__ __forceinline__ float bf_hi(unsigned u) { return __uint_as_float(u & 0xffff0000u); }
__device__ __forceinline__ f32x4 dec4bf(u32x2 u) { return (f32x4){bf_lo(u.x), bf_hi(u.x), bf_lo(u.y), bf_hi(u.y)}; }
__device__ __forceinline__ unsigned pkbf(float lo, float hi) { return pg8::cvt_pk_bf16(lo, hi); }
__device__ __forceinline__ u32x2 pk4bf(f32x4 v) { u32x2 r; r.x = pkbf(v[0], v[1]); r.y = pkbf(v[2], v[3]); return r; }
__device__ __forceinline__ unsigned pkh(float lo, float hi) { h2 h; h.x = (f16)lo; h.y = (f16)hi; return __builtin_bit_cast(unsigned, h); }
__device__ __forceinline__ u32x2 pk4h(f32x4 v) { u32x2 r; r.x = pkh(v[0], v[1]); r.y = pkh(v[2], v[3]); return r; }
__device__ __forceinline__ h2 as_h2(unsigned u) { return __builtin_bit_cast(h2, u); }
__device__ __forceinline__ f32x4 dec4h(u32x2 u) { const h2 a = as_h2(u.x), b = as_h2(u.y); return (f32x4){(float)a.x, (float)a.y, (float)b.x, (float)b.y}; }
__device__ __forceinline__ float sigm(float x) { return __builtin_amdgcn_rcpf(1.f + __expf(-x)); }
__device__ __forceinline__ float wave_sum(float v) {
#pragma unroll
    for (int o = 1; o < 64; o <<= 1) v += __shfl_xor(v, o);
    return v;
}
template <int CTRL> __device__ __forceinline__ float dppf(float x) { return __int_as_float(__builtin_amdgcn_update_dpp(0, __float_as_int(x), CTRL, 0xF, 0xF, false)); }
__device__ __forceinline__ float row_sum16(float x) { x += dppf<0x128>(x); x += dppf<0x124>(x); x += dppf<0x122>(x); x += dppf<0x121>(x); return x; }
__device__ __forceinline__ float quad_sum(float x) { x += dppf<0xB1>(x); x += dppf<0x4E>(x); return x; }
__device__ __forceinline__ const float* xrow_ptr(const Args& a, int m) { return m < NPROMPT ? a.in[0] + (size_t)m * 1024 : a.in[1] + (size_t)(m - NPROMPT) * 1024; }

template <class F> struct Epi8 {
    static constexpr bool PERM = true, AFTER_DRAIN = false; F f;
    __device__ __forceinline__ void operator()(const f32x4 (&acc)[2][2][4][2], const pg8::Unit& u, int wr, int wc, int fr, int fq) const {
        const int row0 = u.pm * 256 + wr * 64 + fr, col0 = u.pn * 256 + wc * 32 + 8 * fq;
#pragma unroll
        for (int ai = 0; ai < 2; ++ai)
#pragma unroll
            for (int m = 0; m < 4; ++m)
#pragma unroll
                for (int bj = 0; bj < 2; ++bj) f(row0 + ai * 128 + m * 16, col0 + bj * 128, acc[ai][bj][m][0], acc[ai][bj][m][1]);
    }
};
template <class F> struct Epi4 {
    static constexpr bool PERM = false, AFTER_DRAIN = false; F f;
    __device__ __forceinline__ void operator()(const f32x4 (&acc)[2][2][4][2], const pg8::Unit& u, int wr, int wc, int fr, int fq) const {
        const int row0 = u.pm * 256 + wr * 64 + fr, col0 = u.pn * 256 + wc * 32 + 4 * fq;
#pragma unroll
        for (int ai = 0; ai < 2; ++ai)
#pragma unroll
            for (int m = 0; m < 4; ++m)
#pragma unroll
                for (int bj = 0; bj < 2; ++bj)
#pragma unroll
                    for (int n = 0; n < 2; ++n) f(row0 + ai * 128 + m * 16, col0 + bj * 128 + n * 16, acc[ai][bj][m][n]);
    }
};
__device__ __forceinline__ u32x4 pk8bf(f32x4 a, f32x4 b) { u32x4 w; w.x = pkbf(a[0], a[1]); w.y = pkbf(a[2], a[3]); w.z = pkbf(b[0], b[1]); w.w = pkbf(b[2], b[3]); return w; }
__device__ __forceinline__ u32x4 pk8h(f32x4 a, f32x4 b) { u32x4 w; w.x = pkh(a[0], a[1]); w.y = pkh(a[2], a[3]); w.z = pkh(b[0], b[1]); w.w = pkh(b[2], b[3]); return w; }
__device__ __forceinline__ void dec8bf(u32x4 w, f32x4& a, f32x4& b) { a = (f32x4){bf_lo(w.x), bf_hi(w.x), bf_lo(w.y), bf_hi(w.y)}; b = (f32x4){bf_lo(w.z), bf_hi(w.z), bf_lo(w.w), bf_hi(w.w)}; }

struct FStoreBf16 { bf16* O; int ldc;
    __device__ __forceinline__ void operator()(int r, int c, f32x4 v0, f32x4 v1) const { *(u32x4*)(O + (size_t)r * ldc + c) = pk8bf(v0, v1); } };
struct FStoreF32 { float* O; int ldc;
    __device__ __forceinline__ void operator()(int r, int c, f32x4 v) const { *(f32x4*)(O + (size_t)r * ldc + c) = v; } };
struct FLora { f16* WL; f16* AR; f16* G; const float* w0; const float* a0;
    __device__ __forceinline__ void operator()(int r, int c, f32x4 v0, f32x4 v1) const {
        const int t = c >> 10, cc = c & 1023;
        if (t == 0) { const f32x4 b0 = *(const f32x4*)(w0 + cc), b1 = *(const f32x4*)(w0 + cc + 4);
#pragma unroll
            for (int i = 0; i < 4; ++i) { v0[i] = -0.60653066f * sigm(v0[i] + b0[i]); v1[i] = -0.60653066f * sigm(v1[i] + b1[i]); }
            *(u32x4*)(WL + (size_t)r * 1024 + cc) = pk8h(v0, v1); }
        else if (t == 1) { const f32x4 b0 = *(const f32x4*)(a0 + cc), b1 = *(const f32x4*)(a0 + cc + 4);
#pragma unroll
            for (int i = 0; i < 4; ++i) { v0[i] = sigm(v0[i] + b0[i]); v1[i] = sigm(v1[i] + b1[i]); }
            *(u32x4*)(AR + (size_t)r * 1024 + cc) = pk8h(v0, v1); }
        else *(u32x4*)(G + (size_t)r * 1024 + cc) = pk8h(v0, v1);
    } };
struct FP1b { bf16* base;
    __device__ __forceinline__ void operator()(int r, int c, f32x4 v0, f32x4 v1) const {
        const int t = c >> 10, cc = c & 1023;
        if (t >= 2) {
#pragma unroll
            for (int i = 0; i < 4; ++i) { v0[i] = sigm(v0[i]); v1[i] = sigm(v1[i]); } }
        *(u32x4*)(base + (size_t)t * (U / 2) + (size_t)r * 1024 + cc) = pk8bf(v0, v1);
    } };
struct FGateA { const bf16* GA; bf16* M1;
    __device__ __forceinline__ void operator()(int r, int c, f32x4 v0, f32x4 v1) const {
        const size_t o = (size_t)r * 1024 + c; f32x4 g0, g1; dec8bf(*(const u32x4*)(GA + o), g0, g1);
        *(u32x4*)(M1 + o) = pk8bf(v0 * g0, v1 * g1);
    } };
struct FGateB { const bf16* GB; bf16* MMp;
    __device__ __forceinline__ void operator()(int r, int c, f32x4 v0, f32x4 v1) const {
        const size_t o = (size_t)r * 1024 + c; f32x4 g0, g1, m0, m1; dec8bf(*(const u32x4*)(GB + o), g0, g1); dec8bf(*(const u32x4*)(MMp + o), m0, m1);
        *(u32x4*)(MMp + o) = pk8bf(m0 + v0 * g0, m1 + v1 * g1);
    } };
struct EpiGU {
    static constexpr bool PERM = true, AFTER_DRAIN = false; bf16* H;
    __device__ __forceinline__ void operator()(const f32x4 (&acc)[2][2][4][2], const pg8::Unit& u, int wr, int wc, int fr, int fq) const {
        const int row0 = u.pm * 256 + wr * 64 + fr, h0 = u.pn * 128 + wc * 32 + 8 * fq;
#pragma unroll
        for (int ai = 0; ai < 2; ++ai)
#pragma unroll
            for (int m = 0; m < 4; ++m) {
                f32x4 o0, o1;
#pragma unroll
                for (int i = 0; i < 4; ++i) { const float g0 = acc[ai][0][m][0][i], g1 = acc[ai][1][m][0][i];
                    o0[i] = g0 * sigm(g0) * acc[ai][0][m][1][i]; o1[i] = g1 * sigm(g1) * acc[ai][1][m][1][i]; }
                *(u32x4*)(H + (size_t)(row0 + ai * 128 + m * 16) * DFF + h0) = pk8bf(o0, o1);
            }
    }
};

#define PH_PROLOG const int tid = threadIdx.x, lane = tid & 63, wave = __builtin_amdgcn_readfirstlane(tid >> 6); const int G = gridDim.x, bid = blockIdx.x; const int gw = bid * 8 + wave, NGW = G * 8; (void)lane; (void)gw; (void)NGW; (void)lds;

__device__ __forceinline__ float conv_src(const Args& a, int mat, int R, int k) {
    switch (mat) {
    case 0: return a.in[5][(size_t)k * 7424 + R];
    case 1: return a.in[21][(size_t)k * 1024 + R];
    case 2: return a.in[22][(size_t)k * 1024 + R];
    case 3: return a.in[23][(size_t)k * 1024 + R];
    case 4: { const int cl = R & 255, pn = R >> 8, bj = (cl >> 7) & 1, wc = (cl >> 5) & 3, fq = (cl >> 3) & 3, n = (cl >> 2) & 1, e = cl & 3;
              const int hcol = 128 * pn + 32 * wc + 8 * fq + 4 * bj + e; return (n ? a.in[27] : a.in[26])[(size_t)k * DFF + hcol]; }
    case 5: return a.in[28][(size_t)k * 1024 + R];
    case 6: { if (R < 1024) return k < 64 ? a.in[8][k * 1024 + R] : 0.f;
              if (R < 2048) return (k >= 64 && k < 128) ? a.in[10][(k - 64) * 1024 + R - 1024] : 0.f;
              return k >= 128 ? a.in[11][(k - 128) * 1024 + R - 2048] : 0.f; }
    default: { const int t = R & 127; return k <= t ? a.in[19][(size_t)R * 128 + k] : 0.f; }
    }
}
__device__ __forceinline__ void rms_row_to_bf16(const float* xrow, const float* gain, bf16* orow, int lane) {
    f32x4 v[4]; float ss = 0.f;
#pragma unroll
    for (int j = 0; j < 4; ++j) { v[j] = ((const f32x4*)xrow)[lane + 64 * j]; ss += (v[j][0] * v[j][0] + v[j][1] * v[j][1]) + (v[j][2] * v[j][2] + v[j][3] * v[j][3]); }
    const float rs = rsqrtf(wave_sum(ss) * (1.f / 1024.f) + 1e-6f);
#pragma unroll
    for (int j = 0; j < 4; ++j) { const f32x4 g = ((const f32x4*)gain)[lane + 64 * j]; ((u32x2*)orow)[lane + 64 * j] = pk4bf(v[j] * rs * g); }
}
constexpr int CV_MAT[8] = {0, 6, 1, 2, 3, 4, 5, 7};
constexpr int CV_NIT[8] = {928 * 16, 384 * 4, 128 * 16, 128 * 16, 128 * 16, 704 * 16, 128 * 44, 128 * 2};
constexpr int CV_KD[8] = {1024, 256, 1024, 1024, 1024, 1024, 2816, 128};
constexpr size_t CV_DST[8] = {WS_WIN, WS_LORA, WS_WA, WS_WB, WS_WO, WS_GU, WS_WD, WS_WSP};
constexpr int CV_EARLY = CV_NIT[0] + CV_NIT[1], CV_ALL = CV_EARLY + CV_NIT[2] + CV_NIT[3] + CV_NIT[4] + CV_NIT[5] + CV_NIT[6] + CV_NIT[7];
__device__ __forceinline__ void conv_items(const Args& a, int lo, int hi, int worker, int nworkers, int lane) {
    for (int it = lo + worker; it < hi; it += nworkers) {
        int r = it, mi = 0;
#pragma unroll
        for (int q = 0; q < 7; ++q) { if (mi == q && r >= CV_NIT[q]) { r -= CV_NIT[q]; mi = q + 1; } }
        int Kd = 1024, mat = 0; size_t dst = WS_WIN;
#pragma unroll
        for (int q = 0; q < 8; ++q) if (mi == q) { Kd = CV_KD[q]; dst = CV_DST[q]; mat = CV_MAT[q]; }
        const int kbn = Kd >> 6, rb = r / kbn, kb = r - rb * kbn;
        const int R = rb * 8 + (lane >> 3), k0 = kb * 64 + (lane & 7) * 8;
        float s[8];
#pragma unroll
        for (int j = 0; j < 8; ++j) s[j] = conv_src(a, mat, R, k0 + j);
        u32x4 w; w.x = pkbf(s[0], s[1]); w.y = pkbf(s[2], s[3]); w.z = pkbf(s[4], s[5]); w.w = pkbf(s[6], s[7]);
        *(u32x4*)(a.ws + dst + ((size_t)R * Kd + k0) * 2) = w;
    }
}
__device__ __forceinline__ void phase_p0(const Args& a, LAS unsigned char* lds) {
    PH_PROLOG
    conv_items(a, 0, G > 128 ? CV_EARLY : CV_ALL, gw, NGW, lane);
    bf16* XN = (bf16*)(a.ws + WS_XN);
    for (int m = gw; m < M; m += NGW) rms_row_to_bf16(xrow_ptr(a, m), a.in[4], XN + (size_t)m * 1024, lane);
}

__device__ __forceinline__ void phase_p2a(const Args& a, LAS unsigned char* lds) {
    PH_PROLOG
    const bf16* PS = (const bf16*)(a.ws + WS_PS); bf16* LX = (bf16*)(a.ws + WS_LX);
    const f32x4 mu = *(const f32x4*)(a.in[6] + 3072 + 4 * lane);
    for (int m = gw; m < M; m += NGW) {
        const bool samp = m >= NPROMPT; const int t = samp ? ((m - NPROMPT) & 63) : (m & 4095);
        const f32x4 p = dec4bf(*(const u32x2*)(PS + (size_t)m * SHW + 3072 + 4 * lane));
        f32x4 pp = (f32x4){0.f, 0.f, 0.f, 0.f};
        if (t > 0) pp = dec4bf(*(const u32x2*)(PS + (size_t)(m - 1) * SHW + 3072 + 4 * lane));
        else if (samp) pp = *(const f32x4*)(a.in[2] + (size_t)((m - NPROMPT) >> 6) * SHW + 3072 + 4 * lane);
        f32x4 x = p + (pp - p) * mu;
        if (lane < 16) {
#pragma unroll
            for (int i = 0; i < 4; ++i) x[i] = 1.f - 2.f * __builtin_amdgcn_rcpf(__expf(2.f * x[i]) + 1.f); }
        else if (lane >= 32) {
#pragma unroll
            for (int i = 0; i < 4; ++i) x[i] = sigm(x[i]); }
        *(u32x2*)(LX + (size_t)m * 256 + 4 * lane) = pk4bf(x);
    }
    if (gw < 40) {
        const int row = gw < 8 ? gw * 4096 + 4095 : NPROMPT + (gw - 8) * 64 + 63;
        float* dst = a.out + (gw < 8 ? OUT_SHIFT_P + (size_t)gw * SHW : OUT_SHIFT_S + (size_t)(gw - 8) * SHW);
        for (int c = lane; c < SHW; c += 64) dst[c] = bf_lo((unsigned)PS[(size_t)row * SHW + c]);
    }
}

typedef _Float16 h4 __attribute__((ext_vector_type(4)));
typedef _Float16 h8 __attribute__((ext_vector_type(8)));
#define MFMA16(a, b, c) __builtin_amdgcn_mfma_f32_16x16x16f16(a, b, c, 0, 0, 0)
#define MFMA32(a, b, c) __builtin_amdgcn_mfma_f32_16x16x32_f16(a, b, c, 0, 0, 0)
__device__ __forceinline__ h4 cvt_h4(f32x4 v) { h4 r; r[0] = (f16)v[0]; r[1] = (f16)v[1]; r[2] = (f16)v[2]; r[3] = (f16)v[3]; return r; }
__device__ __forceinline__ f32x4 h4_f32(h4 v) { return (f32x4){(float)v[0], (float)v[1], (float)v[2], (float)v[3]}; }
constexpr int CK_NPROD = 6, CK_NCONS = 2, CK_NVB = 4 / CK_NCONS, CK_NSLOT = 5;
constexpr int CKS_ET = 0, CKS_GY = 2048, CKS_BK = 4096, CKS_XV = 8192, CKS_U0 = 10240, CKS_Y0 = 12288, CKS_LC = 14336, CKS_SIZE = 14848;
constexpr int CKP_AT = 0, CKP_BT = 2048, CKP_KT = 4096, CKP_RT = 6144, CKP_ATT = 8192, CKP_EX = 10240, CKP_LR = 11264, CKP_SIZE = 11520;
constexpr int CK_SLOTS = 0, CK_SCR = CK_NSLOT * CKS_SIZE, CK_FLAGS = CK_SCR + CK_NPROD * CKP_SIZE, CK_END = CK_FLAGS + 256;
static_assert(CK_END <= LDS_BYTES - 256, "chunked scan LDS map");
__device__ __forceinline__ int ck_img8(int row, int e4) { return row * 128 + ((((e4 >> 1) ^ (row & 7))) << 4) + ((e4 & 1) << 3); }
__device__ __forceinline__ int ck_img16(int row, int c16) { return row * 128 + ((c16 ^ (row & 7)) << 4); }
__device__ __forceinline__ bf16 f2bf_c(float f) { const unsigned u = __float_as_uint(f); return (bf16)((u + 0x7fffu + ((u >> 16) & 1u)) >> 16); }
__device__ __forceinline__ void ck_wait_ge(volatile LAS unsigned* flag, unsigned target) { while (*flag < target) __builtin_amdgcn_s_sleep(1); asm volatile("" ::: "memory"); }

struct CkRaw { u32x2 r[4], k[4], v[4], lw[4], ar[4], pr, pk, pv; };
__device__ __forceinline__ void ck_load(CkRaw& R, const bf16* PS, const f16* LW, const f16* AR, int mq, int cidx, int m_lo) {
#pragma unroll
    for (int i = 0; i < 4; ++i) { const bf16* base = PS + (size_t)(mq + i) * SHW + cidx;
        R.r[i] = *(const u32x2*)base; R.k[i] = *(const u32x2*)(base + 1024); R.v[i] = *(const u32x2*)(base + 2048);
        R.lw[i] = *(const u32x2*)(LW + (size_t)(mq + i) * 1024 + cidx); R.ar[i] = *(const u32x2*)(AR + (size_t)(mq + i) * 1024 + cidx); }
    const int mp = mq - 1 < m_lo ? m_lo : mq - 1; const bf16* pb = PS + (size_t)mp * SHW + cidx;
    R.pr = *(const u32x2*)pb; R.pk = *(const u32x2*)(pb + 1024); R.pv = *(const u32x2*)(pb + 2048);
}
struct CkK { f32x4 mu_r, mu_k, mu_v, kk, ka; };
__device__ __forceinline__ void ck_prep(LAS unsigned char* slot, LAS unsigned char* scr, const CkRaw& R, const float* const* in, int cidx, bool first, const float* ssrc, int lane) {
    const int q = lane >> 4, kg = lane & 15;
    f32x4 lv[4];
    lv[0] = dec4h(R.lw[0]); lv[1] = dec4h(R.lw[1]) + lv[0]; lv[2] = dec4h(R.lw[2]) + lv[1]; lv[3] = dec4h(R.lw[3]) + lv[2];
    *(LAS f32x4*)(scr + CKP_EX + lane * 16) = lv[3];
    const f32x4 zero4 = (f32x4){0.f, 0.f, 0.f, 0.f};
    f32x4 pre, lref, l15;
    { const f32x4 Q0 = *(const LAS f32x4*)(scr + CKP_EX + kg * 16), Q1 = *(const LAS f32x4*)(scr + CKP_EX + (16 + kg) * 16), Q2 = *(const LAS f32x4*)(scr + CKP_EX + (32 + kg) * 16), Q3 = *(const LAS f32x4*)(scr + CKP_EX + (48 + kg) * 16);
      pre = (q > 0 ? Q0 : zero4) + (q > 1 ? Q1 : zero4) + (q > 2 ? Q2 : zero4); lref = Q0 + Q1; l15 = (Q0 + Q1) + (Q2 + Q3); }
    f32x4 eC, eprev;
    { f32x4 lamref, lamC;
#pragma unroll
      for (int j = 0; j < 4; ++j) { eC[j] = __expf(l15[j] - lref[j]); lamref[j] = __expf(lref[j]); lamC[j] = __expf(l15[j]); eprev[j] = __expf(pre[j] - lref[j]); }
      if (q == 0) { *(LAS f32x4*)(slot + CKS_LC + kg * 16) = lamC; *(LAS f32x4*)(scr + CKP_LR + kg * 16) = lamref; } }
    pre = pre - lref;
    const f32x4 mu_r = *(const f32x4*)(in[6] + cidx), mu_k = *(const f32x4*)(in[6] + 1024 + cidx), mu_v = *(const f32x4*)(in[6] + 2048 + cidx), c_kk = *(const f32x4*)(in[12] + cidx), c_ka = *(const f32x4*)(in[13] + cidx);
    f32x4 pr = dec4bf(R.pr), pk = dec4bf(R.pk), pv = dec4bf(R.pv);
    if (first) { pr = zero4; pk = zero4; pv = zero4; if (ssrc) { pr = *(const f32x4*)ssrc; pk = *(const f32x4*)(ssrc + 1024); pv = *(const f32x4*)(ssrc + 2048); } }
    h4 att[4], bbt[4], kbt[4], xt[4];
#pragma unroll
    for (int i = 0; i < 4; ++i) {
        const f32x4 r = dec4bf(R.r[i]), k = dec4bf(R.k[i]), v = dec4bf(R.v[i]), ar = dec4h(R.ar[i]);
        const f32x4 xr = r + (pr - r) * mu_r, xk = k + (pk - k) * mu_k, xv = v + (pv - v) * mu_v;
        pr = r; pk = k; pv = v;
        const f32x4 kkr = xk * c_kk;
        float ssq = (kkr[0] * kkr[0] + kkr[1] * kkr[1]) + (kkr[2] * kkr[2] + kkr[3] * kkr[3]);
        ssq = row_sum16(ssq);
        const float inv = 1.f / fmaxf(sqrtf(ssq), 1e-12f);
        const f32x4 kkn = kkr * inv;
        f32x4 e, rc;
#pragma unroll
        for (int j = 0; j < 4; ++j) { const float d = lv[i][j] + pre[j]; e[j] = __expf(d); rc[j] = __expf(-d); }
        const f32x4 at = -kkn * eprev, bt = kkn * ar * rc, kt = xk * (1.f + (ar - 1.f) * c_ka) * rc, rt = xr * e, bb = bt * eC, kb = kt * eC;
        eprev = e;
        const int o = ck_img8(4 * q + i, kg);
        *(LAS h4*)(scr + CKP_AT + o) = cvt_h4(at); *(LAS h4*)(scr + CKP_BT + o) = cvt_h4(bt); *(LAS h4*)(scr + CKP_KT + o) = cvt_h4(kt); *(LAS h4*)(scr + CKP_RT + o) = cvt_h4(rt);
#pragma unroll
        for (int j = 0; j < 4; ++j) { att[j][i] = (f16)at[j]; bbt[j][i] = (f16)bb[j]; kbt[j][i] = (f16)kb[j]; xt[j][i] = (f16)xv[j]; }
    }
#pragma unroll
    for (int j = 0; j < 4; ++j) {
        const int key = 4 * kg + j;
        *(LAS h4*)(scr + CKP_ATT + key * 32 + q * 8) = att[j];
        *(LAS h4*)(slot + CKS_BK + key * 64 + q * 16) = bbt[j]; *(LAS h4*)(slot + CKS_BK + key * 64 + q * 16 + 8) = kbt[j];
        *(LAS h4*)(slot + CKS_XV + key * 32 + q * 8) = xt[j];
    }
}
__device__ __forceinline__ void ck_mfma(LAS unsigned char* slot, LAS unsigned char* scr, int lane) {
    const int n = lane & 15, q = lane >> 4;
    const f32x4 z4 = (f32x4){0.f, 0.f, 0.f, 0.f};
    f32x4 Nab = z4, NabT = z4, NakT = z4, Nbr = z4, Nkr = z4;
#pragma unroll
    for (int ks = 0; ks < 2; ++ks) {
        const int o = ck_img16(n, 4 * ks + q);
        const h8 fa = *(const LAS h8*)(scr + CKP_AT + o), fb = *(const LAS h8*)(scr + CKP_BT + o), fk = *(const LAS h8*)(scr + CKP_KT + o), fr8 = *(const LAS h8*)(scr + CKP_RT + o);
        Nab = MFMA32(fb, fa, Nab); NabT = MFMA32(fa, fb, NabT); NakT = MFMA32(fa, fk, NakT); Nbr = MFMA32(fb, fr8, Nbr); Nkr = MFMA32(fk, fr8, Nkr);
    }
    f32x4 P, Qm, MakT, Mbr, Mkr, Tm, Tt;
#pragma unroll
    for (int ii = 0; ii < 4; ++ii) { const int row = 4 * q + ii;
        P[ii] = row < n ? Nab[ii] : 0.f; Qm[ii] = n < row ? NabT[ii] : 0.f; MakT[ii] = n < row ? NakT[ii] : 0.f;
        Mbr[ii] = row <= n ? Nbr[ii] : 0.f; Mkr[ii] = row <= n ? Nkr[ii] : 0.f;
        const float id = row == n ? 1.f : 0.f; Tm[ii] = id + P[ii]; Tt[ii] = id + Qm[ii]; }
#pragma unroll
    for (int lev = 0; lev < 3; ++lev) {
        const h4 hp = cvt_h4(P), hq = cvt_h4(Qm);
        const f32x4 P2 = MFMA16(hq, hp, z4), Q2 = MFMA16(hp, hq, z4);
        const h4 hp2 = cvt_h4(P2), hq2 = cvt_h4(Q2), ht = cvt_h4(Tm), htt = cvt_h4(Tt);
        const f32x4 Tn = MFMA16(htt, hp2, Tm), Ttn = MFMA16(hp2, htt, Tt);
        P = P2; Qm = Q2; Tm = Tn; Tt = Ttn; (void)ht; (void)hq2;
    }
    const h4 hT = cvt_h4(Tm), hMbr = cvt_h4(Mbr), hMakT = cvt_h4(MakT);
    const f32x4 F = MFMA16(hMakT, hT, z4);
    const f32x4 Ft = MFMA16(hT, hMakT, z4);
    const h4 hF = cvt_h4(F), hFt = cvt_h4(Ft);
    const f32x4 Hy = MFMA16(hFt, hMbr, Mkr);
    const h4 hHy = cvt_h4(Hy);
#pragma unroll
    for (int kb = 0; kb < 4; ++kb) {
        const h4 fat = *(const LAS h4*)(scr + CKP_ATT + (16 * kb + n) * 32 + q * 8);
        const f32x4 lam = *(const LAS f32x4*)(scr + CKP_LR + (16 * kb + 4 * q) * 4);
        const f32x4 E = MFMA16(fat, hT, z4);
        const f32x4 Et = MFMA16(hT, fat, z4);
        const int oe = ck_img8(n, 8 * (kb >> 1) + 2 * q + (kb & 1));
        *(LAS h4*)(slot + CKS_ET + oe) = cvt_h4(E * lam);
        const f32x4 rt = h4_f32(*(const LAS h4*)(scr + CKP_RT + ck_img8(n, 4 * kb + q)));
        const f32x4 Gy = MFMA16(cvt_h4(Et), hMbr, rt);
        *(LAS h4*)(slot + CKS_GY + oe) = cvt_h4(Gy * lam);
        const h4 fx = *(const LAS h4*)(slot + CKS_XV + (16 * kb + n) * 32 + q * 8);
        const f32x4 U0 = MFMA16(hF, fx, z4), Y0 = MFMA16(hHy, fx, z4);
        *(LAS h4*)(slot + CKS_U0 + kb * 512 + lane * 8) = cvt_h4(U0); *(LAS h4*)(slot + CKS_Y0 + kb * 512 + lane * 8) = cvt_h4(Y0);
    }
}
__device__ __forceinline__ void ck_consume(const LAS unsigned char* slot, f32x4 (&Sb)[4], int vb, int lane, bf16* Yrow  ) {
    const int n = lane & 15, q = lane >> 4;
    f32x4 U = h4_f32(*(const LAS h4*)(slot + CKS_U0 + vb * 512 + lane * 8)), Yv = h4_f32(*(const LAS h4*)(slot + CKS_Y0 + vb * 512 + lane * 8));
#pragma unroll
    for (int ks = 0; ks < 2; ++ks) {
        const int o = ck_img16(n, 4 * ks + q);
        const h8 fe = *(const LAS h8*)(slot + CKS_ET + o), fg = *(const LAS h8*)(slot + CKS_GY + o);
        h8 fs;
#pragma unroll
        for (int j = 0; j < 8; ++j) fs[j] = (f16)Sb[2 * ks + (j >> 2)][j & 3];
        U = MFMA32(fe, fs, U); Yv = MFMA32(fg, fs, Yv);
    }
#pragma unroll
    for (int ii = 0; ii < 4; ++ii) Yrow[(size_t)(4 * q + ii) * 1024 + 16 * vb + n] = f2bf_c(Yv[ii]);
    const h4 fx = *(const LAS h4*)(slot + CKS_XV + (16 * vb + n) * 32 + q * 8);
    h8 fuv;
#pragma unroll
    for (int j = 0; j < 4; ++j) { fuv[j] = (f16)U[j]; fuv[4 + j] = fx[j]; }
#pragma unroll
    for (int kb = 0; kb < 4; ++kb) {
        const h8 fbk = *(const LAS h8*)(slot + CKS_BK + (16 * kb + n) * 64 + q * 16);
        const f32x4 lam = *(const LAS f32x4*)(slot + CKS_LC + (16 * kb + 4 * q) * 4);
        Sb[kb] = MFMA32(fbk, fuv, Sb[kb] * lam);
    }
}
__device__ __forceinline__ void phase_scan(const Args& a, LAS unsigned char* lds) {
    PH_PROLOG
    const bf16* PS = (const bf16*)(a.ws + WS_PS); const f16* LW = (const f16*)((const unsigned char*)a.out + U); const f16* AR = (const f16*)(a.ws + WS_AR);
    bf16* Y = (bf16*)a.out;
    volatile LAS unsigned* ready = (volatile LAS unsigned*)(lds + CK_FLAGS); volatile LAS unsigned* done = ready + 8;
    const int nsw = G > 128 ? G - 128 : G, sw0 = G > 128 ? 128 : 0;
    for (int pass = 0;; ++pass) {
        int task;
        if (G > 128) { if (bid < 128) { if (pass > 0) break; task = bid; } else { task = 128 + (bid - 128) + pass * nsw; if (task >= 640) break; } }
        else { task = bid + pass * G; if (task >= 640) break; }
        (void)sw0;
        const bool samp = task >= 128; const int tq = samp ? task - 128 : task;
        const int b = tq >> 4, h = tq & 15;
        const int m0 = samp ? NPROMPT + b * 64 : b * 4096, nch = samp ? 4 : 256;
        if (tid < 16) ready[tid] = 0u;
        __syncthreads();
        if (wave < CK_NPROD) {
            const int q = lane >> 4, kg = lane & 15, cidx = h * 64 + 4 * kg;
            const float* ssrc = samp ? a.in[2] + (size_t)b * SHW + cidx : nullptr;
            LAS unsigned char* scr = lds + CK_SCR + wave * CKP_SIZE;
            CkRaw R;
            if (wave < nch) ck_load(R, PS, LW, AR, m0 + 16 * wave + 4 * q, cidx, m0);
            for (int c = wave; c < nch; c += CK_NPROD) {
                LAS unsigned char* slot = lds + CK_SLOTS + (c % CK_NSLOT) * CKS_SIZE;
                unsigned tch0 = 0u, tch1 = 0u;
                if (c + 2 * CK_NPROD < nch) {
                    const int mt = m0 + 16 * (c + 2 * CK_NPROD);
                    { const int tk = lane / 5, ar_ = lane - 5 * tk; const size_t row = (size_t)(mt + tk);
                      const unsigned* p = ar_ < 3 ? (const unsigned*)(PS + row * SHW + ar_ * 1024 + h * 64) : (ar_ == 3 ? (const unsigned*)(LW + row * 1024 + h * 64) : (const unsigned*)(AR + row * 1024 + h * 64));
                      tch0 = *p; }
                    if (lane < 16) { const int idx = 64 + lane, tk = idx / 5, ar_ = idx - 5 * tk; const size_t row = (size_t)(mt + tk);
                      const unsigned* p = ar_ < 3 ? (const unsigned*)(PS + row * SHW + ar_ * 1024 + h * 64) : (ar_ == 3 ? (const unsigned*)(LW + row * 1024 + h * 64) : (const unsigned*)(AR + row * 1024 + h * 64));
                      tch1 = *p; }
                }
                if (c >= CK_NSLOT) {
#pragma unroll
                    for (int j = 0; j < CK_NCONS; ++j) ck_wait_ge(done + j, (unsigned)(c - CK_NSLOT + 1));
                }
                ck_prep(slot, scr, R, a.in, cidx, c == 0 && q == 0, ssrc, lane);
                if (c + CK_NPROD < nch) ck_load(R, PS, LW, AR, m0 + 16 * (c + CK_NPROD) + 4 * q, cidx, m0);
                ck_mfma(slot, scr, lane);
                asm volatile("s_waitcnt lgkmcnt(0)" ::: "memory");
                if (lane == 0) ready[c % CK_NSLOT] = (unsigned)(c + 1);
                asm volatile("" :: "v"(tch0), "v"(tch1));
            }
        } else if (wave < CK_NPROD + CK_NCONS) {
            const int cj = wave - CK_NPROD, n = lane & 15, q = lane >> 4;
            f32x4 Sb[CK_NVB][4];
#pragma unroll
            for (int v = 0; v < CK_NVB; ++v)
#pragma unroll
                for (int kb = 0; kb < 4; ++kb) {
                    Sb[v][kb] = (f32x4){0.f, 0.f, 0.f, 0.f};
                    if (samp) Sb[v][kb] = *(const f32x4*)(a.in[3] + ((size_t)((b * 16 + h) * 64 + 16 * (cj * CK_NVB + v) + n)) * 64 + 16 * kb + 4 * q);
                }
            for (int c = 0; c < nch; ++c) {
                const LAS unsigned char* slot = lds + CK_SLOTS + (c % CK_NSLOT) * CKS_SIZE;
                ck_wait_ge(ready + (c % CK_NSLOT), (unsigned)(c + 1));
                asm volatile("" ::: "memory");
#pragma unroll
                for (int v = 0; v < CK_NVB; ++v) ck_consume(slot, Sb[v], cj * CK_NVB + v, lane, Y + (size_t)(m0 + 16 * c) * 1024 + h * 64);
                asm volatile("s_waitcnt lgkmcnt(0)" ::: "memory");
                if (lane == 0) done[cj] = (unsigned)(c + 1);
            }
            float* So = a.out + (samp ? OUT_WKV_S : OUT_WKV_P);
#pragma unroll
            for (int v = 0; v < CK_NVB; ++v)
#pragma unroll
                for (int kb = 0; kb < 4; ++kb) *(f32x4*)(So + ((size_t)((b * 16 + h) * 64 + 16 * (cj * CK_NVB + v) + n)) * 64 + 16 * kb + 4 * q) = Sb[v][kb];
        }
        __syncthreads();
    }
    if (G > 128 && bid >= 128) conv_items(a, CV_EARLY, CV_ALL, (bid - 128) * 8 + wave, (G - 128) * 8, lane);
}

__device__ __forceinline__ void ld16bf(const bf16* p, float (&o)[16]) {
    const u32x4 w0 = *(const u32x4*)p, w1 = *(const u32x4*)(p + 8); f32x4 a, b, c, d; dec8bf(w0, a, b); dec8bf(w1, c, d);
#pragma unroll
    for (int i = 0; i < 4; ++i) { o[i] = a[i]; o[4 + i] = b[i]; o[8 + i] = c[i]; o[12 + i] = d[i]; }
}
__device__ __forceinline__ void ld16h(const f16* p, float (&o)[16]) {
    const u32x4 w0 = *(const u32x4*)p, w1 = *(const u32x4*)(p + 8);
    const f32x4 a = dec4h((u32x2){w0.x, w0.y}), b = dec4h((u32x2){w0.z, w0.w}), c = dec4h((u32x2){w1.x, w1.y}), d = dec4h((u32x2){w1.z, w1.w});
#pragma unroll
    for (int i = 0; i < 4; ++i) { o[i] = a[i]; o[4 + i] = b[i]; o[8 + i] = c[i]; o[12 + i] = d[i]; }
}
__device__ __forceinline__ void ld16f(const float* p, float (&o)[16]) {
#pragma unroll
    for (int j = 0; j < 4; ++j) { const f32x4 x = ((const f32x4*)p)[j];
#pragma unroll
        for (int i = 0; i < 4; ++i) o[4 * j + i] = x[i]; }
}
__device__ __forceinline__ void tokshift16(float (&x)[16], const bf16* prevp, bool has_prev, bool samp, const float* ssrc, const float* mu) {
    float tmp[16], cst[16];
    if (has_prev) ld16bf(prevp, tmp);
    else if (samp) ld16f(ssrc, tmp);
    else {
#pragma unroll
        for (int i = 0; i < 16; ++i) tmp[i] = 0.f; }
    ld16f(mu, cst);
#pragma unroll
    for (int i = 0; i < 16; ++i) x[i] = x[i] + (tmp[i] - x[i]) * cst[i];
}
__device__ __forceinline__ float oct_sum(float x) { x += dppf<0xB1>(x); x += dppf<0x4E>(x); x += dppf<0x141>(x); return x; }
__device__ __forceinline__ void ld8f(const float* p, float (&o)[8]) { const f32x4 a = *(const f32x4*)p, b = *(const f32x4*)(p + 4);
#pragma unroll
    for (int i = 0; i < 4; ++i) { o[i] = a[i]; o[4 + i] = b[i]; } }
__device__ __forceinline__ void ld8bf(const bf16* p, float (&o)[8]) { f32x4 a, b; dec8bf(*(const u32x4*)p, a, b);
#pragma unroll
    for (int i = 0; i < 4; ++i) { o[i] = a[i]; o[4 + i] = b[i]; } }
__device__ __forceinline__ void ld8h(const f16* p, float (&o)[8]) { const u32x4 w = *(const u32x4*)p; const f32x4 a = dec4h((u32x2){w.x, w.y}), b = dec4h((u32x2){w.z, w.w});
#pragma unroll
    for (int i = 0; i < 4; ++i) { o[i] = a[i]; o[4 + i] = b[i]; } }
template <bool DRY> __device__ __forceinline__ void phase_gn(const Args& a, LAS unsigned char* lds) {
    PH_PROLOG
    const bf16* PS = (const bf16*)(a.ws + WS_PS); const f16* AR = (const f16*)(a.ws + WS_AR); f16* Gp = (f16*)(a.ws + WS_G);
    const bf16* Y = (const bf16*)a.out;
    const int h = gw & 15, c = h * 64 + 8 * (lane & 7), r8 = lane >> 3;
    float mu_r[8], mu_k[8], mu_v[8], ka[8], rkc[8], gg[8], gb[8];
    ld8f(a.in[6] + c, mu_r); ld8f(a.in[6] + 1024 + c, mu_k); ld8f(a.in[6] + 2048 + c, mu_v); ld8f(a.in[13] + c, ka); ld8f(a.in[14] + c, rkc); ld8f(a.in[15] + c, gg); ld8f(a.in[16] + c, gb);
    for (int rg = gw >> 4; rg < M / 8; rg += NGW >> 4) {
        const int m = rg * 8 + r8; const bool samp = m >= NPROMPT; const int t = samp ? ((m - NPROMPT) & 63) : (m & 4095);
        const bf16* base = PS + (size_t)m * SHW + c;
        float xr[8], xk[8], xv[8], pr[8], pk[8], pv[8], ar[8], y[8], g[8];
        ld8bf(base, xr); ld8bf(base + 1024, xk); ld8bf(base + 2048, xv);
        if (t > 0) { ld8bf(base - SHW, pr); ld8bf(base - SHW + 1024, pk); ld8bf(base - SHW + 2048, pv); }
        else if (samp) { const float* ss = a.in[2] + (size_t)((m - NPROMPT) >> 6) * SHW + c; ld8f(ss, pr); ld8f(ss + 1024, pk); ld8f(ss + 2048, pv); }
        else {
#pragma unroll
            for (int i = 0; i < 8; ++i) { pr[i] = 0.f; pk[i] = 0.f; pv[i] = 0.f; } }
        ld8h(AR + (size_t)m * 1024 + c, ar); ld8bf(Y + (size_t)m * 1024 + c, y); ld8h(Gp + (size_t)m * 1024 + c, g);
        float rk = 0.f, s = 0.f;
#pragma unroll
        for (int i = 0; i < 8; ++i) {
            xr[i] = xr[i] + (pr[i] - xr[i]) * mu_r[i]; xk[i] = xk[i] + (pk[i] - xk[i]) * mu_k[i]; xv[i] = xv[i] + (pv[i] - xv[i]) * mu_v[i];
            xk[i] = xk[i] * (1.f + (ar[i] - 1.f) * ka[i]);
            rk += xr[i] * xk[i] * rkc[i]; s += y[i];
        }
        rk = oct_sum(rk);
        const float mean = oct_sum(s) * (1.f / 64.f); float q2 = 0.f;
#pragma unroll
        for (int i = 0; i < 8; ++i) { y[i] -= mean; q2 += y[i] * y[i]; }
        const float rstd = rsqrtf(oct_sum(q2) * (1.f / 64.f) + 64e-5f);
        float o[8];
#pragma unroll
        for (int i = 0; i < 8; ++i) o[i] = (y[i] * rstd * gg[i] + gb[i] + rk * xv[i]) * g[i];
        u32x4 w; w.x = pkbf(o[0], o[1]); w.y = pkbf(o[2], o[3]); w.z = pkbf(o[4], o[5]); w.w = pkbf(o[6], o[7]);
        if (!DRY || rk == 1.2345e30f) *(u32x4*)((bf16*)Gp + (size_t)m * 1024 + c) = w;
    }
}

__device__ __forceinline__ int gm_swz(int row) { return (row & 3) | (((row >> 3) & 1) << 2); }
__device__ __forceinline__ void phase_gmlp(const Args& a, LAS unsigned char* lds) {
    PH_PROLOG
    const bf16* PU = (const bf16*)(a.ws + WS_P4); const bf16* PV = (const bf16*)(a.ws + WS_P4 + U); bf16* OB = (bf16*)(a.ws + WS_OB);
    const bf16* WSP = (const bf16*)(a.ws + WS_WSP);
    LAS float* stats = (LAS float*)lds;
    LAS unsigned char* img = lds + 4096;
    for (int unit = bid; unit < 272; unit += G) {
        const bool samp = unit >= 256; const int m0 = unit * 128;
        for (int i = 0; i < 16; ++i) {
            const int tk = wave * 16 + i; float x[16]; ld16bf(PV + (size_t)(m0 + tk) * 1024 + 16 * lane, x);
            float s = 0.f;
#pragma unroll
            for (int j = 0; j < 16; ++j) s += x[j];
            const float mean = wave_sum(s) * (1.f / 1024.f); float q2 = 0.f;
#pragma unroll
            for (int j = 0; j < 16; ++j) { x[j] -= mean; q2 += x[j] * x[j]; }
            const float rstd = rsqrtf(wave_sum(q2) * (1.f / 1024.f) + 1e-5f);
            if (lane == 0) { stats[2 * tk] = mean; stats[2 * tk + 1] = rstd; }
            if (samp) {
                float g[16], bb[16]; ld16f(a.in[17] + 16 * lane, g); ld16f(a.in[18] + 16 * lane, bb);
                float* o = a.out + OUT_VS + (size_t)(m0 + tk - NPROMPT) * 1024 + 16 * lane;
#pragma unroll
                for (int j = 0; j < 4; ++j) ((f32x4*)o)[j] = (f32x4){x[4 * j] * rstd * g[4 * j] + bb[4 * j], x[4 * j + 1] * rstd * g[4 * j + 1] + bb[4 * j + 1], x[4 * j + 2] * rstd * g[4 * j + 2] + bb[4 * j + 2], x[4 * j + 3] * rstd * g[4 * j + 3] + bb[4 * j + 3]};
            }
        }
        __syncthreads();
        const int trow_off = (samp && wave >= 4) ? 64 : 0, t0 = wave * 16;
        const int ks_lo = trow_off >> 5, ks_hi = (t0 + 15) >> 5;
        for (int g = 0; g < 8; ++g) {
#pragma unroll
            for (int i = 0; i < 4; ++i) {
                const int p = tid + 512 * i, row = p >> 4, c8 = p & 15, gc = g * 128 + 8 * c8;
                f32x4 x0, x1; dec8bf(*(const u32x4*)(PV + (size_t)(m0 + row) * 1024 + gc), x0, x1);
                const float mean = stats[2 * row], rstd = stats[2 * row + 1];
                const f32x4 g0 = *(const f32x4*)(a.in[17] + gc), g1 = *(const f32x4*)(a.in[17] + gc + 4), b0 = *(const f32x4*)(a.in[18] + gc), b1 = *(const f32x4*)(a.in[18] + gc + 4);
                x0 = (x0 - mean) * rstd * g0 + b0; x1 = (x1 - mean) * rstd * g1 + b1;
                *(LAS u32x4*)(img + row * 256 + (((c8 >> 1) ^ gm_swz(row)) << 5) + (c8 & 1) * 16) = pk8bf(x0, x1);
            }
            __syncthreads();
            f32x4 acc[8];
#pragma unroll
            for (int ct = 0; ct < 8; ++ct) acc[ct] = (f32x4){0.f, 0.f, 0.f, 0.f};
            for (int ks = ks_lo; ks <= ks_hi; ++ks) {
                const bf16x8 wf = *(const bf16x8*)(WSP + ((size_t)(g * 128 + t0 - trow_off + (lane & 15))) * 128 + 32 * ks - trow_off + 8 * (lane >> 4));
                const int row = 32 * ks + 8 * (lane >> 4) + ((lane & 15) >> 2);
                const int sw = gm_swz(row);
#pragma unroll
                for (int ct = 0; ct < 8; ++ct) {
                    LAS unsigned char* p = img + row * 256 + ((ct ^ sw) << 5) + (lane & 3) * 8;
                    const s16x4 lo = __builtin_amdgcn_ds_read_tr16_b64_v4i16((LAS s16x4*)p), hi = __builtin_amdgcn_ds_read_tr16_b64_v4i16((LAS s16x4*)(p + 1024));
                    bf16x8 vf; vf[0] = lo[0]; vf[1] = lo[1]; vf[2] = lo[2]; vf[3] = lo[3]; vf[4] = hi[0]; vf[5] = hi[1]; vf[6] = hi[2]; vf[7] = hi[3];
                    acc[ct] = __builtin_amdgcn_mfma_f32_16x16x32_bf16(vf, wf, acc[ct], 0, 0, 0);
                }
            }
            const int t = t0 + (lane & 15);
            const float bias = a.in[20][g * 128 + t - trow_off];
#pragma unroll
            for (int ct = 0; ct < 8; ++ct) {
                const size_t o = (size_t)(m0 + t) * 1024 + g * 128 + 16 * ct + 4 * (lane >> 4);
                const f32x4 pu = dec4bf(*(const u32x2*)(PU + o));
                *(u32x2*)(OB + o) = pk4bf(pu * (acc[ct] + bias));
            }
            __syncthreads();
        }
    }
}

__device__ __forceinline__ void phase_p5b(const Args& a, LAS unsigned char* lds) {
    PH_PROLOG
    const float* MO = (const float*)(a.ws + WS_MO); bf16* F = (bf16*)(a.ws + WS_F);
    for (int m = gw; m < M; m += NGW) {
        const float* xr = xrow_ptr(a, m); f32x4 v[4]; float ss = 0.f;
#pragma unroll
        for (int j = 0; j < 4; ++j) { v[j] = ((const f32x4*)(MO + (size_t)m * 1024))[lane + 64 * j]; ss += (v[j][0] * v[j][0] + v[j][1] * v[j][1]) + (v[j][2] * v[j][2] + v[j][3] * v[j][3]); }
        const float rs = rsqrtf(wave_sum(ss) * (1.f / 1024.f) + 1e-6f); float s2 = 0.f;
#pragma unroll
        for (int j = 0; j < 4; ++j) { const f32x4 g = ((const f32x4*)a.in[24])[lane + 64 * j], x = ((const f32x4*)xr)[lane + 64 * j];
            v[j] = x + v[j] * rs * g; ((f32x4*)(a.out + OUT_Y + (size_t)m * 1024))[lane + 64 * j] = v[j];
            s2 += (v[j][0] * v[j][0] + v[j][1] * v[j][1]) + (v[j][2] * v[j][2] + v[j][3] * v[j][3]); }
        const float rs2 = rsqrtf(wave_sum(s2) * (1.f / 1024.f) + 1e-6f);
#pragma unroll
        for (int j = 0; j < 4; ++j) { const f32x4 g = ((const f32x4*)a.in[25])[lane + 64 * j]; ((u32x2*)(F + (size_t)m * 1024))[lane + 64 * j] = pk4bf(v[j] * rs2 * g); }
    }
}
__device__ __forceinline__ void phase_p7b(const Args& a, LAS unsigned char* lds) {
    PH_PROLOG
    const float* F2 = (const float*)(a.ws + WS_F2);
    for (int m = gw; m < M; m += NGW) {
        f32x4 v[4]; float ss = 0.f;
#pragma unroll
        for (int j = 0; j < 4; ++j) { v[j] = ((const f32x4*)(F2 + (size_t)m * 1024))[lane + 64 * j]; ss += (v[j][0] * v[j][0] + v[j][1] * v[j][1]) + (v[j][2] * v[j][2] + v[j][3] * v[j][3]); }
        const float rs = rsqrtf(wave_sum(ss) * (1.f / 1024.f) + 1e-6f);
        f32x4* o = (f32x4*)(a.out + OUT_Y + (size_t)m * 1024);
#pragma unroll
        for (int j = 0; j < 4; ++j) { const f32x4 g = ((const f32x4*)a.in[29])[lane + 64 * j]; o[lane + 64 * j] = o[lane + 64 * j] + v[j] * rs * g; }
    }
}

#define XB_TMO      128
#define XB_XCNT(j)  (256  + 64 * (j))
#define XB_XSUB(j)  (1280 + 64 * (j))
#define XB_XGEN(j)  (2304 + 64 * (j))
#define XB_TOP      3328
#define XB_TOPGEN   3392
#define XCD_BAR_WORDS 3456
#define XB_SPIN_CAP (1u << 18)

__device__ __forceinline__ unsigned xb_ld(unsigned* p)              { return __hip_atomic_load(p, __ATOMIC_RELAXED, __HIP_MEMORY_SCOPE_AGENT); }
__device__ __forceinline__ unsigned xb_add(unsigned* p, unsigned v) { return __hip_atomic_fetch_add(p, v, __ATOMIC_RELAXED, __HIP_MEMORY_SCOPE_AGENT); }
__device__ __forceinline__ unsigned xb_xcc_id() { return (unsigned)__builtin_amdgcn_s_getreg((3 << 11) | 20) & 0xFu; }
#define XB_SPIN(cond, bar) do { unsigned _sp = 0; while (cond) { __builtin_amdgcn_s_sleep(1); \
    if ((++_sp & 255u) == 0u) { if (xb_ld(&(bar)[XB_TMO])) break; if (_sp > XB_SPIN_CAP) { atomicAdd(&(bar)[XB_TMO], 1u); break; } } } } while (0)

struct XcdBarrier {
    unsigned* bar; unsigned x;
    volatile LAS unsigned* st;
};

__device__ __forceinline__ XcdBarrier xcd_barrier_post(unsigned* bar, volatile LAS unsigned* st) {
    XcdBarrier b; b.bar = bar; b.x = xb_xcc_id(); b.st = st;
    if (threadIdx.x == 0) (void)xb_add(&bar[XB_XCNT(b.x)], 1u);
    return b;
}
__device__ __forceinline__ void xcd_barrier_complete(unsigned* bar, unsigned x, unsigned& nloc, unsigned& nx) {
    const unsigned G = gridDim.x * gridDim.y * gridDim.z;
    unsigned sum, cnt, mine, sp = 0u;
    for (;;) {
        sum = 0u; cnt = 0u; mine = 0u;
#pragma unroll
        for (unsigned j = 0; j < 16; ++j) { const unsigned c = xb_ld(&bar[XB_XCNT(j)]); sum += c; cnt += (c > 0u) ? 1u : 0u; mine = (j == x) ? c : mine; }
        if (sum == G) break;
        __builtin_amdgcn_s_sleep(1);
        if ((++sp & 255u) == 0u) { if (xb_ld(&bar[XB_TMO])) break; if (sp > XB_SPIN_CAP) { atomicAdd(&bar[XB_TMO], 1u); break; } }
    }
    nloc = mine > 0u ? mine : 1u; nx = cnt > 0u ? cnt : 1u;
}

__device__ __forceinline__ void xcd_barrier(const XcdBarrier& b) {
    asm volatile("s_waitcnt vmcnt(0)" ::: "memory");
    __syncthreads();
    if (threadIdx.x == 0) {
        unsigned* bar = b.bar;
        __builtin_amdgcn_s_waitcnt(0);
        unsigned nloc = b.st[0], nx = b.st[1];
        if (nloc == 0u) { xcd_barrier_complete(bar, b.x, nloc, nx); b.st[0] = nloc; b.st[1] = nx; }
        const unsigned old = xb_add(&bar[XB_XSUB(b.x)], 1u);
        const unsigned gen = old / nloc;
        if (old + 1u == (gen + 1u) * nloc) {
            __builtin_amdgcn_fence(__ATOMIC_RELEASE, "agent");
            asm volatile("s_waitcnt vmcnt(0)" ::: "memory");
            const unsigned og = xb_add(&bar[XB_TOP], 1u);
            const unsigned tg = og / nx;
            if (og + 1u == (tg + 1u) * nx) xb_add(&bar[XB_TOPGEN], 1u);
            else XB_SPIN(xb_ld(&bar[XB_TOPGEN]) == tg, bar);
            __builtin_amdgcn_fence(__ATOMIC_ACQUIRE, "agent");
            xb_add(&bar[XB_XGEN(b.x)], 1u);
            asm volatile("s_waitcnt vmcnt(0)" ::: "memory");
        } else {
            XB_SPIN(xb_ld(&bar[XB_XGEN(b.x)]) == gen, bar);
            __builtin_amdgcn_fence(__ATOMIC_ACQUIRE, "agent");
            asm volatile("s_waitcnt vmcnt(0)" ::: "memory");
        }
    }
    __syncthreads();
}

template <class E> __device__ __forceinline__ void run_gemm(LAS unsigned char* lds, const bf16* A, const bf16* Bt, int N, int K, const E& e) {
    pg8::Gemm g{A, Bt, M, N, K}; pg8::StaticOrder S; S.init(M, N, (int)gridDim.x, (int)blockIdx.x);
    pg8::gemm_phase<E, pg8::StaticOrder, true, true>(lds, g, S, e);
}
__global__ void __launch_bounds__(512, 2) mk_fwd(Args a) {
    extern __shared__ __attribute__((aligned(16))) unsigned char lds_raw[];
    LAS unsigned char* lds = (LAS unsigned char*)lds_raw;
    unsigned char* ws = a.ws;
    const int lo = a.ph_lo, hi = a.ph_hi;
    volatile LAS unsigned* MISC = (volatile LAS unsigned*)(lds + LDS_BYTES - 256);
    if (threadIdx.x < 64) MISC[threadIdx.x] = 0u;
    __syncthreads();
#define IN(k) (lo <= (k) && (k) < hi)
#ifndef MK_REP
#define MK_REP -1
#endif
#define XBAR() do { XcdBarrier b_; b_.bar = (unsigned*)a.ws; b_.x = xb_xcc_id(); b_.st = (volatile LAS unsigned*)(lds + LDS_BYTES - 256) + 8; xcd_barrier(b_); } while (0)
#define SEAM(k) do { if (IN(k) && IN((k) + 1)) { if ((k) == 0) { cg::this_grid().sync(); if (threadIdx.x == 0) (void)xb_add((unsigned*)a.ws + XB_XCNT(xb_xcc_id()), 1u); } else XBAR(); } } while (0)
#define REP(k, ...) do { if (MK_REP == (k)) { XBAR(); __VA_ARGS__; } } while (0)
    if (IN(0)) { phase_p0(a, lds); REP(0, phase_p0(a, lds)); } SEAM(0);
    if (IN(1)) { Epi8<FStoreBf16> e{{(bf16*)(ws + WS_PS), SHW}}; run_gemm(lds, (const bf16*)(ws + WS_XN), (const bf16*)(ws + WS_WIN), SHW, 1024, e); REP(1, Epi8<FStoreBf16> e{{(bf16*)(ws + WS_PS), SHW}}; run_gemm(lds, (const bf16*)(ws + WS_XN), (const bf16*)(ws + WS_WIN), SHW, 1024, e)); } SEAM(1);
    if (IN(2)) { phase_p2a(a, lds); REP(2, phase_p2a(a, lds)); } SEAM(2);
    if (IN(3)) { Epi8<FLora> e{{(f16*)((unsigned char*)a.out + U), (f16*)(ws + WS_AR), (f16*)(ws + WS_G), a.in[7], a.in[9]}}; run_gemm(lds, (const bf16*)(ws + WS_LX), (const bf16*)(ws + WS_LORA), 3072, 256, e); REP(3, Epi8<FLora> e{{(f16*)((unsigned char*)a.out + U), (f16*)(ws + WS_AR), (f16*)(ws + WS_G), a.in[7], a.in[9]}}; run_gemm(lds, (const bf16*)(ws + WS_LX), (const bf16*)(ws + WS_LORA), 3072, 256, e)); } SEAM(3);
    if (IN(4)) { phase_scan(a, lds); REP(4, phase_scan(a, lds)); } SEAM(4);
    if (IN(5)) { phase_gn<false>(a, lds); REP(5, phase_gn<true>(a, lds)); } SEAM(5);
    if (IN(6)) { Epi8<FP1b> e{{(bf16*)(ws + WS_P4)}}; run_gemm(lds, (const bf16*)(ws + WS_XN), (const bf16*)(ws + WS_WIN) + (size_t)SHW * 1024, 4096, 1024, e); REP(6, Epi8<FP1b> e{{(bf16*)(ws + WS_P4)}}; run_gemm(lds, (const bf16*)(ws + WS_XN), (const bf16*)(ws + WS_WIN) + (size_t)SHW * 1024, 4096, 1024, e)); } SEAM(6);
    if (IN(7)) { phase_gmlp(a, lds); REP(7, phase_gmlp(a, lds)); } SEAM(7);
    if (IN(8)) { Epi8<FGateA> e{{(const bf16*)(ws + WS_P4 + 2 * U), (bf16*)(ws + WS_MM)}}; run_gemm(lds, (const bf16*)(ws + WS_OA), (const bf16*)(ws + WS_WA), 1024, 1024, e); REP(8, Epi8<FGateA> e{{(const bf16*)(ws + WS_P4 + 2 * U), (bf16*)(ws + WS_MM)}}; run_gemm(lds, (const bf16*)(ws + WS_OA), (const bf16*)(ws + WS_WA), 1024, 1024, e)); } SEAM(8);
    if (IN(9)) { Epi8<FGateB> e{{(const bf16*)(ws + WS_P4 + 3 * U), (bf16*)(ws + WS_MM)}}; run_gemm(lds, (const bf16*)(ws + WS_OB), (const bf16*)(ws + WS_WB), 1024, 1024, e); REP(9, Epi8<FGateB> e{{(const bf16*)(ws + WS_P4 + 3 * U), (bf16*)(ws + WS_MM)}}; run_gemm(lds, (const bf16*)(ws + WS_OB), (const bf16*)(ws + WS_WB), 1024, 1024, e)); } SEAM(9);
    if (IN(10)) { Epi4<FStoreF32> e{{(float*)(ws + WS_MO), 1024}}; run_gemm(lds, (const bf16*)(ws + WS_MM), (const bf16*)(ws + WS_WO), 1024, 1024, e); REP(10, Epi4<FStoreF32> e{{(float*)(ws + WS_MO), 1024}}; run_gemm(lds, (const bf16*)(ws + WS_MM), (const bf16*)(ws + WS_WO), 1024, 1024, e)); } SEAM(10);
    if (IN(11)) { phase_p5b(a, lds); REP(11, phase_p5b(a, lds)); } SEAM(11);
    if (IN(12)) { EpiGU e{(bf16*)(ws + WS_H)}; run_gemm(lds, (const bf16*)(ws + WS_F), (const bf16*)(ws + WS_GU), 2 * DFF, 1024, e); REP(12, EpiGU e{(bf16*)(ws + WS_H)}; run_gemm(lds, (const bf16*)(ws + WS_F), (const bf16*)(ws + WS_GU), 2 * DFF, 1024, e)); } SEAM(12);
    if (IN(13)) { Epi4<FStoreF32> e{{(float*)(ws + WS_F2), 1024}}; run_gemm(lds, (const bf16*)(ws + WS_H), (const bf16*)(ws + WS_WD), 1024, DFF, e); REP(13, Epi4<FStoreF32> e{{(float*)(ws + WS_F2), 1024}}; run_gemm(lds, (const bf16*)(ws + WS_H), (const bf16*)(ws + WS_WD), 1024, DFF, e)); } SEAM(13);
    if (MK_REP == 100) { for (int i = 0; i < 14; ++i) XBAR(); }
    if (IN(14)) { phase_p7b(a, lds); }
#undef IN
#undef SEAM
}


#ifndef MK_DBG
#define MK_DBG 0
#endif
__global__ void dbg_zero(float* p, size_t n) { for (size_t i = (size_t)blockIdx.x * blockDim.x + threadIdx.x; i < n; i += (size_t)gridDim.x * blockDim.x) p[i] = 0.f; }
extern "C" void kernel_launch(void* const* d_in, const int* in_sizes, int n_in, void* d_out, int out_size, void* d_ws, size_t ws_size, hipStream_t stream) {
    static int grid = 0;
    if (grid == 0) {
        if (n_in != 30 || (size_t)out_size != OUT_END || ws_size < WS_END) { fprintf(stderr, "kernel_launch: unexpected shapes (n_in %d out %d ws %zu, need ws >= %zu)\n", n_in, out_size, ws_size, (size_t)WS_END); }
        int dev = 0, cus = 0, per_cu = 0;
        (void)hipGetDevice(&dev); (void)hipDeviceGetAttribute(&cus, hipDeviceAttributeMultiprocessorCount, dev);
        (void)hipFuncSetAttribute((const void*)mk_fwd, hipFuncAttributeMaxDynamicSharedMemorySize, LDS_BYTES);
        (void)hipOccupancyMaxActiveBlocksPerMultiprocessor(&per_cu, (const void*)mk_fwd, 512, LDS_BYTES);
        if (per_cu < 1) { fprintf(stderr, "kernel_launch: occupancy query says %d blocks per CU\n", per_cu); per_cu = 1; }
        grid = cus > 0 ? cus : 256;
        (void)hipGetLastError();
    }
    Args a{};
    for (int i = 0; i < 30; ++i) a.in[i] = (const float*)d_in[i];
    a.out = (float*)d_out; a.ws = (unsigned char*)d_ws;
#if MK_ONE_LAUNCH
    (void)hipMemsetAsync(d_ws, 0, 65536, stream);
    a.ph_lo = 0; a.ph_hi = NPHASE;
    void* args[] = {&a};
    hipError_t e = hipLaunchCooperativeKernel((const void*)mk_fwd, dim3(grid), dim3(512), args, LDS_BYTES, stream);
    if (e != hipSuccess) fprintf(stderr, "cooperative launch failed: %s (grid %d)\n", hipGetErrorString(e), grid);
#else
    const int nph = MK_DBG == 1 ? 5 : (MK_DBG == 2 ? 3 : (MK_DBG == 3 ? 8 : NPHASE));
    for (int p = 0; p < nph; ++p) { a.ph_lo = p; a.ph_hi = p + 1; hipLaunchKernelGGL(mk_fwd, dim3(grid), dim3(512), LDS_BYTES, stream, a); }
    float* o = (float*)d_out;
    if (MK_DBG >= 1) hipLaunchKernelGGL(dbg_zero, dim3(1024), dim3(256), 0, stream, o + OUT_Y, (size_t)M * 1024);
    if (MK_DBG == 1 || MK_DBG == 2) hipLaunchKernelGGL(dbg_zero, dim3(1024), dim3(256), 0, stream, o + OUT_VS, (size_t)32 * 64 * 1024);
    if (MK_DBG == 2) { hipLaunchKernelGGL(dbg_zero, dim3(1024), dim3(256), 0, stream, o + OUT_WKV_P, (size_t)8 * 16 * 4096); hipLaunchKernelGGL(dbg_zero, dim3(1024), dim3(256), 0, stream, o + OUT_WKV_S, (size_t)32 * 16 * 4096); }
#endif
}
```

```cpp
#include <hip/hip_runtime.h>
#include <hip/hip_cooperative_groups.h>
#include <cstdio>
#include <cstdint>
namespace cg = cooperative_groups;
namespace pg8 {
#define PG8_LAS __attribute__((address_space(3)))
typedef unsigned short bf16_t;
typedef short bf16x8 __attribute__((ext_vector_type(8)));
typedef float f32x4 __attribute__((ext_vector_type(4)));
typedef unsigned u32x4 __attribute__((ext_vector_type(4)));
constexpr int BM = 256, BK = 64, HALF = 128, HTB = HALF * BK * 2  , STAGE_BYTES = 8 * HTB, NXCD = 8, WGM = 8;

__host__ __device__ __forceinline__ int lds_byte(int r, int c) { const int st = (r >> 4) * 2 + (c >> 5), rr = r & 15, cc = c & 31, ob = rr * 64 + cc * 2; return st * 1024 + (ob ^ (((ob >> 9) & 1) << 5)); }
__host__ __device__ __forceinline__ void stage_rc(int b, int& R, int& C) { const int st = b / 1024, sb = b % 1024, swz = sb ^ (((sb >> 9) & 1) << 5); R = (st >> 1) * 16 + swz / 64; C = (st & 1) * 32 + (swz % 64) / 2; }
__host__ __device__ __forceinline__ int perm32(int rho) { const int n = rho >> 4, i = rho & 15; return 8 * (i >> 2) + 4 * n + (i & 3); }

struct Unit { int pm, pn; };
struct Gemm { const bf16_t* A; const bf16_t* Bt; int M, N, K; };

struct StaticOrder {
    int nM, nN, nwg, G, c;
    __host__ __device__ void init(int M, int N, int G_, int c_) { nM = M / BM; nN = N / BM; nwg = nM * nN; G = G_; c = c_; }
    __host__ __device__ bool next(int i, Unit& u) const {
        const long L = (long)i * G + c; if (L >= nwg) return false;
        int wgid = (int)L; { const int q = nwg / NXCD, r = nwg % NXCD, xcd = wgid % NXCD, off = wgid / NXCD; wgid = (xcd < r ? xcd * (q + 1) : r * (q + 1) + (xcd - r) * q) + off; }
        const int nig = WGM * nN, gid = wgid / nig, fm = gid * WGM, gsz = (nM - fm) < WGM ? (nM - fm) : WGM;
        u.pm = fm + ((wgid % nig) % gsz); u.pn = (wgid % nig) / gsz; return true;
    }
    __device__ __forceinline__ void a_ready(const Unit&) const {}
    __device__ __forceinline__ void done(const Unit&) const {}
};

__device__ __forceinline__ unsigned cvt_pk_bf16(float lo, float hi) { unsigned r; asm volatile("v_cvt_pk_bf16_f32 %0, %1, %2" : "=v"(r) : "v"(lo), "v"(hi)); return r; }
typedef float f32x2 __attribute__((ext_vector_type(2)));
template <class Epi, class Sched, bool ALIGN_EPI = false, bool SP2 = false>
__device__ __forceinline__ void gemm_phase(PG8_LAS unsigned char* lds, const Gemm g, const Sched& S, const Epi& E) {
    const int tid = threadIdx.x, wid = __builtin_amdgcn_readfirstlane(tid >> 6), lane = tid & 63, wr = wid >> 2, wc = wid & 3, fr = lane & 15, fq = lane >> 4;
    const int K = g.K, nt = K / BK;
    unsigned voffA[2], voffB[2];
#pragma unroll
    for (int i = 0; i < 2; ++i) { int R, C; stage_rc(tid * 16 + i * 8192, R, C); const int Rb = Epi::PERM ? ((R & ~31) + perm32(R & 31)) : R;
        voffA[i] = (unsigned)(R * K + C) * 2u; voffB[i] = (unsigned)(Rb * K + C) * 2u; }
    const size_t kstep = (size_t)(BK * 2);
    const size_t hstep = (size_t)HALF * K * 2;
    const size_t tstep = 2 * hstep;
    const unsigned ldsw = (unsigned)wid * 1024u;
    const int aoff = lds_byte(wr * 64 + fr, fq * 8), boff = lds_byte(wc * 32 + fr, fq * 8);
#define PG8_SA(b, h) (((b) * 2 + (h)) * HTB)
#define PG8_SB(b, h) ((4 + (b) * 2 + (h)) * HTB)
#define PG8_STAGE(bufoff, gbase, voff) do { _Pragma("unroll") for (int _i = 0; _i < 2; ++_i) \
        __builtin_amdgcn_global_load_lds((const unsigned*)((const char*)(gbase) + (voff)[_i]), (PG8_LAS unsigned*)(lds + (bufoff) + ldsw + _i * 8192), 16, 0, 0); } while (0)
#define PG8_LDA(dst, b, h) do { _Pragma("unroll") for (int m = 0; m < 4; ++m) _Pragma("unroll") for (int k = 0; k < 2; ++k) dst[m][k] = *(const PG8_LAS bf16x8*)(lds + PG8_SA(b, h) + aoff + m * 2048 + k * 1024); } while (0)
#define PG8_LDB(dst, b, h) do { _Pragma("unroll") for (int n = 0; n < 2; ++n) _Pragma("unroll") for (int k = 0; k < 2; ++k) dst[n][k] = *(const PG8_LAS bf16x8*)(lds + PG8_SB(b, h) + boff + n * 2048 + k * 1024); } while (0)
#define PG8_MMA(ai, bj, At, Bt) do { __builtin_amdgcn_s_setprio(1); _Pragma("unroll") for (int m = 0; m < 4; ++m) _Pragma("unroll") for (int n = 0; n < 2; ++n) _Pragma("unroll") for (int k = 0; k < 2; ++k) \
        acc[ai][bj][m][n] = __builtin_amdgcn_mfma_f32_16x16x32_bf16(Bt[n][k], At[m][k], acc[ai][bj][m][n], 0, 0, 0); __builtin_amdgcn_s_setprio(0); } while (0)
#define PG8_WAIT_V(n) asm volatile("s_waitcnt vmcnt(" #n ")" ::: "memory")
#define PG8_WAIT_L(n) asm volatile("s_waitcnt lgkmcnt(" #n ")" ::: "memory")
#define PG8_BAR __builtin_amdgcn_s_barrier()
#define PG8_SCHED __builtin_amdgcn_sched_barrier(0)
    Unit cur, nxt; int ui = 0;
    if (!S.next(0, cur)) return;
    f32x4 acc[2][2][4][2];
#pragma unroll
    for (int a = 0; a < 2; ++a)
#pragma unroll
        for (int b = 0; b < 2; ++b)
#pragma unroll
            for (int m = 0; m < 4; ++m)
#pragma unroll
                for (int n = 0; n < 2; ++n) acc[a][b][m][n] = (f32x4){0.f, 0.f, 0.f, 0.f};
    bf16x8 At[4][2], B0[2][2], B1[2][2];
    const char* cA = (const char*)g.A + (size_t)cur.pm * tstep; const char* cB = (const char*)g.Bt + (size_t)cur.pn * tstep;
    S.a_ready(cur);
    if constexpr (SP2) {
        PG8_STAGE(PG8_SB(0, 0), cB, voffB); PG8_STAGE(PG8_SB(0, 1), cB + hstep, voffB); PG8_STAGE(PG8_SA(0, 0), cA, voffA); PG8_STAGE(PG8_SA(0, 1), cA + hstep, voffA);
        if (wr == 1) PG8_BAR;
        PG8_WAIT_V(2); PG8_BAR;
        PG8_STAGE(PG8_SB(1, 0), cB + kstep, voffB); PG8_STAGE(PG8_SA(1, 0), cA + kstep, voffA); PG8_STAGE(PG8_SB(1, 1), cB + hstep + kstep, voffB);
        PG8_WAIT_V(6); PG8_BAR;
    } else {
        PG8_STAGE(PG8_SB(0, 0), cB, voffB); PG8_STAGE(PG8_SA(0, 0), cA, voffA); PG8_STAGE(PG8_SB(0, 1), cB + hstep, voffB); PG8_STAGE(PG8_SA(0, 1), cA + hstep, voffA);
        if (wr == 1) PG8_BAR;
        PG8_WAIT_V(4); PG8_BAR;
        PG8_STAGE(PG8_SB(1, 0), cB + kstep, voffB); PG8_STAGE(PG8_SA(1, 0), cA + kstep, voffA); PG8_STAGE(PG8_SB(1, 1), cB + hstep + kstep, voffB);
        PG8_WAIT_V(6); PG8_BAR;
    }
    for (;;) {
        const bool has_next = S.next(ui + 1, nxt);
        const char* nA = has_next ? (const char*)g.A + (size_t)nxt.pm * tstep : cA; const char* nB = has_next ? (const char*)g.Bt + (size_t)nxt.pn * tstep : cB;
        for (int t = 0; t < nt; t += 2) {
            const bool last = (t == nt - 2);
            const char* a1 = cA + (size_t)(t + 1) * kstep;
            const char* a2 = last ? nA : cA + (size_t)(t + 2) * kstep; const char* b2 = last ? nB : cB + (size_t)(t + 2) * kstep;
            const char* a3 = a2 + kstep; const char* b3 = b2 + kstep;
            if (last && has_next) S.a_ready(nxt);
            if constexpr (SP2) {
            PG8_LDB(B0, 0, 0); PG8_LDB(B1, 0, 1); PG8_SCHED; PG8_LDA(At, 0, 0); PG8_STAGE(PG8_SA(1, 1), a1 + hstep, voffA);
            PG8_WAIT_V(8); PG8_WAIT_L(0); PG8_BAR; PG8_MMA(0, 0, At, B0); PG8_MMA(0, 1, At, B1); PG8_BAR; PG8_SCHED;
            PG8_LDA(At, 0, 1); PG8_STAGE(PG8_SB(0, 0), b2, voffB); PG8_STAGE(PG8_SB(0, 1), b2 + hstep, voffB); PG8_STAGE(PG8_SA(0, 0), a2, voffA);
            PG8_WAIT_V(8); PG8_WAIT_L(0); PG8_BAR; PG8_MMA(1, 0, At, B0); PG8_MMA(1, 1, At, B1); PG8_BAR; PG8_SCHED;
            PG8_LDB(B0, 1, 0); PG8_LDB(B1, 1, 1); PG8_SCHED; PG8_LDA(At, 1, 0); PG8_STAGE(PG8_SA(0, 1), a2 + hstep, voffA);
            PG8_WAIT_V(8); PG8_WAIT_L(0); PG8_BAR; PG8_MMA(0, 0, At, B0); PG8_MMA(0, 1, At, B1); PG8_BAR; PG8_SCHED;
            PG8_LDA(At, 1, 1); PG8_STAGE(PG8_SB(1, 0), b3, voffB); PG8_STAGE(PG8_SB(1, 1), b3 + hstep, voffB); PG8_STAGE(PG8_SA(1, 0), a3, voffA);
            PG8_WAIT_V(8); PG8_WAIT_L(0); PG8_BAR; PG8_MMA(1, 0, At, B0); PG8_MMA(1, 1, At, B1); PG8_BAR; PG8_SCHED;
            } else {
            PG8_LDB(B0, 0, 0); PG8_SCHED; PG8_LDA(At, 0, 0); PG8_STAGE(PG8_SA(1, 1), a1 + hstep, voffA);
            PG8_WAIT_L(8); PG8_BAR; PG8_WAIT_L(0); PG8_MMA(0, 0, At, B0); PG8_BAR; PG8_SCHED;
            PG8_LDB(B1, 0, 1); PG8_STAGE(PG8_SB(0, 0), b2, voffB);
            PG8_BAR; PG8_WAIT_L(0); PG8_MMA(0, 1, At, B1); PG8_BAR;
            PG8_LDA(At, 0, 1); PG8_STAGE(PG8_SA(0, 0), a2, voffA);
            PG8_BAR; PG8_WAIT_L(0); PG8_MMA(1, 0, At, B0); PG8_BAR; PG8_SCHED;
            PG8_STAGE(PG8_SB(0, 1), b2 + hstep, voffB);
            PG8_WAIT_V(6); PG8_BAR; PG8_MMA(1, 1, At, B1); PG8_BAR;
            PG8_LDB(B0, 1, 0); PG8_SCHED; PG8_LDA(At, 1, 0); PG8_STAGE(PG8_SA(0, 1), a2 + hstep, voffA);
            PG8_WAIT_L(8); PG8_BAR; PG8_WAIT_L(0); PG8_MMA(0, 0, At, B0); PG8_BAR; PG8_SCHED;
            PG8_LDB(B1, 1, 1); PG8_STAGE(PG8_SB(1, 0), b3, voffB);
            PG8_BAR; PG8_WAIT_L(0); PG8_MMA(0, 1, At, B1); PG8_BAR;
            PG8_LDA(At, 1, 1); PG8_STAGE(PG8_SA(1, 0), a3, voffA);
            PG8_BAR; PG8_WAIT_L(0); PG8_MMA(1, 0, At, B0); PG8_BAR; PG8_SCHED;
            PG8_STAGE(PG8_SB(1, 1), b3 + hstep, voffB);
            PG8_WAIT_V(6); PG8_BAR; PG8_MMA(1, 1, At, B1); PG8_BAR;
            }
        }
        if constexpr (ALIGN_EPI) { if (wr == 0) PG8_BAR; }
        if constexpr (!Epi::AFTER_DRAIN) { E(acc, cur, wr, wc, fr, fq); S.done(cur); }
        if (!has_next) break;
#pragma unroll
        for (int a = 0; a < 2; ++a)
#pragma unroll
            for (int b = 0; b < 2; ++b)
#pragma unroll
                for (int m = 0; m < 4; ++m)
#pragma unroll
                    for (int n = 0; n < 2; ++n) acc[a][b][m][n] = (f32x4){0.f, 0.f, 0.f, 0.f};
        cur = nxt; cA = nA; cB = nB; ++ui;
        if constexpr (ALIGN_EPI) { if (wr == 1) PG8_BAR; }
    }
    PG8_WAIT_V(0);
    if constexpr (!ALIGN_EPI) { if (wr == 0) PG8_BAR; }
    PG8_BAR;
    if constexpr (Epi::AFTER_DRAIN) { E.fused(acc, cur, wr, wc, fr, fq, lds, wid, lane); S.done(cur); }
#undef PG8_SA
#undef PG8_SB
#undef PG8_STAGE
#undef PG8_LDA
#undef PG8_LDB
#undef PG8_MMA
#undef PG8_WAIT_V
#undef PG8_WAIT_L
#undef PG8_BAR
#undef PG8_SCHED
}
}
#define LAS __attribute__((address_space(3)))
typedef unsigned short bf16;
typedef _Float16 f16;
typedef float f32x4 __attribute__((ext_vector_type(4)));
typedef short bf16x8 __attribute__((ext_vector_type(8)));
typedef short s16x4 __attribute__((ext_vector_type(4)));
typedef unsigned u32x4 __attribute__((ext_vector_type(4)));
typedef unsigned u32x2 __attribute__((ext_vector_type(2)));
typedef _Float16 h2 __attribute__((ext_vector_type(2)));

#ifndef MK_ONE_LAUNCH
#define MK_ONE_LAUNCH 1
#endif

constexpr int NPROMPT = 8 * 4096, NSAMP = 32 * 64, M = NPROMPT + NSAMP;
constexpr int DM = 1024, SHW = 3328, DFF = 2816;
constexpr size_t MiB = 1u << 20;
constexpr size_t U = (size_t)M * 1024 * 2;
constexpr size_t WS_WIN = 1 * MiB;
constexpr size_t WS_WA = WS_WIN + (size_t)7424 * 1024 * 2;
constexpr size_t WS_WB = WS_WA + (size_t)1024 * 1024 * 2;
constexpr size_t WS_WO = WS_WB + (size_t)1024 * 1024 * 2;
constexpr size_t WS_GU = WS_WO + (size_t)1024 * 1024 * 2;
constexpr size_t WS_WD = WS_GU + (size_t)5632 * 1024 * 2;
constexpr size_t WS_LORA = WS_WD + (size_t)1024 * 2816 * 2;
constexpr size_t WS_WSP = WS_LORA + (size_t)3072 * 256 * 2;
constexpr size_t WS_R0 = 40 * MiB;
static_assert(WS_WSP + 8 * 128 * 128 * 2 <= WS_R0, "weights fit below R0");
constexpr size_t WS_XN = WS_R0;
constexpr size_t WS_WL = WS_R0;
constexpr size_t WS_PS = WS_R0 + U;
constexpr size_t WS_AR = WS_R0 + U * 17 / 4;
constexpr size_t WS_G = WS_R0 + U * 21 / 4;
constexpr size_t WS_LX = WS_R0 + U * 25 / 4;
constexpr size_t WS_END = WS_R0 + U * 26 / 4;
constexpr size_t WS_XN2 = WS_R0;
constexpr size_t WS_P4 = WS_R0 + U;
constexpr size_t WS_OA = WS_G;
constexpr size_t WS_OB = WS_R0;
constexpr size_t WS_MM = WS_R0 + U;
constexpr size_t WS_MO = WS_R0 + 2 * U;
constexpr size_t WS_F = WS_R0;
constexpr size_t WS_H = WS_R0 + U;
constexpr size_t WS_F2 = WS_R0 + 4 * U;
constexpr size_t OUT_Y = 0;
constexpr size_t OUT_SHIFT_P = (size_t)M * 1024;
constexpr size_t OUT_WKV_P = OUT_SHIFT_P + 8 * 3328;
constexpr size_t OUT_SHIFT_S = OUT_WKV_P + (size_t)8 * 16 * 4096;
constexpr size_t OUT_WKV_S = OUT_SHIFT_S + 32 * 3328;
constexpr size_t OUT_VS = OUT_WKV_S + (size_t)32 * 16 * 4096;
constexpr size_t OUT_END = OUT_VS + (size_t)32 * 64 * 1024;
static_assert(OUT_END == 40503296, "output size");

constexpr int LDS_BYTES = 147456;
constexpr int NPHASE = 15;

struct Args { const float* in[30]; float* out; unsigned char* ws; int ph_lo, ph_hi; };

__device__ __forceinline__ float bf_lo(unsigned u) { return __uint_as_float(u << 16); }
__device__ __forceinline__ float bf_hi(unsigned u) { return __uint_as_float(u & 0xffff0000u); }
__device__ __forceinline__ f32x4 dec4bf(u32x2 u) { return (f32x4){bf_lo(u.x), bf_hi(u.x), bf_lo(u.y), bf_hi(u.y)}; }
__device__ __forceinline__ unsigned pkbf(float lo, float hi) { return pg8::cvt_pk_bf16(lo, hi); }
__device__ __forceinline__ u32x2 pk4bf(f32x4 v) { u32x2 r; r.x = pkbf(v[0], v[1]); r.y = pkbf(v[2], v[3]); return r; }
__device__ __forceinline__ unsigned pkh(float lo, float hi) { h2 h; h.x = (f16)lo; h.y = (f16)hi; return __builtin_bit_cast(unsigned, h); }
__device__ __forceinline__ u32x2 pk4h(f32x4 v) { u32x2 r; r.x = pkh(v[0], v[1]); r.y = pkh(v[2], v[3]); return r; }
__device__ __forceinline__ h2 as_h2(unsigned u) { return __builtin_bit_cast(h2, u); }
__device__ __forceinline__ f32x4 dec4h(u32x2 u) { const h2 a = as_h2(u.x), b = as_h2(u.y); return (f32x4){(float)a.x, (float)a.y, (float)b.x, (float)b.y}; }
__device__ __forceinline__ float sigm(float x) { return __builtin_amdgcn_rcpf(1.f + __expf(-x)); }
__device__ __forceinline__ float wave_sum(float v) {
#pragma unroll
    for (int o = 1; o < 64; o <<= 1) v += __shfl_xor(v, o);
    return v;
}
template <int CTRL> __device__ __forceinline__ float dppf(float x) { return __int_as_float(__builtin_amdgcn_update_dpp(0, __float_as_int(x), CTRL, 0xF, 0xF, false)); }
__device__ __forceinline__ float row_sum16(float x) { x += dppf<0x128>(x); x += dppf<0x124>(x); x += dppf<0x122>(x); x += dppf<0x121>(x); return x; }
__device__ __forceinline__ float quad_sum(float x) { x += dppf<0xB1>(x); x += dppf<0x4E>(x); return x; }
__device__ __forceinline__ const float* xrow_ptr(const Args& a, int m) { return m < NPROMPT ? a.in[0] + (size_t)m * 1024 : a.in[1] + (size_t)(m - NPROMPT) * 1024; }

template <class F> struct Epi8 {
    static constexpr bool PERM = true, AFTER_DRAIN = false; F f;
    __device__ __forceinline__ void operator()(const f32x4 (&acc)[2][2][4][2], const pg8::Unit& u, int wr, int wc, int fr, int fq) const {
        const int row0 = u.pm * 256 + wr * 64 + fr, col0 = u.pn * 256 + wc * 32 + 8 * fq;
#pragma unroll
        for (int ai = 0; ai < 2; ++ai)
#pragma unroll
            for (int m = 0; m < 4; ++m)
#pragma unroll
                for (int bj = 0; bj < 2; ++bj) f(row0 + ai * 128 + m * 16, col0 + bj * 128, acc[ai][bj][m][0], acc[ai][bj][m][1]);
    }
};
template <class F> struct Epi4 {
    static constexpr bool PERM = false, AFTER_DRAIN = false; F f;
    __device__ __forceinline__ void operator()(const f32x4 (&acc)[2][2][4][2], const pg8::Unit& u, int wr, int wc, int fr, int fq) const {
        const int row0 = u.pm * 256 + wr * 64 + fr, col0 = u.pn * 256 + wc * 32 + 4 * fq;
#pragma unroll
        for (int ai = 0; ai < 2; ++ai)
#pragma unroll
            for (int m = 0; m < 4; ++m)
#pragma unroll
                for (int bj = 0; bj < 2; ++bj)
#pragma unroll
                    for (int n = 0; n < 2; ++n) f(row0 + ai * 128 + m * 16, col0 + bj * 128 + n * 16, acc[ai][bj][m][n]);
    }
};
__device__ __forceinline__ u32x4 pk8bf(f32x4 a, f32x4 b) { u32x4 w; w.x = pkbf(a[0], a[1]); w.y = pkbf(a[2], a[3]); w.z = pkbf(b[0], b[1]); w.w = pkbf(b[2], b[3]); return w; }
__device__ __forceinline__ u32x4 pk8h(f32x4 a, f32x4 b) { u32x4 w; w.x = pkh(a[0], a[1]); w.y = pkh(a[2], a[3]); w.z = pkh(b[0], b[1]); w.w = pkh(b[2], b[3]); return w; }
__device__ __forceinline__ void dec8bf(u32x4 w, f32x4& a, f32x4& b) { a = (f32x4){bf_lo(w.x), bf_hi(w.x), bf_lo(w.y), bf_hi(w.y)}; b = (f32x4){bf_lo(w.z), bf_hi(w.z), bf_lo(w.w), bf_hi(w.w)}; }

struct FStoreBf16 { bf16* O; int ldc;
    __device__ __forceinline__ void operator()(int r, int c, f32x4 v0, f32x4 v1) const { *(u32x4*)(O + (size_t)r * ldc + c) = pk8bf(v0, v1); } };
struct FStoreF32 { float* O; int ldc;
    __device__ __forceinline__ void operator()(int r, int c, f32x4 v) const { *(f32x4*)(O + (size_t)r * ldc + c) = v; } };
struct FLora { f16* WL; f16* AR; f16* G; const float* w0; const float* a0;
    __device__ __forceinline__ void operator()(int r, int c, f32x4 v0, f32x4 v1) const {
        const int t = c >> 10, cc = c & 1023;
        if (t == 0) { const f32x4 b0 = *(const f32x4*)(w0 + cc), b1 = *(const f32x4*)(w0 + cc + 4);
#pragma unroll
            for (int i = 0; i < 4; ++i) { v0[i] = -0.60653066f * sigm(v0[i] + b0[i]); v1[i] = -0.60653066f * sigm(v1[i] + b1[i]); }
            *(u32x4*)(WL + (size_t)r * 1024 + cc) = pk8h(v0, v1); }
        else if (t == 1) { const f32x4 b0 = *(const f32x4*)(a0 + cc), b1 = *(const f32x4*)(a0 + cc + 4);
#pragma unroll
            for (int i = 0; i < 4; ++i) { v0[i] = sigm(v0[i] + b0[i]); v1[i] = sigm(v1[i] + b1[i]); }
            *(u32x4*)(AR + (size_t)r * 1024 + cc) = pk8h(v0, v1); }
        else *(u32x4*)(G + (size_t)r * 1024 + cc) = pk8h(v0, v1);
    } };
struct FP1b { bf16* base;
    __device__ __forceinline__ void operator()(int r, int c, f32x4 v0, f32x4 v1) const {
        const int t = c >> 10, cc = c & 1023;
        if (t >= 2) {
#pragma unroll
            for (int i = 0; i < 4; ++i) { v0[i] = sigm(v0[i]); v1[i] = sigm(v1[i]); } }
        *(u32x4*)(base + (size_t)t * (U / 2) + (size_t)r * 1024 + cc) = pk8bf(v0, v1);
    } };
struct FGateA { const bf16* GA; bf16* M1;
    __device__ __forceinline__ void operator()(int r, int c, f32x4 v0, f32x4 v1) const {
        const size_t o = (size_t)r * 1024 + c; f32x4 g0, g1; dec8bf(*(const u32x4*)(GA + o), g0, g1);
        *(u32x4*)(M1 + o) = pk8bf(v0 * g0, v1 * g1);
    } };
struct FGateB { const bf16* GB; bf16* MMp;
    __device__ __forceinline__ void operator()(int r, int c, f32x4 v0, f32x4 v1) const {
        const size_t o = (size_t)r * 1024 + c; f32x4 g0, g1, m0, m1; dec8bf(*(const u32x4*)(GB + o), g0, g1); dec8bf(*(const u32x4*)(MMp + o), m0, m1);
        *(u32x4*)(MMp + o) = pk8bf(m0 + v0 * g0, m1 + v1 * g1);
    } };
__device__ __forceinline__ float fq_sum(float x) {
    const unsigned u = __float_as_uint(x); const auto r = __builtin_amdgcn_permlane16_swap(u, u, false, false);
    const float y = __uint_as_float(r[0]) + __uint_as_float(r[1]);
    const unsigned v = __float_as_uint(y); const auto r2 = __builtin_amdgcn_permlane32_swap(v, v, false, false);
    return __uint_as_float(r2[0]) + __uint_as_float(r2[1]);
}
struct EpiP1b {
    static constexpr bool PERM = true, AFTER_DRAIN = false; bf16* base; float* lnp;
    __device__ __forceinline__ void operator()(const f32x4 (&acc)[2][2][4][2], const pg8::Unit& u, int wr, int wc, int fr, int fq) const {
        const int row0 = u.pm * 256 + wr * 64 + fr, t = u.pn >> 2, pnl = u.pn & 3, col0 = pnl * 256 + wc * 32 + 8 * fq;
        bf16* dst = base + (size_t)t * (U / 2);
#pragma unroll
        for (int ai = 0; ai < 2; ++ai)
#pragma unroll
            for (int m = 0; m < 4; ++m) {
                const int row = row0 + ai * 128 + m * 16; float s = 0.f, s2 = 0.f;
#pragma unroll
                for (int bj = 0; bj < 2; ++bj) {
                    f32x4 v0 = acc[ai][bj][m][0], v1 = acc[ai][bj][m][1];
                    if (t >= 2) {
#pragma unroll
                        for (int i = 0; i < 4; ++i) { v0[i] = sigm(v0[i]); v1[i] = sigm(v1[i]); } }
                    if (t == 1) {
#pragma unroll
                        for (int i = 0; i < 4; ++i) { s += v0[i] + v1[i]; s2 += v0[i] * v0[i] + v1[i] * v1[i]; } }
                    *(u32x4*)(dst + (size_t)row * 1024 + col0 + bj * 128) = pk8bf(v0, v1);
                }
                if (t == 1) {
                    s = fq_sum(s); s2 = fq_sum(s2);
                    if (fq == 0) *(float2*)(lnp + (size_t)row * 32 + 2 * (4 * pnl + wc)) = make_float2(s, s2);
                }
            }
    }
};
struct EpiGU {
    static constexpr bool PERM = true, AFTER_DRAIN = false; bf16* H;
    __device__ __forceinline__ void operator()(const f32x4 (&acc)[2][2][4][2], const pg8::Unit& u, int wr, int wc, int fr, int fq) const {
        const int row0 = u.pm * 256 + wr * 64 + fr, h0 = u.pn * 128 + wc * 32 + 8 * fq;
#pragma unroll
        for (int ai = 0; ai < 2; ++ai)
#pragma unroll
            for (int m = 0; m < 4; ++m) {
                f32x4 o0, o1;
#pragma unroll
                for (int i = 0; i < 4; ++i) { const float g0 = acc[ai][0][m][0][i], g1 = acc[ai][1][m][0][i];
                    o0[i] = g0 * sigm(g0) * acc[ai][0][m][1][i]; o1[i] = g1 * sigm(g1) * acc[ai][1][m][1][i]; }
                *(u32x4*)(H + (size_t)(row0 + ai * 128 + m * 16) * DFF + h0) = pk8bf(o0, o1);
            }
    }
};

#define PH_PROLOG const int tid = threadIdx.x, lane = tid & 63, wave = __builtin_amdgcn_readfirstlane(tid >> 6); const int G = gridDim.x, bid = blockIdx.x; const int gw = bid * 8 + wave, NGW = G * 8; (void)lane; (void)gw; (void)NGW; (void)lds;

__device__ __forceinline__ float conv_src(const Args& a, int mat, int R, int k) {
    switch (mat) {
    case 0: return a.in[5][(size_t)k * 7424 + R];
    case 1: return a.in[21][(size_t)k * 1024 + R];
    case 2: return a.in[22][(size_t)k * 1024 + R];
    case 3: return a.in[23][(size_t)k * 1024 + R];
    case 4: { const int cl = R & 255, pn = R >> 8, bj = (cl >> 7) & 1, wc = (cl >> 5) & 3, fq = (cl >> 3) & 3, n = (cl >> 2) & 1, e = cl & 3;
              const int hcol = 128 * pn + 32 * wc + 8 * fq + 4 * bj + e; return (n ? a.in[27] : a.in[26])[(size_t)k * DFF + hcol]; }
    case 5: return a.in[28][(size_t)k * 1024 + R];
    case 6: { if (R < 1024) return k < 64 ? a.in[8][k * 1024 + R] : 0.f;
              if (R < 2048) return (k >= 64 && k < 128) ? a.in[10][(k - 64) * 1024 + R - 1024] : 0.f;
              return k >= 128 ? a.in[11][(k - 128) * 1024 + R - 2048] : 0.f; }
    default: { const int t = R & 127; return k <= t ? a.in[19][(size_t)R * 128 + k] : 0.f; }
    }
}
__device__ __forceinline__ void rms_row_to_bf16(const float* xrow, const float* gain, bf16* orow, int lane) {
    f32x4 v[4]; float ss = 0.f;
#pragma unroll
    for (int j = 0; j < 4; ++j) { v[j] = ((const f32x4*)xrow)[lane + 64 * j]; ss += (v[j][0] * v[j][0] + v[j][1] * v[j][1]) + (v[j][2] * v[j][2] + v[j][3] * v[j][3]); }
    const float rs = rsqrtf(wave_sum(ss) * (1.f / 1024.f) + 1e-6f);
#pragma unroll
    for (int j = 0; j < 4; ++j) { const f32x4 g = ((const f32x4*)gain)[lane + 64 * j]; ((u32x2*)orow)[lane + 64 * j] = pk4bf(v[j] * rs * g); }
}
constexpr int CV_MAT[8] = {0, 6, 1, 2, 3, 4, 5, 7};
constexpr int CV_NIT[8] = {928 * 16, 384 * 4, 128 * 16, 128 * 16, 128 * 16, 704 * 16, 128 * 44, 128 * 2};
constexpr int CV_KD[8] = {1024, 256, 1024, 1024, 1024, 1024, 2816, 128};
constexpr size_t CV_DST[8] = {WS_WIN, WS_LORA, WS_WA, WS_WB, WS_WO, WS_GU, WS_WD, WS_WSP};
constexpr int CV_EARLY = CV_NIT[0] + CV_NIT[1], CV_ALL = CV_EARLY + CV_NIT[2] + CV_NIT[3] + CV_NIT[4] + CV_NIT[5] + CV_NIT[6] + CV_NIT[7];
__device__ __forceinline__ void conv_items(const Args& a, int lo, int hi, int worker, int nworkers, int lane) {
    for (int it = lo + worker; it < hi; it += nworkers) {
        int r = it, mi = 0;
#pragma unroll
        for (int q = 0; q < 7; ++q) { if (mi == q && r >= CV_NIT[q]) { r -= CV_NIT[q]; mi = q + 1; } }
        int Kd = 1024, mat = 0; size_t dst = WS_WIN;
#pragma unroll
        for (int q = 0; q < 8; ++q) if (mi == q) { Kd = CV_KD[q]; dst = CV_DST[q]; mat = CV_MAT[q]; }
        const int kbn = Kd >> 6, rb = r / kbn, kb = r - rb * kbn;
        const int R = rb * 8 + (lane >> 3), k0 = kb * 64 + (lane & 7) * 8;
        float s[8];
#pragma unroll
        for (int j = 0; j < 8; ++j) s[j] = conv_src(a, mat, R, k0 + j);
        u32x4 w; w.x = pkbf(s[0], s[1]); w.y = pkbf(s[2], s[3]); w.z = pkbf(s[4], s[5]); w.w = pkbf(s[6], s[7]);
        *(u32x4*)(a.ws + dst + ((size_t)R * Kd + k0) * 2) = w;
    }
}
__device__ __forceinline__ void phase_p0(const Args& a, LAS unsigned char* lds) {
    PH_PROLOG
    conv_items(a, 0, G > 128 ? CV_EARLY : CV_ALL, gw, NGW, lane);
    bf16* XN = (bf16*)(a.ws + WS_XN);
    for (int m = gw; m < M; m += NGW) rms_row_to_bf16(xrow_ptr(a, m), a.in[4], XN + (size_t)m * 1024, lane);
}

__device__ __forceinline__ void phase_p2a(const Args& a, LAS unsigned char* lds) {
    PH_PROLOG
    const bf16* PS = (const bf16*)(a.ws + WS_PS); bf16* LX = (bf16*)(a.ws + WS_LX);
    const f32x4 mu = *(const f32x4*)(a.in[6] + 3072 + 4 * lane);
    for (int m = gw; m < M; m += NGW) {
        const bool samp = m >= NPROMPT; const int t = samp ? ((m - NPROMPT) & 63) : (m & 4095);
        const f32x4 p = dec4bf(*(const u32x2*)(PS + (size_t)m * SHW + 3072 + 4 * lane));
        f32x4 pp = (f32x4){0.f, 0.f, 0.f, 0.f};
        if (t > 0) pp = dec4bf(*(const u32x2*)(PS + (size_t)(m - 1) * SHW + 3072 + 4 * lane));
        else if (samp) pp = *(const f32x4*)(a.in[2] + (size_t)((m - NPROMPT) >> 6) * SHW + 3072 + 4 * lane);
        f32x4 x = p + (pp - p) * mu;
        if (lane < 16) {
#pragma unroll
            for (int i = 0; i < 4; ++i) x[i] = 1.f - 2.f * __builtin_amdgcn_rcpf(__expf(2.f * x[i]) + 1.f); }
        else if (lane >= 32) {
#pragma unroll
            for (int i = 0; i < 4; ++i) x[i] = sigm(x[i]); }
        *(u32x2*)(LX + (size_t)m * 256 + 4 * lane) = pk4bf(x);
    }
    if (gw < 40) {
        const int row = gw < 8 ? gw * 4096 + 4095 : NPROMPT + (gw - 8) * 64 + 63;
        float* dst = a.out + (gw < 8 ? OUT_SHIFT_P + (size_t)gw * SHW : OUT_SHIFT_S + (size_t)(gw - 8) * SHW);
        for (int c = lane; c < SHW; c += 64) dst[c] = bf_lo((unsigned)PS[(size_t)row * SHW + c]);
    }
}

typedef _Float16 h4 __attribute__((ext_vector_type(4)));
typedef _Float16 h8 __attribute__((ext_vector_type(8)));
#define MFMA16(a, b, c) __builtin_amdgcn_mfma_f32_16x16x16f16(a, b, c, 0, 0, 0)
#define MFMA32(a, b, c) __builtin_amdgcn_mfma_f32_16x16x32_f16(a, b, c, 0, 0, 0)
__device__ __forceinline__ h4 cvt_h4(f32x4 v) { h4 r; r[0] = (f16)v[0]; r[1] = (f16)v[1]; r[2] = (f16)v[2]; r[3] = (f16)v[3]; return r; }
__device__ __forceinline__ f32x4 h4_f32(h4 v) { return (f32x4){(float)v[0], (float)v[1], (float)v[2], (float)v[3]}; }
constexpr int CK_NPROD = 6, CK_NCONS = 2, CK_NVB = 4 / CK_NCONS, CK_NSLOT = 5;
constexpr int CKS_ET = 0, CKS_GY = 2048, CKS_BK = 4096, CKS_XV = 8192, CKS_U0 = 10240, CKS_Y0 = 12288, CKS_LC = 14336, CKS_SIZE = 14848;
constexpr int CKP_AT = 0, CKP_BT = 2048, CKP_KT = 4096, CKP_RT = 6144, CKP_ATT = 8192, CKP_EX = 10240, CKP_LR = 11264, CKP_SIZE = 11520;
constexpr int CK_SLOTS = 0, CK_SCR = CK_NSLOT * CKS_SIZE, CK_FLAGS = CK_SCR + CK_NPROD * CKP_SIZE, CK_END = CK_FLAGS + 256;
static_assert(CK_END <= LDS_BYTES - 256, "chunked scan LDS map");
__device__ __forceinline__ int ck_img8(int row, int e4) { return row * 128 + ((((e4 >> 1) ^ (row & 7))) << 4) + ((e4 & 1) << 3); }
__device__ __forceinline__ int ck_img16(int row, int c16) { return row * 128 + ((c16 ^ (row & 7)) << 4); }
__device__ __forceinline__ bf16 f2bf_c(float f) { const unsigned u = __float_as_uint(f); return (bf16)((u + 0x7fffu + ((u >> 16) & 1u)) >> 16); }
__device__ __forceinline__ void ck_wait_ge(volatile LAS unsigned* flag, unsigned target) { while (*flag < target) __builtin_amdgcn_s_sleep(1); asm volatile("" ::: "memory"); }

struct CkRaw { u32x2 r[4], k[4], v[4], lw[4], ar[4], pr, pk, pv; };
__device__ __forceinline__ void ck_load(CkRaw& R, const bf16* PS, const f16* LW, const f16* AR, int mq, int cidx, int m_lo) {
#pragma unroll
    for (int i = 0; i < 4; ++i) { const bf16* base = PS + (size_t)(mq + i) * SHW + cidx;
        R.r[i] = *(const u32x2*)base; R.k[i] = *(const u32x2*)(base + 1024); R.v[i] = *(const u32x2*)(base + 2048);
        R.lw[i] = *(const u32x2*)(LW + (size_t)(mq + i) * 1024 + cidx); R.ar[i] = *(const u32x2*)(AR + (size_t)(mq + i) * 1024 + cidx); }
    const int mp = mq - 1 < m_lo ? m_lo : mq - 1; const bf16* pb = PS + (size_t)mp * SHW + cidx;
    R.pr = *(const u32x2*)pb; R.pk = *(const u32x2*)(pb + 1024); R.pv = *(const u32x2*)(pb + 2048);
}
struct CkK { f32x4 mu_r, mu_k, mu_v, kk, ka; };
__device__ __forceinline__ void ck_prep(LAS unsigned char* slot, LAS unsigned char* scr, const CkRaw& R, const float* const* in, int cidx, bool first, const float* ssrc, int lane) {
    const int q = lane >> 4, kg = lane & 15;
    f32x4 lv[4];
    lv[0] = dec4h(R.lw[0]); lv[1] = dec4h(R.lw[1]) + lv[0]; lv[2] = dec4h(R.lw[2]) + lv[1]; lv[3] = dec4h(R.lw[3]) + lv[2];
    *(LAS f32x4*)(scr + CKP_EX + lane * 16) = lv[3];
    const f32x4 zero4 = (f32x4){0.f, 0.f, 0.f, 0.f};
    f32x4 pre, lref, l15;
    { const f32x4 Q0 = *(const LAS f32x4*)(scr + CKP_EX + kg * 16), Q1 = *(const LAS f32x4*)(scr + CKP_EX + (16 + kg) * 16), Q2 = *(const LAS f32x4*)(scr + CKP_EX + (32 + kg) * 16), Q3 = *(const LAS f32x4*)(scr + CKP_EX + (48 + kg) * 16);
      pre = (q > 0 ? Q0 : zero4) + (q > 1 ? Q1 : zero4) + (q > 2 ? Q2 : zero4); lref = Q0 + Q1; l15 = (Q0 + Q1) + (Q2 + Q3); }
    f32x4 eC, eprev;
    { f32x4 lamref, lamC;
#pragma unroll
      for (int j = 0; j < 4; ++j) { eC[j] = __expf(l15[j] - lref[j]); lamref[j] = __expf(lref[j]); lamC[j] = __expf(l15[j]); eprev[j] = __expf(pre[j] - lref[j]); }
      if (q == 0) { *(LAS f32x4*)(slot + CKS_LC + kg * 16) = lamC; *(LAS f32x4*)(scr + CKP_LR + kg * 16) = lamref; } }
    pre = pre - lref;
    const f32x4 mu_r = *(const f32x4*)(in[6] + cidx), mu_k = *(const f32x4*)(in[6] + 1024 + cidx), mu_v = *(const f32x4*)(in[6] + 2048 + cidx), c_kk = *(const f32x4*)(in[12] + cidx), c_ka = *(const f32x4*)(in[13] + cidx);
    f32x4 pr = dec4bf(R.pr), pk = dec4bf(R.pk), pv = dec4bf(R.pv);
    if (first) { pr = zero4; pk = zero4; pv = zero4; if (ssrc) { pr = *(const f32x4*)ssrc; pk = *(const f32x4*)(ssrc + 1024); pv = *(const f32x4*)(ssrc + 2048); } }
    h4 att[4], bbt[4], kbt[4], xt[4];
#pragma unroll
    for (int i = 0; i < 4; ++i) {
        const f32x4 r = dec4bf(R.r[i]), k = dec4bf(R.k[i]), v = dec4bf(R.v[i]), ar = dec4h(R.ar[i]);
        const f32x4 xr = r + (pr - r) * mu_r, xk = k + (pk - k) * mu_k, xv = v + (pv - v) * mu_v;
        pr = r; pk = k; pv = v;
        const f32x4 kkr = xk * c_kk;
        float ssq = (kkr[0] * kkr[0] + kkr[1] * kkr[1]) + (kkr[2] * kkr[2] + kkr[3] * kkr[3]);
        ssq = row_sum16(ssq);
        const float inv = 1.f / fmaxf(sqrtf(ssq), 1e-12f);
        const f32x4 kkn = kkr * inv;
        f32x4 e, rc;
#pragma unroll
        for (int j = 0; j < 4; ++j) { const float d = lv[i][j] + pre[j]; e[j] = __expf(d); rc[j] = __expf(-d); }
        const f32x4 at = -kkn * eprev, bt = kkn * ar * rc, kt = xk * (1.f + (ar - 1.f) * c_ka) * rc, rt = xr * e, bb = bt * eC, kb = kt * eC;
        eprev = e;
        const int o = ck_img8(4 * q + i, kg);
        *(LAS h4*)(scr + CKP_AT + o) = cvt_h4(at); *(LAS h4*)(scr + CKP_BT + o) = cvt_h4(bt); *(LAS h4*)(scr + CKP_KT + o) = cvt_h4(kt); *(LAS h4*)(scr + CKP_RT + o) = cvt_h4(rt);
#pragma unroll
        for (int j = 0; j < 4; ++j) { att[j][i] = (f16)at[j]; bbt[j][i] = (f16)bb[j]; kbt[j][i] = (f16)kb[j]; xt[j][i] = (f16)xv[j]; }
    }
#pragma unroll
    for (int j = 0; j < 4; ++j) {
        const int key = 4 * kg + j;
        *(LAS h4*)(scr + CKP_ATT + key * 32 + q * 8) = att[j];
        *(LAS h4*)(slot + CKS_BK + key * 64 + q * 16) = bbt[j]; *(LAS h4*)(slot + CKS_BK + key * 64 + q * 16 + 8) = kbt[j];
        *(LAS h4*)(slot + CKS_XV + key * 32 + q * 8) = xt[j];
    }
}
__device__ __forceinline__ void ck_mfma(LAS unsigned char* slot, LAS unsigned char* scr, int lane) {
    const int n = lane & 15, q = lane >> 4;
    const f32x4 z4 = (f32x4){0.f, 0.f, 0.f, 0.f};
    f32x4 Nab = z4, NabT = z4, NakT = z4, Nbr = z4, Nkr = z4;
#pragma unroll
    for (int ks = 0; ks < 2; ++ks) {
        const int o = ck_img16(n, 4 * ks + q);
        const h8 fa = *(const LAS h8*)(scr + CKP_AT + o), fb = *(const LAS h8*)(scr + CKP_BT + o), fk = *(const LAS h8*)(scr + CKP_KT + o), fr8 = *(const LAS h8*)(scr + CKP_RT + o);
        Nab = MFMA32(fb, fa, Nab); NabT = MFMA32(fa, fb, NabT); NakT = MFMA32(fa, fk, NakT); Nbr = MFMA32(fb, fr8, Nbr); Nkr = MFMA32(fk, fr8, Nkr);
    }
    f32x4 P, Qm, MakT, Mbr, Mkr, Tm, Tt;
#pragma unroll
    for (int ii = 0; ii < 4; ++ii) { const int row = 4 * q + ii;
        P[ii] = row < n ? Nab[ii] : 0.f; Qm[ii] = n < row ? NabT[ii] : 0.f; MakT[ii] = n < row ? NakT[ii] : 0.f;
        Mbr[ii] = row <= n ? Nbr[ii] : 0.f; Mkr[ii] = row <= n ? Nkr[ii] : 0.f;
        const float id = row == n ? 1.f : 0.f; Tm[ii] = id + P[ii]; Tt[ii] = id + Qm[ii]; }
#pragma unroll
    for (int lev = 0; lev < 3; ++lev) {
        const h4 hp = cvt_h4(P), hq = cvt_h4(Qm);
        const f32x4 P2 = MFMA16(hq, hp, z4), Q2 = MFMA16(hp, hq, z4);
        const h4 hp2 = cvt_h4(P2), hq2 = cvt_h4(Q2), ht = cvt_h4(Tm), htt = cvt_h4(Tt);
        const f32x4 Tn = MFMA16(htt, hp2, Tm), Ttn = MFMA16(hp2, htt, Tt);
        P = P2; Qm = Q2; Tm = Tn; Tt = Ttn; (void)ht; (void)hq2;
    }
    const h4 hT = cvt_h4(Tm), hMbr = cvt_h4(Mbr), hMakT = cvt_h4(MakT);
    const f32x4 F = MFMA16(hMakT, hT, z4);
    const f32x4 Ft = MFMA16(hT, hMakT, z4);
    const h4 hF = cvt_h4(F), hFt = cvt_h4(Ft);
    const f32x4 Hy = MFMA16(hFt, hMbr, Mkr);
    const h4 hHy = cvt_h4(Hy);
#pragma unroll
    for (int kb = 0; kb < 4; ++kb) {
        const h4 fat = *(const LAS h4*)(scr + CKP_ATT + (16 * kb + n) * 32 + q * 8);
        const f32x4 lam = *(const LAS f32x4*)(scr + CKP_LR + (16 * kb + 4 * q) * 4);
        const f32x4 E = MFMA16(fat, hT, z4);
        const f32x4 Et = MFMA16(hT, fat, z4);
        const int oe = ck_img8(n, 8 * (kb >> 1) + 2 * q + (kb & 1));
        *(LAS h4*)(slot + CKS_ET + oe) = cvt_h4(E * lam);
        const f32x4 rt = h4_f32(*(const LAS h4*)(scr + CKP_RT + ck_img8(n, 4 * kb + q)));
        const f32x4 Gy = MFMA16(cvt_h4(Et), hMbr, rt);
        *(LAS h4*)(slot + CKS_GY + oe) = cvt_h4(Gy * lam);
        const h4 fx = *(const LAS h4*)(slot + CKS_XV + (16 * kb + n) * 32 + q * 8);
        const f32x4 U0 = MFMA16(hF, fx, z4), Y0 = MFMA16(hHy, fx, z4);
        *(LAS h4*)(slot + CKS_U0 + kb * 512 + lane * 8) = cvt_h4(U0); *(LAS h4*)(slot + CKS_Y0 + kb * 512 + lane * 8) = cvt_h4(Y0);
    }
}
__device__ __forceinline__ void ck_consume(const LAS unsigned char* slot, f32x4 (&Sb)[4], int vb, int lane, bf16* Yrow  ) {
    const int n = lane & 15, q = lane >> 4;
    f32x4 U = h4_f32(*(const LAS h4*)(slot + CKS_U0 + vb * 512 + lane * 8)), Yv = h4_f32(*(const LAS h4*)(slot + CKS_Y0 + vb * 512 + lane * 8));
#pragma unroll
    for (int ks = 0; ks < 2; ++ks) {
        const int o = ck_img16(n, 4 * ks + q);
        const h8 fe = *(const LAS h8*)(slot + CKS_ET + o), fg = *(const LAS h8*)(slot + CKS_GY + o);
        h8 fs;
#pragma unroll
        for (int j = 0; j < 8; ++j) fs[j] = (f16)Sb[2 * ks + (j >> 2)][j & 3];
        U = MFMA32(fe, fs, U); Yv = MFMA32(fg, fs, Yv);
    }
#pragma unroll
    for (int ii = 0; ii < 4; ++ii) Yrow[(size_t)(4 * q + ii) * 1024 + 16 * vb + n] = f2bf_c(Yv[ii]);
    const h4 fx = *(const LAS h4*)(slot + CKS_XV + (16 * vb + n) * 32 + q * 8);
    h8 fuv;
#pragma unroll
    for (int j = 0; j < 4; ++j) { fuv[j] = (f16)U[j]; fuv[4 + j] = fx[j]; }
#pragma unroll
    for (int kb = 0; kb < 4; ++kb) {
        const h8 fbk = *(const LAS h8*)(slot + CKS_BK + (16 * kb + n) * 64 + q * 16);
        const f32x4 lam = *(const LAS f32x4*)(slot + CKS_LC + (16 * kb + 4 * q) * 4);
        Sb[kb] = MFMA32(fbk, fuv, Sb[kb] * lam);
    }
}
__device__ __forceinline__ void phase_scan(const Args& a, LAS unsigned char* lds) {
    PH_PROLOG
    const bf16* PS = (const bf16*)(a.ws + WS_PS); const f16* LW = (const f16*)((const unsigned char*)a.out + U); const f16* AR = (const f16*)(a.ws + WS_AR);
    bf16* Y = (bf16*)a.out;
    volatile LAS unsigned* ready = (volatile LAS unsigned*)(lds + CK_FLAGS); volatile LAS unsigned* done = ready + 8;
    const int nsw = G > 128 ? G - 128 : G, sw0 = G > 128 ? 128 : 0;
    for (int pass = 0;; ++pass) {
        int task;
        if (G > 128) { if (bid < 128) { if (pass > 0) break; task = bid; } else { task = 128 + (bid - 128) + pass * nsw; if (task >= 640) break; } }
        else { task = bid + pass * G; if (task >= 640) break; }
        (void)sw0;
        const bool samp = task >= 128; const int tq = samp ? task - 128 : task;
        const int b = tq >> 4, h = tq & 15;
        const int m0 = samp ? NPROMPT + b * 64 : b * 4096, nch = samp ? 4 : 256;
        if (tid < 16) ready[tid] = 0u;
        __syncthreads();
        if (wave < CK_NPROD) {
            const int q = lane >> 4, kg = lane & 15, cidx = h * 64 + 4 * kg;
            const float* ssrc = samp ? a.in[2] + (size_t)b * SHW + cidx : nullptr;
            LAS unsigned char* scr = lds + CK_SCR + wave * CKP_SIZE;
            CkRaw R;
            if (wave < nch) ck_load(R, PS, LW, AR, m0 + 16 * wave + 4 * q, cidx, m0);
            for (int c = wave; c < nch; c += CK_NPROD) {
                LAS unsigned char* slot = lds + CK_SLOTS + (c % CK_NSLOT) * CKS_SIZE;
                unsigned tch0 = 0u, tch1 = 0u;
                if (c + 2 * CK_NPROD < nch) {
                    const int mt = m0 + 16 * (c + 2 * CK_NPROD);
                    { const int tk = lane / 5, ar_ = lane - 5 * tk; const size_t row = (size_t)(mt + tk);
                      const unsigned* p = ar_ < 3 ? (const unsigned*)(PS + row * SHW + ar_ * 1024 + h * 64) : (ar_ == 3 ? (const unsigned*)(LW + row * 1024 + h * 64) : (const unsigned*)(AR + row * 1024 + h * 64));
                      tch0 = *p; }
                    if (lane < 16) { const int idx = 64 + lane, tk = idx / 5, ar_ = idx - 5 * tk; const size_t row = (size_t)(mt + tk);
                      const unsigned* p = ar_ < 3 ? (const unsigned*)(PS + row * SHW + ar_ * 1024 + h * 64) : (ar_ == 3 ? (const unsigned*)(LW + row * 1024 + h * 64) : (const unsigned*)(AR + row * 1024 + h * 64));
                      tch1 = *p; }
                }
                if (c >= CK_NSLOT) {
#pragma unroll
                    for (int j = 0; j < CK_NCONS; ++j) ck_wait_ge(done + j, (unsigned)(c - CK_NSLOT + 1));
                }
                ck_prep(slot, scr, R, a.in, cidx, c == 0 && q == 0, ssrc, lane);
                if (c + CK_NPROD < nch) ck_load(R, PS, LW, AR, m0 + 16 * (c + CK_NPROD) + 4 * q, cidx, m0);
                ck_mfma(slot, scr, lane);
                asm volatile("s_waitcnt lgkmcnt(0)" ::: "memory");
                if (lane == 0) ready[c % CK_NSLOT] = (unsigned)(c + 1);
                asm volatile("" :: "v"(tch0), "v"(tch1));
            }
        } else if (wave < CK_NPROD + CK_NCONS) {
            const int cj = wave - CK_NPROD, n = lane & 15, q = lane >> 4;
            f32x4 Sb[CK_NVB][4];
#pragma unroll
            for (int v = 0; v < CK_NVB; ++v)
#pragma unroll
                for (int kb = 0; kb < 4; ++kb) {
                    Sb[v][kb] = (f32x4){0.f, 0.f, 0.f, 0.f};
                    if (samp) Sb[v][kb] = *(const f32x4*)(a.in[3] + ((size_t)((b * 16 + h) * 64 + 16 * (cj * CK_NVB + v) + n)) * 64 + 16 * kb + 4 * q);
                }
            for (int c = 0; c < nch; ++c) {
                const LAS unsigned char* slot = lds + CK_SLOTS + (c % CK_NSLOT) * CKS_SIZE;
                ck_wait_ge(ready + (c % CK_NSLOT), (unsigned)(c + 1));
                asm volatile("" ::: "memory");
#pragma unroll
                for (int v = 0; v < CK_NVB; ++v) ck_consume(slot, Sb[v], cj * CK_NVB + v, lane, Y + (size_t)(m0 + 16 * c) * 1024 + h * 64);
                asm volatile("s_waitcnt lgkmcnt(0)" ::: "memory");
                if (lane == 0) done[cj] = (unsigned)(c + 1);
            }
            float* So = a.out + (samp ? OUT_WKV_S : OUT_WKV_P);
#pragma unroll
            for (int v = 0; v < CK_NVB; ++v)
#pragma unroll
                for (int kb = 0; kb < 4; ++kb) *(f32x4*)(So + ((size_t)((b * 16 + h) * 64 + 16 * (cj * CK_NVB + v) + n)) * 64 + 16 * kb + 4 * q) = Sb[v][kb];
        }
        __syncthreads();
    }
    if (G > 128 && bid >= 128) conv_items(a, CV_EARLY, CV_ALL, (bid - 128) * 8 + wave, (G - 128) * 8, lane);
}

__device__ __forceinline__ void ld16bf(const bf16* p, float (&o)[16]) {
    const u32x4 w0 = *(const u32x4*)p, w1 = *(const u32x4*)(p + 8); f32x4 a, b, c, d; dec8bf(w0, a, b); dec8bf(w1, c, d);
#pragma unroll
    for (int i = 0; i < 4; ++i) { o[i] = a[i]; o[4 + i] = b[i]; o[8 + i] = c[i]; o[12 + i] = d[i]; }
}
__device__ __forceinline__ void ld16h(const f16* p, float (&o)[16]) {
    const u32x4 w0 = *(const u32x4*)p, w1 = *(const u32x4*)(p + 8);
    const f32x4 a = dec4h((u32x2){w0.x, w0.y}), b = dec4h((u32x2){w0.z, w0.w}), c = dec4h((u32x2){w1.x, w1.y}), d = dec4h((u32x2){w1.z, w1.w});
#pragma unroll
    for (int i = 0; i < 4; ++i) { o[i] = a[i]; o[4 + i] = b[i]; o[8 + i] = c[i]; o[12 + i] = d[i]; }
}
__device__ __forceinline__ void ld16f(const float* p, float (&o)[16]) {
#pragma unroll
    for (int j = 0; j < 4; ++j) { const f32x4 x = ((const f32x4*)p)[j];
#pragma unroll
        for (int i = 0; i < 4; ++i) o[4 * j + i] = x[i]; }
}
__device__ __forceinline__ void tokshift16(float (&x)[16], const bf16* prevp, bool has_prev, bool samp, const float* ssrc, const float* mu) {
    float tmp[16], cst[16];
    if (has_prev) ld16bf(prevp, tmp);
    else if (samp) ld16f(ssrc, tmp);
    else {
#pragma unroll
        for (int i = 0; i < 16; ++i) tmp[i] = 0.f; }
    ld16f(mu, cst);
#pragma unroll
    for (int i = 0; i < 16; ++i) x[i] = x[i] + (tmp[i] - x[i]) * cst[i];
}
__device__ __forceinline__ float oct_sum(float x) { x += dppf<0xB1>(x); x += dppf<0x4E>(x); x += dppf<0x141>(x); return x; }
__device__ __forceinline__ void ld8f(const float* p, float (&o)[8]) { const f32x4 a = *(const f32x4*)p, b = *(const f32x4*)(p + 4);
#pragma unroll
    for (int i = 0; i < 4; ++i) { o[i] = a[i]; o[4 + i] = b[i]; } }
__device__ __forceinline__ void ld8bf(const bf16* p, float (&o)[8]) { f32x4 a, b; dec8bf(*(const u32x4*)p, a, b);
#pragma unroll
    for (int i = 0; i < 4; ++i) { o[i] = a[i]; o[4 + i] = b[i]; } }
__device__ __forceinline__ void ld8h(const f16* p, float (&o)[8]) { const u32x4 w = *(const u32x4*)p; const f32x4 a = dec4h((u32x2){w.x, w.y}), b = dec4h((u32x2){w.z, w.w});
#pragma unroll
    for (int i = 0; i < 4; ++i) { o[i] = a[i]; o[4 + i] = b[i]; } }
template <bool DRY> __device__ __forceinline__ void phase_gn(const Args& a, LAS unsigned char* lds) {
    PH_PROLOG
    const bf16* PS = (const bf16*)(a.ws + WS_PS); const f16* AR = (const f16*)(a.ws + WS_AR); f16* Gp = (f16*)(a.ws + WS_G);
    const bf16* Y = (const bf16*)a.out;
    const int h = gw & 15, c = h * 64 + 8 * (lane & 7), r8 = lane >> 3;
    float mu_r[8], mu_k[8], mu_v[8], ka[8], rkc[8], gg[8], gb[8];
    ld8f(a.in[6] + c, mu_r); ld8f(a.in[6] + 1024 + c, mu_k); ld8f(a.in[6] + 2048 + c, mu_v); ld8f(a.in[13] + c, ka); ld8f(a.in[14] + c, rkc); ld8f(a.in[15] + c, gg); ld8f(a.in[16] + c, gb);
    for (int rg = gw >> 4; rg < M / 8; rg += NGW >> 4) {
        const int m = rg * 8 + r8; const bool samp = m >= NPROMPT; const int t = samp ? ((m - NPROMPT) & 63) : (m & 4095);
        const bf16* base = PS + (size_t)m * SHW + c;
        float xr[8], xk[8], xv[8], pr[8], pk[8], pv[8], ar[8], y[8], g[8];
        ld8bf(base, xr); ld8bf(base + 1024, xk); ld8bf(base + 2048, xv);
        if (t > 0) { ld8bf(base - SHW, pr); ld8bf(base - SHW + 1024, pk); ld8bf(base - SHW + 2048, pv); }
        else if (samp) { const float* ss = a.in[2] + (size_t)((m - NPROMPT) >> 6) * SHW + c; ld8f(ss, pr); ld8f(ss + 1024, pk); ld8f(ss + 2048, pv); }
        else {
#pragma unroll
            for (int i = 0; i < 8; ++i) { pr[i] = 0.f; pk[i] = 0.f; pv[i] = 0.f; } }
        ld8h(AR + (size_t)m * 1024 + c, ar); ld8bf(Y + (size_t)m * 1024 + c, y); ld8h(Gp + (size_t)m * 1024 + c, g);
        float rk = 0.f, s = 0.f;
#pragma unroll
        for (int i = 0; i < 8; ++i) {
            xr[i] = xr[i] + (pr[i] - xr[i]) * mu_r[i]; xk[i] = xk[i] + (pk[i] - xk[i]) * mu_k[i]; xv[i] = xv[i] + (pv[i] - xv[i]) * mu_v[i];
            xk[i] = xk[i] * (1.f + (ar[i] - 1.f) * ka[i]);
            rk += xr[i] * xk[i] * rkc[i]; s += y[i];
        }
        rk = oct_sum(rk);
        const float mean = oct_sum(s) * (1.f / 64.f); float q2 = 0.f;
#pragma unroll
        for (int i = 0; i < 8; ++i) { y[i] -= mean; q2 += y[i] * y[i]; }
        const float rstd = rsqrtf(oct_sum(q2) * (1.f / 64.f) + 64e-5f);
        float o[8];
#pragma unroll
        for (int i = 0; i < 8; ++i) o[i] = (y[i] * rstd * gg[i] + gb[i] + rk * xv[i]) * g[i];
        u32x4 w; w.x = pkbf(o[0], o[1]); w.y = pkbf(o[2], o[3]); w.z = pkbf(o[4], o[5]); w.w = pkbf(o[6], o[7]);
        if (!DRY || rk == 1.2345e30f) *(u32x4*)((bf16*)Gp + (size_t)m * 1024 + c) = w;
    }
}

__device__ __forceinline__ int gm_swz(int row) { return (row & 3) | (((row >> 3) & 1) << 2); }
__device__ __forceinline__ void phase_gmlp(const Args& a, LAS unsigned char* lds) {
    PH_PROLOG
    const bf16* PU = (const bf16*)(a.ws + WS_P4); const bf16* PV = (const bf16*)(a.ws + WS_P4 + U); bf16* OB = (bf16*)(a.ws + WS_OB);
    const bf16* WSP = (const bf16*)(a.ws + WS_WSP); const float* LNP = (const float*)(a.ws + WS_LX);
    LAS float* stats = (LAS float*)lds;
    LAS unsigned char* img = lds + 4096;
    const int trow_s = wave >= 4 ? 64 : 0, t0 = wave * 16;
    for (int unit = bid; unit < 272 * 8; unit += G) {
        const int ch = unit >> 3, g = unit & 7; const bool samp = ch >= 256; const int m0 = ch * 128;
        if (tid < 128) {
            const float* p = LNP + (size_t)(m0 + tid) * 32; float sm = 0.f, sq = 0.f;
#pragma unroll
            for (int j = 0; j < 8; ++j) { const f32x4 v = *(const f32x4*)(p + 4 * j); sm += v[0] + v[2]; sq += v[1] + v[3]; }
            const float mean = sm * (1.f / 1024.f), var = sq * (1.f / 1024.f) - mean * mean;
            stats[2 * tid] = mean; stats[2 * tid + 1] = rsqrtf(fmaxf(var, 0.f) + 1e-5f);
        }
        __syncthreads();
#pragma unroll
        for (int i = 0; i < 4; ++i) {
            const int p = tid + 512 * i, row = p >> 4, c8 = p & 15, gc = g * 128 + 8 * c8;
            f32x4 x0, x1; dec8bf(*(const u32x4*)(PV + (size_t)(m0 + row) * 1024 + gc), x0, x1);
            const float mean = stats[2 * row], rstd = stats[2 * row + 1];
            const f32x4 g0 = *(const f32x4*)(a.in[17] + gc), g1 = *(const f32x4*)(a.in[17] + gc + 4), b0 = *(const f32x4*)(a.in[18] + gc), b1 = *(const f32x4*)(a.in[18] + gc + 4);
            x0 = (x0 - mean) * rstd * g0 + b0; x1 = (x1 - mean) * rstd * g1 + b1;
            *(LAS u32x4*)(img + row * 256 + (((c8 >> 1) ^ gm_swz(row)) << 5) + (c8 & 1) * 16) = pk8bf(x0, x1);
            if (samp) { float* o = a.out + OUT_VS + (size_t)(m0 + row - NPROMPT) * 1024 + gc; *(f32x4*)o = x0; *(f32x4*)(o + 4) = x1; }
        }
        __syncthreads();
        const int trow_off = samp ? trow_s : 0;
        const int ks_lo = trow_off >> 5, ks_hi = (t0 + 15) >> 5;
        f32x4 acc[8];
#pragma unroll
        for (int ct = 0; ct < 8; ++ct) acc[ct] = (f32x4){0.f, 0.f, 0.f, 0.f};
        for (int ks = ks_lo; ks <= ks_hi; ++ks) {
            const bf16x8 wf = *(const bf16x8*)(WSP + ((size_t)(g * 128 + t0 - trow_off + (lane & 15))) * 128 + 32 * ks - trow_off + 8 * (lane >> 4));
            const int row = 32 * ks + 8 * (lane >> 4) + ((lane & 15) >> 2);
            const int sw = gm_swz(row);
#pragma unroll
            for (int ct = 0; ct < 8; ++ct) {
                LAS unsigned char* p = img + row * 256 + ((ct ^ sw) << 5) + (lane & 3) * 8;
                const s16x4 lo = __builtin_amdgcn_ds_read_tr16_b64_v4i16((LAS s16x4*)p), hi = __builtin_amdgcn_ds_read_tr16_b64_v4i16((LAS s16x4*)(p + 1024));
                bf16x8 vf; vf[0] = lo[0]; vf[1] = lo[1]; vf[2] = lo[2]; vf[3] = lo[3]; vf[4] = hi[0]; vf[5] = hi[1]; vf[6] = hi[2]; vf[7] = hi[3];
                acc[ct] = __builtin_amdgcn_mfma_f32_16x16x32_bf16(vf, wf, acc[ct], 0, 0, 0);
            }
        }
        const int t = t0 + (lane & 15);
        const float bias = a.in[20][g * 128 + t - trow_off];
#pragma unroll
        for (int ct = 0; ct < 8; ++ct) {
            const size_t o = (size_t)(m0 + t) * 1024 + g * 128 + 16 * ct + 4 * (lane >> 4);
            const f32x4 pu = dec4bf(*(const u32x2*)(PU + o));
            *(u32x2*)(OB + o) = pk4bf(pu * (acc[ct] + bias));
        }
        __syncthreads();
    }
}

__device__ __forceinline__ void phase_p5b(const Args& a, LAS unsigned char* lds) {
    PH_PROLOG
    const float* MO = (const float*)(a.ws + WS_MO); bf16* F = (bf16*)(a.ws + WS_F);
    for (int m = gw; m < M; m += NGW) {
        const float* xr = xrow_ptr(a, m); f32x4 v[4]; float ss = 0.f;
#pragma unroll
        for (int j = 0; j < 4; ++j) { v[j] = ((const f32x4*)(MO + (size_t)m * 1024))[lane + 64 * j]; ss += (v[j][0] * v[j][0] + v[j][1] * v[j][1]) + (v[j][2] * v[j][2] + v[j][3] * v[j][3]); }
        const float rs = rsqrtf(wave_sum(ss) * (1.f / 1024.f) + 1e-6f); float s2 = 0.f;
#pragma unroll
        for (int j = 0; j < 4; ++j) { const f32x4 g = ((const f32x4*)a.in[24])[lane + 64 * j], x = ((const f32x4*)xr)[lane + 64 * j];
            v[j] = x + v[j] * rs * g; ((f32x4*)(a.out + OUT_Y + (size_t)m * 1024))[lane + 64 * j] = v[j];
            s2 += (v[j][0] * v[j][0] + v[j][1] * v[j][1]) + (v[j][2] * v[j][2] + v[j][3] * v[j][3]); }
        const float rs2 = rsqrtf(wave_sum(s2) * (1.f / 1024.f) + 1e-6f);
#pragma unroll
        for (int j = 0; j < 4; ++j) { const f32x4 g = ((const f32x4*)a.in[25])[lane + 64 * j]; ((u32x2*)(F + (size_t)m * 1024))[lane + 64 * j] = pk4bf(v[j] * rs2 * g); }
    }
}
__device__ __forceinline__ void phase_p7b(const Args& a, LAS unsigned char* lds) {
    PH_PROLOG
    const float* F2 = (const float*)(a.ws + WS_F2);
    for (int m = gw; m < M; m += NGW) {
        f32x4 v[4]; float ss = 0.f;
#pragma unroll
        for (int j = 0; j < 4; ++j) { v[j] = ((const f32x4*)(F2 + (size_t)m * 1024))[lane + 64 * j]; ss += (v[j][0] * v[j][0] + v[j][1] * v[j][1]) + (v[j][2] * v[j][2] + v[j][3] * v[j][3]); }
        const float rs = rsqrtf(wave_sum(ss) * (1.f / 1024.f) + 1e-6f);
        f32x4* o = (f32x4*)(a.out + OUT_Y + (size_t)m * 1024);
#pragma unroll
        for (int j = 0; j < 4; ++j) { const f32x4 g = ((const f32x4*)a.in[29])[lane + 64 * j]; o[lane + 64 * j] = o[lane + 64 * j] + v[j] * rs * g; }
    }
}

#define XB_TMO      128
#define XB_XCNT(j)  (256  + 64 * (j))
#define XB_XSUB(j)  (1280 + 64 * (j))
#define XB_XGEN(j)  (2304 + 64 * (j))
#define XB_TOP      3328
#define XB_TOPGEN   3392
#define XCD_BAR_WORDS 3456
#define XB_SPIN_CAP (1u << 18)

__device__ __forceinline__ unsigned xb_ld(unsigned* p)              { return __hip_atomic_load(p, __ATOMIC_RELAXED, __HIP_MEMORY_SCOPE_AGENT); }
__device__ __forceinline__ unsigned xb_add(unsigned* p, unsigned v) { return __hip_atomic_fetch_add(p, v, __ATOMIC_RELAXED, __HIP_MEMORY_SCOPE_AGENT); }
__device__ __forceinline__ unsigned xb_xcc_id() { return (unsigned)__builtin_amdgcn_s_getreg((3 << 11) | 20) & 0xFu; }
#define XB_SPIN(cond, bar) do { unsigned _sp = 0; while (cond) { __builtin_amdgcn_s_sleep(1); \
    if ((++_sp & 255u) == 0u) { if (xb_ld(&(bar)[XB_TMO])) break; if (_sp > XB_SPIN_CAP) { atomicAdd(&(bar)[XB_TMO], 1u); break; } } } } while (0)

struct XcdBarrier {
    unsigned* bar; unsigned x;
    volatile LAS unsigned* st;
};

__device__ __forceinline__ XcdBarrier xcd_barrier_post(unsigned* bar, volatile LAS unsigned* st) {
    XcdBarrier b; b.bar = bar; b.x = xb_xcc_id(); b.st = st;
    if (threadIdx.x == 0) (void)xb_add(&bar[XB_XCNT(b.x)], 1u);
    return b;
}
__device__ __forceinline__ void xcd_barrier_complete(unsigned* bar, unsigned x, unsigned& nloc, unsigned& nx) {
    const unsigned G = gridDim.x * gridDim.y * gridDim.z;
    unsigned sum, cnt, mine, sp = 0u;
    for (;;) {
        sum = 0u; cnt = 0u; mine = 0u;
#pragma unroll
        for (unsigned j = 0; j < 16; ++j) { const unsigned c = xb_ld(&bar[XB_XCNT(j)]); sum += c; cnt += (c > 0u) ? 1u : 0u; mine = (j == x) ? c : mine; }
        if (sum == G) break;
        __builtin_amdgcn_s_sleep(1);
        if ((++sp & 255u) == 0u) { if (xb_ld(&bar[XB_TMO])) break; if (sp > XB_SPIN_CAP) { atomicAdd(&bar[XB_TMO], 1u); break; } }
    }
    nloc = mine > 0u ? mine : 1u; nx = cnt > 0u ? cnt : 1u;
}

__device__ __forceinline__ void xcd_barrier(const XcdBarrier& b) {
    asm volatile("s_waitcnt vmcnt(0)" ::: "memory");
    __syncthreads();
    if (threadIdx.x == 0) {
        unsigned* bar = b.bar;
        __builtin_amdgcn_s_waitcnt(0);
        unsigned nloc = b.st[0], nx = b.st[1];
        if (nloc == 0u) { xcd_barrier_complete(bar, b.x, nloc, nx); b.st[0] = nloc; b.st[1] = nx; }
        const unsigned old = xb_add(&bar[XB_XSUB(b.x)], 1u);
        const unsigned gen = old / nloc;
        if (old + 1u == (gen + 1u) * nloc) {
            __builtin_amdgcn_fence(__ATOMIC_RELEASE, "agent");
            asm volatile("s_waitcnt vmcnt(0)" ::: "memory");
            const unsigned og = xb_add(&bar[XB_TOP], 1u);
            const unsigned tg = og / nx;
            if (og + 1u == (tg + 1u) * nx) xb_add(&bar[XB_TOPGEN], 1u);
            else XB_SPIN(xb_ld(&bar[XB_TOPGEN]) == tg, bar);
            __builtin_amdgcn_fence(__ATOMIC_ACQUIRE, "agent");
            xb_add(&bar[XB_XGEN(b.x)], 1u);
            asm volatile("s_waitcnt vmcnt(0)" ::: "memory");
        } else {
            XB_SPIN(xb_ld(&bar[XB_XGEN(b.x)]) == gen, bar);
            __builtin_amdgcn_fence(__ATOMIC_ACQUIRE, "agent");
            asm volatile("s_waitcnt vmcnt(0)" ::: "memory");
        }
    }
    __syncthreads();
}

template <class E> __device__ __forceinline__ void run_gemm(LAS unsigned char* lds, const bf16* A, const bf16* Bt, int N, int K, const E& e) {
    pg8::Gemm g{A, Bt, M, N, K}; pg8::StaticOrder S; S.init(M, N, (int)gridDim.x, (int)blockIdx.x);
    pg8::gemm_phase<E, pg8::StaticOrder, true, true>(lds, g, S, e);
}
__global__ void __launch_bounds__(512, 2) mk_fwd(Args a) {
    extern __shared__ __attribute__((aligned(16))) unsigned char lds_raw[];
    LAS unsigned char* lds = (LAS unsigned char*)lds_raw;
    unsigned char* ws = a.ws;
    const int lo = a.ph_lo, hi = a.ph_hi;
    volatile LAS unsigned* MISC = (volatile LAS unsigned*)(lds + LDS_BYTES - 256);
    if (threadIdx.x < 64) MISC[threadIdx.x] = 0u;
    __syncthreads();
#define IN(k) (lo <= (k) && (k) < hi)
#ifndef MK_REP
#define MK_REP -1
#endif
#define XBAR() do { XcdBarrier b_; b_.bar = (unsigned*)a.ws; b_.x = xb_xcc_id(); b_.st = (volatile LAS unsigned*)(lds + LDS_BYTES - 256) + 8; xcd_barrier(b_); } while (0)
#define SEAM(k) do { if (IN(k) && IN((k) + 1)) { if ((k) == 0) { cg::this_grid().sync(); if (threadIdx.x == 0) (void)xb_add((unsigned*)a.ws + XB_XCNT(xb_xcc_id()), 1u); } else XBAR(); } } while (0)
#define REP(k, ...) do { if (MK_REP == (k)) { XBAR(); __VA_ARGS__; } } while (0)
    if (IN(0)) { phase_p0(a, lds); REP(0, phase_p0(a, lds)); } SEAM(0);
    if (IN(1)) { Epi8<FStoreBf16> e{{(bf16*)(ws + WS_PS), SHW}}; run_gemm(lds, (const bf16*)(ws + WS_XN), (const bf16*)(ws + WS_WIN), SHW, 1024, e); REP(1, Epi8<FStoreBf16> e{{(bf16*)(ws + WS_PS), SHW}}; run_gemm(lds, (const bf16*)(ws + WS_XN), (const bf16*)(ws + WS_WIN), SHW, 1024, e)); } SEAM(1);
    if (IN(2)) { phase_p2a(a, lds); REP(2, phase_p2a(a, lds)); } SEAM(2);
    if (IN(3)) { Epi8<FLora> e{{(f16*)((unsigned char*)a.out + U), (f16*)(ws + WS_AR), (f16*)(ws + WS_G), a.in[7], a.in[9]}}; run_gemm(lds, (const bf16*)(ws + WS_LX), (const bf16*)(ws + WS_LORA), 3072, 256, e); REP(3, Epi8<FLora> e{{(f16*)((unsigned char*)a.out + U), (f16*)(ws + WS_AR), (f16*)(ws + WS_G), a.in[7], a.in[9]}}; run_gemm(lds, (const bf16*)(ws + WS_LX), (const bf16*)(ws + WS_LORA), 3072, 256, e)); } SEAM(3);
    if (IN(4)) { phase_scan(a, lds); REP(4, phase_scan(a, lds)); } SEAM(4);
    if (IN(5)) { phase_gn<false>(a, lds); REP(5, phase_gn<true>(a, lds)); } SEAM(5);
    if (IN(6)) { EpiP1b e{(bf16*)(ws + WS_P4), (float*)(ws + WS_LX)}; run_gemm(lds, (const bf16*)(ws + WS_XN), (const bf16*)(ws + WS_WIN) + (size_t)SHW * 1024, 4096, 1024, e); REP(6, EpiP1b e{(bf16*)(ws + WS_P4), (float*)(ws + WS_LX)}; run_gemm(lds, (const bf16*)(ws + WS_XN), (const bf16*)(ws + WS_WIN) + (size_t)SHW * 1024, 4096, 1024, e)); } SEAM(6);
    if (IN(7)) { phase_gmlp(a, lds); REP(7, phase_gmlp(a, lds)); } SEAM(7);
    if (IN(8)) { Epi8<FGateA> e{{(const bf16*)(ws + WS_P4 + 2 * U), (bf16*)(ws + WS_MM)}}; run_gemm(lds, (const bf16*)(ws + WS_OA), (const bf16*)(ws + WS_WA), 1024, 1024, e); REP(8, Epi8<FGateA> e{{(const bf16*)(ws + WS_P4 + 2 * U), (bf16*)(ws + WS_MM)}}; run_gemm(lds, (const bf16*)(ws + WS_OA), (const bf16*)(ws + WS_WA), 1024, 1024, e)); } SEAM(8);
    if (IN(9)) { Epi8<FGateB> e{{(const bf16*)(ws + WS_P4 + 3 * U), (bf16*)(ws + WS_MM)}}; run_gemm(lds, (const bf16*)(ws + WS_OB), (const bf16*)(ws + WS_WB), 1024, 1024, e); REP(9, Epi8<FGateB> e{{(const bf16*)(ws + WS_P4 + 3 * U), (bf16*)(ws + WS_MM)}}; run_gemm(lds, (const bf16*)(ws + WS_OB), (const bf16*)(ws + WS_WB), 1024, 1024, e)); } SEAM(9);
    if (IN(10)) { Epi4<FStoreF32> e{{(float*)(ws + WS_MO), 1024}}; run_gemm(lds, (const bf16*)(ws + WS_MM), (const bf16*)(ws + WS_WO), 1024, 1024, e); REP(10, Epi4<FStoreF32> e{{(float*)(ws + WS_MO), 1024}}; run_gemm(lds, (const bf16*)(ws + WS_MM), (const bf16*)(ws + WS_WO), 1024, 1024, e)); } SEAM(10);
    if (IN(11)) { phase_p5b(a, lds); REP(11, phase_p5b(a, lds)); } SEAM(11);
    if (IN(12)) { EpiGU e{(bf16*)(ws + WS_H)}; run_gemm(lds, (const bf16*)(ws + WS_F), (const bf16*)(ws + WS_GU), 2 * DFF, 1024, e); REP(12, EpiGU e{(bf16*)(ws + WS_H)}; run_gemm(lds, (const bf16*)(ws + WS_F), (const bf16*)(ws + WS_GU), 2 * DFF, 1024, e)); } SEAM(12);
    if (IN(13)) { Epi4<FStoreF32> e{{(float*)(ws + WS_F2), 1024}}; run_gemm(lds, (const bf16*)(ws + WS_H), (const bf16*)(ws + WS_WD), 1024, DFF, e); REP(13, Epi4<FStoreF32> e{{(float*)(ws + WS_F2), 1024}}; run_gemm(lds, (const bf16*)(ws + WS_H), (const bf16*)(ws + WS_WD), 1024, DFF, e)); } SEAM(13);
    if (MK_REP == 100) { for (int i = 0; i < 14; ++i) XBAR(); }
    if (IN(14)) { phase_p7b(a, lds); }
#undef IN
#undef SEAM
}


#ifndef MK_DBG
#define MK_DBG 0
#endif
__global__ void dbg_zero(float* p, size_t n) { for (size_t i = (size_t)blockIdx.x * blockDim.x + threadIdx.x; i < n; i += (size_t)gridDim.x * blockDim.x) p[i] = 0.f; }
extern "C" void kernel_launch(void* const* d_in, const int* in_sizes, int n_in, void* d_out, int out_size, void* d_ws, size_t ws_size, hipStream_t stream) {
    static int grid = 0;
    if (grid == 0) {
        if (n_in != 30 || (size_t)out_size != OUT_END || ws_size < WS_END) { fprintf(stderr, "kernel_launch: unexpected shapes (n_in %d out %d ws %zu, need ws >= %zu)\n", n_in, out_size, ws_size, (size_t)WS_END); }
        int dev = 0, cus = 0, per_cu = 0;
        (void)hipGetDevice(&dev); (void)hipDeviceGetAttribute(&cus, hipDeviceAttributeMultiprocessorCount, dev);
        (void)hipFuncSetAttribute((const void*)mk_fwd, hipFuncAttributeMaxDynamicSharedMemorySize, LDS_BYTES);
        (void)hipOccupancyMaxActiveBlocksPerMultiprocessor(&per_cu, (const void*)mk_fwd, 512, LDS_BYTES);
        if (per_cu < 1) { fprintf(stderr, "kernel_launch: occupancy query says %d blocks per CU\n", per_cu); per_cu = 1; }
        grid = cus > 0 ? cus : 256;
        (void)hipGetLastError();
    }
    Args a{};
    for (int i = 0; i < 30; ++i) a.in[i] = (const float*)d_in[i];
    a.out = (float*)d_out; a.ws = (unsigned char*)d_ws;
#if MK_ONE_LAUNCH
    (void)hipMemsetAsync(d_ws, 0, 65536, stream);
    a.ph_lo = 0; a.ph_hi = NPHASE;
    void* args[] = {&a};
    hipError_t e = hipLaunchCooperativeKernel((const void*)mk_fwd, dim3(grid), dim3(512), args, LDS_BYTES, stream);
    if (e != hipSuccess) fprintf(stderr, "cooperative launch failed: %s (grid %d)\n", hipGetErrorString(e), grid);
#else
    const int nph = MK_DBG == 1 ? 5 : (MK_DBG == 2 ? 3 : (MK_DBG == 3 ? 8 : NPHASE));
    for (int p = 0; p < nph; ++p) { a.ph_lo = p; a.ph_hi = p + 1; hipLaunchKernelGGL(mk_fwd, dim3(grid), dim3(512), LDS_BYTES, stream, a); }
    float* o = (float*)d_out;
    if (MK_DBG >= 1) hipLaunchKernelGGL(dbg_zero, dim3(1024), dim3(256), 0, stream, o + OUT_Y, (size_t)M * 1024);
    if (MK_DBG == 1 || MK_DBG == 2) hipLaunchKernelGGL(dbg_zero, dim3(1024), dim3(256), 0, stream, o + OUT_VS, (size_t)32 * 64 * 1024);
    if (MK_DBG == 2) { hipLaunchKernelGGL(dbg_zero, dim3(1024), dim3(256), 0, stream, o + OUT_WKV_P, (size_t)8 * 16 * 4096); hipLaunchKernelGGL(dbg_zero, dim3(1024), dim3(256), 0, stream, o + OUT_WKV_S, (size_t)32 * 16 * 4096); }
#endif
}
```

```cpp
#include <hip/hip_runtime.h>
#include <hip/hip_cooperative_groups.h>
#include <cstdio>
#include <cstdint>
namespace cg = cooperative_groups;
namespace pg8 {
#define PG8_LAS __attribute__((address_space(3)))
typedef unsigned short bf16_t;
typedef short bf16x8 __attribute__((ext_vector_type(8)));
typedef float f32x4 __attribute__((ext_vector_type(4)));
typedef unsigned u32x4 __attribute__((ext_vector_type(4)));
constexpr int BM = 256, BK = 64, HALF = 128, HTB = HALF * BK * 2  , STAGE_BYTES = 8 * HTB, NXCD = 8, WGM = 8;

__host__ __device__ __forceinline__ int lds_byte(int r, int c) { const int st = (r >> 4) * 2 + (c >> 5), rr = r & 15, cc = c & 31, ob = rr * 64 + cc * 2; return st * 1024 + (ob ^ (((ob >> 9) & 1) << 5)); }
__host__ __device__ __forceinline__ void stage_rc(int b, int& R, int& C) { const int st = b / 1024, sb = b % 1024, swz = sb ^ (((sb >> 9) & 1) << 5); R = (st >> 1) * 16 + swz / 64; C = (st & 1) * 32 + (swz % 64) / 2; }
__host__ __device__ __forceinline__ int perm32(int rho) { const int n = rho >> 4, i = rho & 15; return 8 * (i >> 2) + 4 * n + (i & 3); }

struct Unit { int pm, pn; };
struct Gemm { const bf16_t* A; const bf16_t* Bt; int M, N, K; int nt = 0; };

struct StaticOrder {
    int nM, nN, nwg, G, c;
    __host__ __device__ void init(int M, int N, int G_, int c_) { nM = M / BM; nN = N / BM; nwg = nM * nN; G = G_; c = c_; }
    __host__ __device__ bool next(int i, Unit& u) const {
        const long L = (long)i * G + c; if (L >= nwg) return false;
        int wgid = (int)L; { const int q = nwg / NXCD, r = nwg % NXCD, xcd = wgid % NXCD, off = wgid / NXCD; wgid = (xcd < r ? xcd * (q + 1) : r * (q + 1) + (xcd - r) * q) + off; }
        const int nig = WGM * nN, gid = wgid / nig, fm = gid * WGM, gsz = (nM - fm) < WGM ? (nM - fm) : WGM;
        u.pm = fm + ((wgid % nig) % gsz); u.pn = (wgid % nig) / gsz; return true;
    }
    __device__ __forceinline__ void a_ready(const Unit&) const {}
    __device__ __forceinline__ void done(const Unit&) const {}
};

__device__ __forceinline__ unsigned cvt_pk_bf16(float lo, float hi) { unsigned r; asm volatile("v_cvt_pk_bf16_f32 %0, %1, %2" : "=v"(r) : "v"(lo), "v"(hi)); return r; }
typedef float f32x2 __attribute__((ext_vector_type(2)));
template <class Epi, class Sched, bool ALIGN_EPI = false, bool SP2 = false>
__device__ __forceinline__ void gemm_phase(PG8_LAS unsigned char* lds, const Gemm g, const Sched& S, const Epi& E) {
    const int tid = threadIdx.x, wid = __builtin_amdgcn_readfirstlane(tid >> 6), lane = tid & 63, wr = wid >> 2, wc = wid & 3, fr = lane & 15, fq = lane >> 4;
    const int K = g.K, nt = g.nt > 0 ? g.nt : K / BK;
    unsigned voffA[2], voffB[2];
#pragma unroll
    for (int i = 0; i < 2; ++i) { int R, C; stage_rc(tid * 16 + i * 8192, R, C); const int Rb = Epi::PERM ? ((R & ~31) + perm32(R & 31)) : R;
        voffA[i] = (unsigned)(R * K + C) * 2u; voffB[i] = (unsigned)(Rb * K + C) * 2u; }
    const size_t kstep = (size_t)(BK * 2);
    const size_t hstep = (size_t)HALF * K * 2;
    const size_t tstep = 2 * hstep;
    const unsigned ldsw = (unsigned)wid * 1024u;
    const int aoff = lds_byte(wr * 64 + fr, fq * 8), boff = lds_byte(wc * 32 + fr, fq * 8);
#define PG8_SA(b, h) (((b) * 2 + (h)) * HTB)
#define PG8_SB(b, h) ((4 + (b) * 2 + (h)) * HTB)
#define PG8_STAGE(bufoff, gbase, voff) do { _Pragma("unroll") for (int _i = 0; _i < 2; ++_i) \
        __builtin_amdgcn_global_load_lds((const unsigned*)((const char*)(gbase) + (voff)[_i]), (PG8_LAS unsigned*)(lds + (bufoff) + ldsw + _i * 8192), 16, 0, 0); } while (0)
#define PG8_LDA(dst, b, h) do { _Pragma("unroll") for (int m = 0; m < 4; ++m) _Pragma("unroll") for (int k = 0; k < 2; ++k) dst[m][k] = *(const PG8_LAS bf16x8*)(lds + PG8_SA(b, h) + aoff + m * 2048 + k * 1024); } while (0)
#define PG8_LDB(dst, b, h) do { _Pragma("unroll") for (int n = 0; n < 2; ++n) _Pragma("unroll") for (int k = 0; k < 2; ++k) dst[n][k] = *(const PG8_LAS bf16x8*)(lds + PG8_SB(b, h) + boff + n * 2048 + k * 1024); } while (0)
#define PG8_MMA(ai, bj, At, Bt) do { __builtin_amdgcn_s_setprio(1); _Pragma("unroll") for (int m = 0; m < 4; ++m) _Pragma("unroll") for (int n = 0; n < 2; ++n) _Pragma("unroll") for (int k = 0; k < 2; ++k) \
        acc[ai][bj][m][n] = __builtin_amdgcn_mfma_f32_16x16x32_bf16(Bt[n][k], At[m][k], acc[ai][bj][m][n], 0, 0, 0); __builtin_amdgcn_s_setprio(0); } while (0)
#define PG8_WAIT_V(n) asm volatile("s_waitcnt vmcnt(" #n ")" ::: "memory")
#define PG8_WAIT_L(n) asm volatile("s_waitcnt lgkmcnt(" #n ")" ::: "memory")
#define PG8_BAR __builtin_amdgcn_s_barrier()
#define PG8_SCHED __builtin_amdgcn_sched_barrier(0)
    Unit cur, nxt; int ui = 0;
    if (!S.next(0, cur)) return;
    f32x4 acc[2][2][4][2];
#pragma unroll
    for (int a = 0; a < 2; ++a)
#pragma unroll
        for (int b = 0; b < 2; ++b)
#pragma unroll
            for (int m = 0; m < 4; ++m)
#pragma unroll
                for (int n = 0; n < 2; ++n) acc[a][b][m][n] = (f32x4){0.f, 0.f, 0.f, 0.f};
    bf16x8 At[4][2], B0[2][2], B1[2][2];
    const char* cA = (const char*)g.A + (size_t)cur.pm * tstep; const char* cB = (const char*)g.Bt + (size_t)cur.pn * tstep;
    S.a_ready(cur);
    if constexpr (SP2) {
        PG8_STAGE(PG8_SB(0, 0), cB, voffB); PG8_STAGE(PG8_SB(0, 1), cB + hstep, voffB); PG8_STAGE(PG8_SA(0, 0), cA, voffA); PG8_STAGE(PG8_SA(0, 1), cA + hstep, voffA);
        if (wr == 1) PG8_BAR;
        PG8_WAIT_V(2); PG8_BAR;
        PG8_STAGE(PG8_SB(1, 0), cB + kstep, voffB); PG8_STAGE(PG8_SA(1, 0), cA + kstep, voffA); PG8_STAGE(PG8_SB(1, 1), cB + hstep + kstep, voffB);
        PG8_WAIT_V(6); PG8_BAR;
    } else {
        PG8_STAGE(PG8_SB(0, 0), cB, voffB); PG8_STAGE(PG8_SA(0, 0), cA, voffA); PG8_STAGE(PG8_SB(0, 1), cB + hstep, voffB); PG8_STAGE(PG8_SA(0, 1), cA + hstep, voffA);
        if (wr == 1) PG8_BAR;
        PG8_WAIT_V(4); PG8_BAR;
        PG8_STAGE(PG8_SB(1, 0), cB + kstep, voffB); PG8_STAGE(PG8_SA(1, 0), cA + kstep, voffA); PG8_STAGE(PG8_SB(1, 1), cB + hstep + kstep, voffB);
        PG8_WAIT_V(6); PG8_BAR;
    }
    for (;;) {
        const bool has_next = S.next(ui + 1, nxt);
        const char* nA = has_next ? (const char*)g.A + (size_t)nxt.pm * tstep : cA; const char* nB = has_next ? (const char*)g.Bt + (size_t)nxt.pn * tstep : cB;
        for (int t = 0; t < nt; t += 2) {
            const bool last = (t == nt - 2);
            const char* a1 = cA + (size_t)(t + 1) * kstep;
            const char* a2 = last ? nA : cA + (size_t)(t + 2) * kstep; const char* b2 = last ? nB : cB + (size_t)(t + 2) * kstep;
            const char* a3 = a2 + kstep; const char* b3 = b2 + kstep;
            if (last && has_next) S.a_ready(nxt);
            if constexpr (SP2) {
            PG8_LDB(B0, 0, 0); PG8_LDB(B1, 0, 1); PG8_SCHED; PG8_LDA(At, 0, 0); PG8_STAGE(PG8_SA(1, 1), a1 + hstep, voffA);
            PG8_WAIT_V(8); PG8_WAIT_L(0); PG8_BAR; PG8_MMA(0, 0, At, B0); PG8_MMA(0, 1, At, B1); PG8_BAR; PG8_SCHED;
            PG8_LDA(At, 0, 1); PG8_STAGE(PG8_SB(0, 0), b2, voffB); PG8_STAGE(PG8_SB(0, 1), b2 + hstep, voffB); PG8_STAGE(PG8_SA(0, 0), a2, voffA);
            PG8_WAIT_V(8); PG8_WAIT_L(0); PG8_BAR; PG8_MMA(1, 0, At, B0); PG8_MMA(1, 1, At, B1); PG8_BAR; PG8_SCHED;
            PG8_LDB(B0, 1, 0); PG8_LDB(B1, 1, 1); PG8_SCHED; PG8_LDA(At, 1, 0); PG8_STAGE(PG8_SA(0, 1), a2 + hstep, voffA);
            PG8_WAIT_V(8); PG8_WAIT_L(0); PG8_BAR; PG8_MMA(0, 0, At, B0); PG8_MMA(0, 1, At, B1); PG8_BAR; PG8_SCHED;
            PG8_LDA(At, 1, 1); PG8_STAGE(PG8_SB(1, 0), b3, voffB); PG8_STAGE(PG8_SB(1, 1), b3 + hstep, voffB); PG8_STAGE(PG8_SA(1, 0), a3, voffA);
            PG8_WAIT_V(8); PG8_WAIT_L(0); PG8_BAR; PG8_MMA(1, 0, At, B0); PG8_MMA(1, 1, At, B1); PG8_BAR; PG8_SCHED;
            } else {
            PG8_LDB(B0, 0, 0); PG8_SCHED; PG8_LDA(At, 0, 0); PG8_STAGE(PG8_SA(1, 1), a1 + hstep, voffA);
            PG8_WAIT_L(8); PG8_BAR; PG8_WAIT_L(0); PG8_MMA(0, 0, At, B0); PG8_BAR; PG8_SCHED;
            PG8_LDB(B1, 0, 1); PG8_STAGE(PG8_SB(0, 0), b2, voffB);
            PG8_BAR; PG8_WAIT_L(0); PG8_MMA(0, 1, At, B1); PG8_BAR;
            PG8_LDA(At, 0, 1); PG8_STAGE(PG8_SA(0, 0), a2, voffA);
            PG8_BAR; PG8_WAIT_L(0); PG8_MMA(1, 0, At, B0); PG8_BAR; PG8_SCHED;
            PG8_STAGE(PG8_SB(0, 1), b2 + hstep, voffB);
            PG8_WAIT_V(6); PG8_BAR; PG8_MMA(1, 1, At, B1); PG8_BAR;
            PG8_LDB(B0, 1, 0); PG8_SCHED; PG8_LDA(At, 1, 0); PG8_STAGE(PG8_SA(0, 1), a2 + hstep, voffA);
            PG8_WAIT_L(8); PG8_BAR; PG8_WAIT_L(0); PG8_MMA(0, 0, At, B0); PG8_BAR; PG8_SCHED;
            PG8_LDB(B1, 1, 1); PG8_STAGE(PG8_SB(1, 0), b3, voffB);
            PG8_BAR; PG8_WAIT_L(0); PG8_MMA(0, 1, At, B1); PG8_BAR;
            PG8_LDA(At, 1, 1); PG8_STAGE(PG8_SA(1, 0), a3, voffA);
            PG8_BAR; PG8_WAIT_L(0); PG8_MMA(1, 0, At, B0); PG8_BAR; PG8_SCHED;
            PG8_STAGE(PG8_SB(1, 1), b3 + hstep, voffB);
            PG8_WAIT_V(6); PG8_BAR; PG8_MMA(1, 1, At, B1); PG8_BAR;
            }
        }
        if constexpr (ALIGN_EPI) { if (wr == 0) PG8_BAR; }
        if constexpr (!Epi::AFTER_DRAIN) { E(acc, cur, wr, wc, fr, fq); S.done(cur); }
        if (!has_next) break;
#pragma unroll
        for (int a = 0; a < 2; ++a)
#pragma unroll
            for (int b = 0; b < 2; ++b)
#pragma unroll
                for (int m = 0; m < 4; ++m)
#pragma unroll
                    for (int n = 0; n < 2; ++n) acc[a][b][m][n] = (f32x4){0.f, 0.f, 0.f, 0.f};
        cur = nxt; cA = nA; cB = nB; ++ui;
        if constexpr (ALIGN_EPI) { if (wr == 1) PG8_BAR; }
    }
    PG8_WAIT_V(0);
    if constexpr (!ALIGN_EPI) { if (wr == 0) PG8_BAR; }
    PG8_BAR;
    if constexpr (Epi::AFTER_DRAIN) { E.fused(acc, cur, wr, wc, fr, fq, lds, wid, lane); S.done(cur); }
#undef PG8_SA
#undef PG8_SB
#undef PG8_STAGE
#undef PG8_LDA
#undef PG8_LDB
#undef PG8_MMA
#undef PG8_WAIT_V
#undef PG8_WAIT_L
#undef PG8_BAR
#undef PG8_SCHED
}
}
#define LAS __attribute__((address_space(3)))
typedef unsigned short bf16;
typedef _Float16 f16;
typedef float f32x4 __attribute__((ext_vector_type(4)));
typedef short bf16x8 __attribute__((ext_vector_type(8)));
typedef short s16x4 __attribute__((ext_vector_type(4)));
typedef unsigned u32x4 __attribute__((ext_vector_type(4)));
typedef unsigned u32x2 __attribute__((ext_vector_type(2)));
typedef _Float16 h2 __attribute__((ext_vector_type(2)));

#ifndef MK_ONE_LAUNCH
#define MK_ONE_LAUNCH 1
#endif

constexpr int NPROMPT = 8 * 4096, NSAMP = 32 * 64, M = NPROMPT + NSAMP;
constexpr int DM = 1024, SHW = 3328, DFF = 2816;
constexpr size_t MiB = 1u << 20;
constexpr size_t U = (size_t)M * 1024 * 2;
constexpr size_t WS_WIN = 1 * MiB;
constexpr size_t WS_WA = WS_WIN + (size_t)7424 * 1024 * 2;
constexpr size_t WS_WB = WS_WA + (size_t)1024 * 1024 * 2;
constexpr size_t WS_WO = WS_WB + (size_t)1024 * 1024 * 2;
constexpr size_t WS_GU = WS_WO + (size_t)1024 * 1024 * 2;
constexpr size_t WS_WD = WS_GU + (size_t)5632 * 1024 * 2;
constexpr size_t WS_LORA = WS_WD + (size_t)1024 * 2816 * 2;
constexpr size_t WS_WSP = WS_LORA + (size_t)3072 * 256 * 2;
constexpr size_t WS_R0 = 40 * MiB;
static_assert(WS_WSP + 8 * 128 * 128 * 2 <= WS_R0, "weights fit below R0");
constexpr size_t WS_XN = WS_R0;
constexpr size_t WS_WL = WS_R0;
constexpr size_t WS_PS = WS_R0 + U;
constexpr size_t WS_AR = WS_R0 + U * 17 / 4;
constexpr size_t WS_G = WS_R0 + U * 21 / 4;
constexpr size_t WS_LX = WS_R0 + U * 25 / 4;
constexpr size_t WS_END0 = WS_R0 + U * 26 / 4;
#ifndef P1E_HOST
#define P1E_HOST P1E_ROWS
#endif
constexpr int P1E_RB = 40, P1E_ROWS = P1E_RB * 256;
constexpr size_t P1E_STRIDE = (size_t)P1E_ROWS * 1024;
constexpr size_t WS_P4E3 = WS_END0;
constexpr size_t WS_END = WS_P4E3 + P1E_STRIDE * 2;
static_assert(3 * P1E_STRIDE * 2 <= U, "early PU|PV|GA fit in half of the y region");
constexpr size_t WS_XN2 = WS_R0;
constexpr size_t WS_P4 = WS_R0 + U;
constexpr size_t WS_OA = WS_G;
constexpr size_t WS_OB = WS_R0;
constexpr size_t WS_MM = WS_R0 + U;
constexpr size_t WS_MO = WS_R0 + 2 * U;
constexpr size_t WS_F = WS_R0;
constexpr size_t WS_H = WS_R0 + U;
constexpr size_t WS_F2 = WS_R0 + 4 * U;
constexpr size_t OUT_Y = 0;
constexpr size_t OUT_SHIFT_P = (size_t)M * 1024;
constexpr size_t OUT_WKV_P = OUT_SHIFT_P + 8 * 3328;
constexpr size_t OUT_SHIFT_S = OUT_WKV_P + (size_t)8 * 16 * 4096;
constexpr size_t OUT_WKV_S = OUT_SHIFT_S + 32 * 3328;
constexpr size_t OUT_VS = OUT_WKV_S + (size_t)32 * 16 * 4096;
constexpr size_t OUT_END = OUT_VS + (size_t)32 * 64 * 1024;
static_assert(OUT_END == 40503296, "output size");

constexpr int LDS_BYTES = 163840;
constexpr int NPHASE = 15;

struct Args { const float* in[30]; float* out; unsigned char* ws; int ph_lo, ph_hi, p1e; };

__device__ __forceinline__ float bf_lo(unsigned u) { return __uint_as_float(u << 16); }
__device__ __forceinline__ float bf_hi(unsigned u) { return __uint_as_float(u & 0xffff0000u); }
__device__ __forceinline__ f32x4 dec4bf(u32x2 u) { return (f32x4){bf_lo(u.x), bf_hi(u.x), bf_lo(u.y), bf_hi(u.y)}; }
__device__ __forceinline__ unsigned pkbf(float lo, float hi) { return pg8::cvt_pk_bf16(lo, hi); }
__device__ __forceinline__ u32x2 pk4bf(f32x4 v) { u32x2 r; r.x = pkbf(v[0], v[1]); r.y = pkbf(v[2], v[3]); return r; }
__device__ __forceinline__ unsigned pkh(float lo, float hi) { h2 h; h.x = (f16)lo; h.y = (f16)hi; return __builtin_bit_cast(unsigned, h); }
__device__ __forceinline__ u32x2 pk4h(f32x4 v) { u32x2 r; r.x = pkh(v[0], v[1]); r.y = pkh(v[2], v[3]); return r; }
__device__ __forceinline__ h2 as_h2(unsigned u) { return __builtin_bit_cast(h2, u); }
__device__ __forceinline__ f32x4 dec4h(u32x2 u) { const h2 a = as_h2(u.x), b = as_h2(u.y); return (f32x4){(float)a.x, (float)a.y, (float)b.x, (float)b.y}; }
__device__ __forceinline__ float sigm(float x) { return __builtin_amdgcn_rcpf(1.f + __expf(-x)); }
__device__ __forceinline__ float wave_sum(float v) {
#pragma unroll
    for (int o = 1; o < 64; o <<= 1) v += __shfl_xor(v, o);
    return v;
}
template <int CTRL> __device__ __forceinline__ float dppf(float x) { return __int_as_float(__builtin_amdgcn_update_dpp(0, __float_as_int(x), CTRL, 0xF, 0xF, false)); }
__device__ __forceinline__ float row_sum16(float x) { x += dppf<0x128>(x); x += dppf<0x124>(x); x += dppf<0x122>(x); x += dppf<0x121>(x); return x; }
__device__ __forceinline__ float quad_sum(float x) { x += dppf<0xB1>(x); x += dppf<0x4E>(x); return x; }
__device__ __forceinline__ const float* xrow_ptr(const Args& a, int m) { return m < NPROMPT ? a.in[0] + (size_t)m * 1024 : a.in[1] + (size_t)(m - NPROMPT) * 1024; }

template <class F> struct Epi8 {
    static constexpr bool PERM = true, AFTER_DRAIN = false; F f;
    __device__ __forceinline__ void operator()(const f32x4 (&acc)[2][2][4][2], const pg8::Unit& u, int wr, int wc, int fr, int fq) const {
        const int row0 = u.pm * 256 + wr * 64 + fr, col0 = u.pn * 256 + wc * 32 + 8 * fq;
#pragma unroll
        for (int ai = 0; ai < 2; ++ai)
#pragma unroll
            for (int m = 0; m < 4; ++m)
#pragma unroll
                for (int bj = 0; bj < 2; ++bj) f(row0 + ai * 128 + m * 16, col0 + bj * 128, acc[ai][bj][m][0], acc[ai][bj][m][1]);
    }
};
template <class F> struct Epi4 {
    static constexpr bool PERM = false, AFTER_DRAIN = false; F f;
    __device__ __forceinline__ void operator()(const f32x4 (&acc)[2][2][4][2], const pg8::Unit& u, int wr, int wc, int fr, int fq) const {
        const int row0 = u.pm * 256 + wr * 64 + fr, col0 = u.pn * 256 + wc * 32 + 4 * fq;
#pragma unroll
        for (int ai = 0; ai < 2; ++ai)
#pragma unroll
            for (int m = 0; m < 4; ++m)
#pragma unroll
                for (int bj = 0; bj < 2; ++bj)
#pragma unroll
                    for (int n = 0; n < 2; ++n) f(row0 + ai * 128 + m * 16, col0 + bj * 128 + n * 16, acc[ai][bj][m][n]);
    }
};
__device__ __forceinline__ u32x4 pk8bf(f32x4 a, f32x4 b) { u32x4 w; w.x = pkbf(a[0], a[1]); w.y = pkbf(a[2], a[3]); w.z = pkbf(b[0], b[1]); w.w = pkbf(b[2], b[3]); return w; }
__device__ __forceinline__ u32x4 pk8h(f32x4 a, f32x4 b) { u32x4 w; w.x = pkh(a[0], a[1]); w.y = pkh(a[2], a[3]); w.z = pkh(b[0], b[1]); w.w = pkh(b[2], b[3]); return w; }
__device__ __forceinline__ void dec8bf(u32x4 w, f32x4& a, f32x4& b) { a = (f32x4){bf_lo(w.x), bf_hi(w.x), bf_lo(w.y), bf_hi(w.y)}; b = (f32x4){bf_lo(w.z), bf_hi(w.z), bf_lo(w.w), bf_hi(w.w)}; }

struct FStoreBf16 { bf16* O; int ldc;
    __device__ __forceinline__ void operator()(int r, int c, f32x4 v0, f32x4 v1) const { *(u32x4*)(O + (size_t)r * ldc + c) = pk8bf(v0, v1); } };
struct FStoreF32 { float* O; int ldc;
    __device__ __forceinline__ void operator()(int r, int c, f32x4 v) const { *(f32x4*)(O + (size_t)r * ldc + c) = v; } };
struct FLora { f16* WL; f16* AR; f16* G; const float* w0; const float* a0;
    __device__ __forceinline__ void operator()(int r, int c, f32x4 v0, f32x4 v1) const {
        const int t = c >> 10, cc = c & 1023;
        if (t == 0) { const f32x4 b0 = *(const f32x4*)(w0 + cc), b1 = *(const f32x4*)(w0 + cc + 4);
#pragma unroll
            for (int i = 0; i < 4; ++i) { v0[i] = -0.87503878f * sigm(v0[i] + b0[i]); v1[i] = -0.87503878f * sigm(v1[i] + b1[i]); }
            *(u32x4*)(WL + (size_t)r * 1024 + cc) = pk8h(v0, v1); }
        else if (t == 1) { const f32x4 b0 = *(const f32x4*)(a0 + cc), b1 = *(const f32x4*)(a0 + cc + 4);
#pragma unroll
            for (int i = 0; i < 4; ++i) { v0[i] = sigm(v0[i] + b0[i]); v1[i] = sigm(v1[i] + b1[i]); }
            *(u32x4*)(AR + (size_t)r * 1024 + cc) = pk8h(v0, v1); }
        else *(u32x4*)(G + (size_t)r * 1024 + cc) = pk8h(v0, v1);
    } };
struct FP1b { bf16* base;
    __device__ __forceinline__ void operator()(int r, int c, f32x4 v0, f32x4 v1) const {
        const int t = c >> 10, cc = c & 1023;
        if (t >= 2) {
#pragma unroll
            for (int i = 0; i < 4; ++i) { v0[i] = sigm(v0[i]); v1[i] = sigm(v1[i]); } }
        *(u32x4*)(base + (size_t)t * (U / 2) + (size_t)r * 1024 + cc) = pk8bf(v0, v1);
    } };
struct FGateA { const bf16* GA; const bf16* GAe; int p1e; bf16* M1;
    __device__ __forceinline__ void operator()(int r, int c, f32x4 v0, f32x4 v1) const {
        const size_t o = (size_t)r * 1024 + c; f32x4 g0, g1; dec8bf(*(const u32x4*)((r < p1e ? GAe : GA) + o), g0, g1);
        *(u32x4*)(M1 + o) = pk8bf(v0 * g0, v1 * g1);
    } };
struct FGateB { const bf16* GB; const bf16* GBe; int p1e; bf16* MMp;
    __device__ __forceinline__ void operator()(int r, int c, f32x4 v0, f32x4 v1) const {
        const size_t o = (size_t)r * 1024 + c; f32x4 g0, g1, m0, m1; dec8bf(*(const u32x4*)((r < p1e ? GBe : GB) + o), g0, g1); dec8bf(*(const u32x4*)(MMp + o), m0, m1);
        *(u32x4*)(MMp + o) = pk8bf(m0 + v0 * g0, m1 + v1 * g1);
    } };
__device__ __forceinline__ float fq_sum(float x) {
    const unsigned u = __float_as_uint(x); const auto r = __builtin_amdgcn_permlane16_swap(u, u, false, false);
    const float y = __uint_as_float(r[0]) + __uint_as_float(r[1]);
    const unsigned v = __float_as_uint(y); const auto r2 = __builtin_amdgcn_permlane32_swap(v, v, false, false);
    return __uint_as_float(r2[0]) + __uint_as_float(r2[1]);
}
struct EpiP1b {
    static constexpr bool PERM = true, AFTER_DRAIN = false; bf16* base; bf16* base3; size_t tstride; float* lnp;
    __device__ __forceinline__ void operator()(const f32x4 (&acc)[2][2][4][2], const pg8::Unit& u, int wr, int wc, int fr, int fq) const {
        const int row0 = u.pm * 256 + wr * 64 + fr, t = u.pn >> 2, pnl = u.pn & 3, col0 = pnl * 256 + wc * 32 + 8 * fq;
        bf16* dst = t == 3 ? base3 : base + (size_t)t * tstride;
#pragma unroll
        for (int ai = 0; ai < 2; ++ai)
#pragma unroll
            for (int m = 0; m < 4; ++m) {
                const int row = row0 + ai * 128 + m * 16; float s = 0.f, s2 = 0.f;
#pragma unroll
                for (int bj = 0; bj < 2; ++bj) {
                    f32x4 v0 = acc[ai][bj][m][0], v1 = acc[ai][bj][m][1];
                    if (t >= 2) {
#pragma unroll
                        for (int i = 0; i < 4; ++i) { v0[i] = sigm(v0[i]); v1[i] = sigm(v1[i]); } }
                    if (t == 1) {
#pragma unroll
                        for (int i = 0; i < 4; ++i) { s += v0[i] + v1[i]; s2 += v0[i] * v0[i] + v1[i] * v1[i]; } }
                    *(u32x4*)(dst + (size_t)row * 1024 + col0 + bj * 128) = pk8bf(v0, v1);
                }
                if (t == 1) {
                    s = fq_sum(s); s2 = fq_sum(s2);
                    if (fq == 0) *(float2*)(lnp + (size_t)row * 32 + 2 * (4 * pnl + wc)) = make_float2(s, s2);
                }
            }
    }
};
struct EpiGU {
    static constexpr bool PERM = true, AFTER_DRAIN = false; bf16* H;
    __device__ __forceinline__ void operator()(const f32x4 (&acc)[2][2][4][2], const pg8::Unit& u, int wr, int wc, int fr, int fq) const {
        const int row0 = u.pm * 256 + wr * 64 + fr, h0 = u.pn * 128 + wc * 32 + 8 * fq;
#pragma unroll
        for (int ai = 0; ai < 2; ++ai)
#pragma unroll
            for (int m = 0; m < 4; ++m) {
                f32x4 o0, o1;
#pragma unroll
                for (int i = 0; i < 4; ++i) { const float g0 = acc[ai][0][m][0][i], g1 = acc[ai][1][m][0][i];
                    o0[i] = g0 * sigm(g0) * acc[ai][0][m][1][i]; o1[i] = g1 * sigm(g1) * acc[ai][1][m][1][i]; }
                *(u32x4*)(H + (size_t)(row0 + ai * 128 + m * 16) * DFF + h0) = pk8bf(o0, o1);
            }
    }
};


struct RoundOrder {
    int round, c;
    __device__ __forceinline__ bool next(int i, pg8::Unit& u) const {
        if (i > 0 || c >= 256) return false;
        const int pm = round * 64 + (c >> 5) * 8 + (c & 7); if (pm >= M / 256) return false;
        u.pm = pm; u.pn = (c >> 3) & 3; return true; }
    __device__ __forceinline__ void a_ready(const pg8::Unit&) const {}
    __device__ __forceinline__ void done(const pg8::Unit&) const {}
};
constexpr int CW_RS = 4096, CW_RS_BANK = (M / 256) * 64;
constexpr size_t RS_SLOT_BANK = (size_t)M * 4 * 4;
constexpr size_t RS_GRAN_OFF = 8 * MiB, RS_GRAN_BANK = (size_t)M * 4 * 8;
constexpr unsigned RS_TAG = 0x5EED0001u;
struct RowStat {
    unsigned long long* gran; unsigned* tmo;
    __device__ __forceinline__ void run(const f32x4 (&v)[2][2][4][2], const pg8::Unit& u, int wr, int wc, int fr, int fq, LAS unsigned char* lds, int wid, int lane) const {
        LAS float* P = (LAS float*)lds; LAS float* S = (LAS float*)(lds + 4096);
#pragma unroll
        for (int ai = 0; ai < 2; ++ai)
#pragma unroll
            for (int m = 0; m < 4; ++m) {
                float q = 0.f;
#pragma unroll
                for (int bj = 0; bj < 2; ++bj)
#pragma unroll
                    for (int n = 0; n < 2; ++n) { const f32x4 x = v[ai][bj][m][n]; q += (x[0] * x[0] + x[1] * x[1]) + (x[2] * x[2] + x[3] * x[3]); }
                q = fq_sum(q);
                if (fq == 0) P[(ai * 128 + wr * 64 + m * 16 + fr) * 4 + wc] = q;
            }
        asm volatile("s_waitcnt lgkmcnt(0)" ::: "memory"); __builtin_amdgcn_s_barrier(); asm volatile("" ::: "memory");
        const int row = wid * 32 + (lane & 31);
        if (lane < 32) { const f32x4 p = *(const LAS f32x4*)(P + row * 4);
            const float mine = (p[0] + p[1]) + (p[2] + p[3]);
            unsigned long long* g = gran + (size_t)(u.pm * 256 + row) * 4;
            __hip_atomic_store(g + u.pn, ((unsigned long long)RS_TAG << 32) | (unsigned long long)__float_as_uint(mine), __ATOMIC_RELAXED, __HIP_MEMORY_SCOPE_AGENT);
            float t = 0.f; unsigned spins = 0;
            for (;;) {
                const unsigned long long g0 = __hip_atomic_load(g + 0, __ATOMIC_RELAXED, __HIP_MEMORY_SCOPE_AGENT), g1 = __hip_atomic_load(g + 1, __ATOMIC_RELAXED, __HIP_MEMORY_SCOPE_AGENT),
                                         g2 = __hip_atomic_load(g + 2, __ATOMIC_RELAXED, __HIP_MEMORY_SCOPE_AGENT), g3 = __hip_atomic_load(g + 3, __ATOMIC_RELAXED, __HIP_MEMORY_SCOPE_AGENT);
                const bool ok = (unsigned)(g0 >> 32) == RS_TAG && (unsigned)(g1 >> 32) == RS_TAG && (unsigned)(g2 >> 32) == RS_TAG && (unsigned)(g3 >> 32) == RS_TAG;
                t = (__uint_as_float((unsigned)g0) + __uint_as_float((unsigned)g1)) + (__uint_as_float((unsigned)g2) + __uint_as_float((unsigned)g3));
                if (__all(ok) || ++spins > (1u << 20)) break;
                __builtin_amdgcn_s_sleep(1);
            }
            S[row] = t; }
        asm volatile("s_waitcnt lgkmcnt(0)" ::: "memory"); __builtin_amdgcn_s_barrier(); asm volatile("" ::: "memory");
    }
};
struct EpiMix {
    static constexpr bool PERM = false, AFTER_DRAIN = true;
    const float* xp; const float* xs; float* out; bf16* F; const float* g1; const float* g2; RowStat st1, st2;
    __device__ __forceinline__ void fused(f32x4 (&acc)[2][2][4][2], const pg8::Unit& u, int wr, int wc, int fr, int fq, LAS unsigned char* lds, int wid, int lane) const {
        const LAS float* S = (const LAS float*)(lds + 4096);
        const int col0 = u.pn * 256 + wc * 32 + 4 * fq;
        st1.run(acc, u, wr, wc, fr, fq, lds, wid, lane);
#pragma unroll
        for (int ai = 0; ai < 2; ++ai)
#pragma unroll
            for (int m = 0; m < 4; ++m) { const int r = ai * 128 + wr * 64 + m * 16 + fr, row = u.pm * 256 + r; const float rs = rsqrtf(S[r] * (1.f / 1024.f) + 1e-6f);
                const float* xrow = row < NPROMPT ? xp + (size_t)row * 1024 : xs + (size_t)(row - NPROMPT) * 1024;
#pragma unroll
                for (int bj = 0; bj < 2; ++bj)
#pragma unroll
                    for (int n = 0; n < 2; ++n) { const int c = col0 + bj * 128 + n * 16; const f32x4 xv = *(const f32x4*)(xrow + c), g = *(const f32x4*)(g1 + c);
                        acc[ai][bj][m][n] = xv + acc[ai][bj][m][n] * rs * g; }
                asm volatile("" : "+v"(acc[ai][0][m][0]), "+v"(acc[ai][0][m][1]), "+v"(acc[ai][1][m][0]), "+v"(acc[ai][1][m][1]));
                if (m & 1) asm volatile("" ::: "memory"); }
        st2.run(acc, u, wr, wc, fr, fq, lds, wid, lane);
#pragma unroll
        for (int ai = 0; ai < 2; ++ai)
#pragma unroll
            for (int m = 0; m < 4; ++m) { const int r = ai * 128 + wr * 64 + m * 16 + fr, row = u.pm * 256 + r; const float rs = rsqrtf(S[r] * (1.f / 1024.f) + 1e-6f);
#pragma unroll
                for (int bj = 0; bj < 2; ++bj)
#pragma unroll
                    for (int n = 0; n < 2; ++n) { const int c = col0 + bj * 128 + n * 16; const f32x4 g = *(const f32x4*)(g2 + c);
                        *(f32x4*)(out + (size_t)row * 1024 + c) = acc[ai][bj][m][n]; *(u32x2*)(F + (size_t)row * 1024 + c) = pk4bf(acc[ai][bj][m][n] * rs * g); }
                asm volatile("" ::: "memory"); }
    }
};
struct EpiFfn {
    static constexpr bool PERM = false, AFTER_DRAIN = true;
    float* out; const float* g3; RowStat st;
    __device__ __forceinline__ void fused(f32x4 (&acc)[2][2][4][2], const pg8::Unit& u, int wr, int wc, int fr, int fq, LAS unsigned char* lds, int wid, int lane) const {
        const LAS float* S = (const LAS float*)(lds + 4096);
        const int col0 = u.pn * 256 + wc * 32 + 4 * fq;
        st.run(acc, u, wr, wc, fr, fq, lds, wid, lane);
#pragma unroll
        for (int ai = 0; ai < 2; ++ai)
#pragma unroll
            for (int m = 0; m < 4; ++m) { const int r = ai * 128 + wr * 64 + m * 16 + fr, row = u.pm * 256 + r; const float rs = rsqrtf(S[r] * (1.f / 1024.f) + 1e-6f);
                float* orow = out + (size_t)row * 1024;
#pragma unroll
                for (int bj = 0; bj < 2; ++bj)
#pragma unroll
                    for (int n = 0; n < 2; ++n) { const int c = col0 + bj * 128 + n * 16; const f32x4 xv = *(const f32x4*)(orow + c), g = *(const f32x4*)(g3 + c);
                        *(f32x4*)(orow + c) = xv + acc[ai][bj][m][n] * rs * g; }
                if (m & 1) asm volatile("" ::: "memory"); }
    }
};
#define LDS_BAR() do { asm volatile("s_waitcnt lgkmcnt(0)" ::: "memory"); __builtin_amdgcn_s_barrier(); asm volatile("" ::: "memory"); } while (0)
template <class E> __device__ __forceinline__ void run_gemm_rounds(LAS unsigned char* lds, const bf16* A, const bf16* Bt, int K, const E& e) {
    pg8::Gemm g{A, Bt, M, 1024, K};
#pragma unroll 1
    for (int r = 0; r < 3; ++r) { RoundOrder S{r, (int)blockIdx.x}; pg8::gemm_phase<E, RoundOrder, false, true>(lds, g, S, e);
        LDS_BAR(); }
}

#define PH_PROLOG int tid_o = threadIdx.x; asm volatile("" : "+v"(tid_o));   const int tid = tid_o, lane = tid & 63, wave = __builtin_amdgcn_readfirstlane(tid >> 6); const int G = gridDim.x, bid = blockIdx.x; const int gw = bid * 8 + wave, NGW = G * 8; (void)lane; (void)gw; (void)NGW; (void)lds;

__device__ __forceinline__ float conv_src(const Args& a, int mat, int R, int k) {
    switch (mat) {
    case 0: return a.in[5][(size_t)k * 7424 + R];
    case 1: return a.in[21][(size_t)k * 1024 + R];
    case 2: return a.in[22][(size_t)k * 1024 + R];
    case 3: return a.in[23][(size_t)k * 1024 + R];
    case 4: { const int cl = R & 255, pn = R >> 8, bj = (cl >> 7) & 1, wc = (cl >> 5) & 3, fq = (cl >> 3) & 3, n = (cl >> 2) & 1, e = cl & 3;
              const int hcol = 128 * pn + 32 * wc + 8 * fq + 4 * bj + e; return (n ? a.in[27] : a.in[26])[(size_t)k * DFF + hcol]; }
    case 5: return a.in[28][(size_t)k * 1024 + R];
    case 6: { if (R < 1024) return k < 64 ? a.in[8][k * 1024 + R] : 0.f;
              if (R < 2048) return (k >= 64 && k < 128) ? a.in[10][(k - 64) * 1024 + R - 1024] : 0.f;
              return k >= 128 ? a.in[11][(k - 128) * 1024 + R - 2048] : 0.f; }
    default: { const int t = R & 127; return k <= t ? a.in[19][(size_t)R * 128 + k] : 0.f; }
    }
}
__device__ __forceinline__ void rms_row_to_bf16(const float* xrow, const float* gain, bf16* orow, int lane) {
    f32x4 v[4]; float ss = 0.f;
#pragma unroll
    for (int j = 0; j < 4; ++j) { v[j] = ((const f32x4*)xrow)[lane + 64 * j]; ss += (v[j][0] * v[j][0] + v[j][1] * v[j][1]) + (v[j][2] * v[j][2] + v[j][3] * v[j][3]); }
    const float rs = rsqrtf(wave_sum(ss) * (1.f / 1024.f) + 1e-6f);
#pragma unroll
    for (int j = 0; j < 4; ++j) { const f32x4 g = ((const f32x4*)gain)[lane + 64 * j]; ((u32x2*)orow)[lane + 64 * j] = pk4bf(v[j] * rs * g); }
}
constexpr int CV_MAT[8] = {0, 6, 1, 2, 3, 4, 5, 7};
constexpr int CV_NIT[8] = {928 * 16, 384 * 4, 128 * 16, 128 * 16, 128 * 16, 704 * 16, 128 * 44, 128 * 2};
constexpr int CV_KD[8] = {1024, 256, 1024, 1024, 1024, 1024, 2816, 128};
constexpr size_t CV_DST[8] = {WS_WIN, WS_LORA, WS_WA, WS_WB, WS_WO, WS_GU, WS_WD, WS_WSP};
constexpr int CV_EARLY = CV_NIT[0] + CV_NIT[1], CV_ALL = CV_EARLY + CV_NIT[2] + CV_NIT[3] + CV_NIT[4] + CV_NIT[5] + CV_NIT[6] + CV_NIT[7];
__device__ __forceinline__ void conv_items(const Args& a, int lo, int hi, int worker, int nworkers, int lane) {
    for (int it = lo + worker; it < hi; it += nworkers) {
        int r = it, mi = 0;
#pragma unroll
        for (int q = 0; q < 7; ++q) { if (mi == q && r >= CV_NIT[q]) { r -= CV_NIT[q]; mi = q + 1; } }
        int Kd = 1024, mat = 0; size_t dst = WS_WIN;
#pragma unroll
        for (int q = 0; q < 8; ++q) if (mi == q) { Kd = CV_KD[q]; dst = CV_DST[q]; mat = CV_MAT[q]; }
        const int kbn = Kd >> 6, rb = r / kbn, kb = r - rb * kbn;
        const int R = rb * 8 + (lane >> 3), k0 = kb * 64 + (lane & 7) * 8;
        float s[8];
#pragma unroll
        for (int j = 0; j < 8; ++j) s[j] = conv_src(a, mat, R, k0 + j);
        u32x4 w; w.x = pkbf(s[0], s[1]); w.y = pkbf(s[2], s[3]); w.z = pkbf(s[4], s[5]); w.w = pkbf(s[6], s[7]);
        *(u32x4*)(a.ws + dst + ((size_t)R * Kd + k0) * 2) = w;
    }
}
__device__ __forceinline__ void phase_p0(const Args& a, LAS unsigned char* lds) {
    PH_PROLOG
    conv_items(a, 0, G > 128 ? CV_EARLY : CV_ALL, gw, NGW, lane);
    bf16* XN = (bf16*)(a.ws + WS_XN);
    for (int m = gw; m < M; m += NGW) rms_row_to_bf16(xrow_ptr(a, m), a.in[4], XN + (size_t)m * 1024, lane);
}

__device__ __forceinline__ void phase_p2a(const Args& a, LAS unsigned char* lds) {
    PH_PROLOG
    const bf16* PS = (const bf16*)(a.ws + WS_PS); bf16* LX = (bf16*)(a.ws + WS_LX);
    const f32x4 mu = *(const f32x4*)(a.in[6] + 3072 + 4 * lane);
    for (int m = gw; m < M; m += NGW) {
        const bool samp = m >= NPROMPT; const int t = samp ? ((m - NPROMPT) & 63) : (m & 4095);
        const f32x4 p = dec4bf(*(const u32x2*)(PS + (size_t)m * SHW + 3072 + 4 * lane));
        f32x4 pp = (f32x4){0.f, 0.f, 0.f, 0.f};
        if (t > 0) pp = dec4bf(*(const u32x2*)(PS + (size_t)(m - 1) * SHW + 3072 + 4 * lane));
        else if (samp) pp = *(const f32x4*)(a.in[2] + (size_t)((m - NPROMPT) >> 6) * SHW + 3072 + 4 * lane);
        f32x4 x = p + (pp - p) * mu;
        if (lane < 16) {
#pragma unroll
            for (int i = 0; i < 4; ++i) x[i] = 1.f - 2.f * __builtin_amdgcn_rcpf(__expf(2.f * x[i]) + 1.f); }
        else if (lane >= 32) {
#pragma unroll
            for (int i = 0; i < 4; ++i) x[i] = sigm(x[i]); }
        *(u32x2*)(LX + (size_t)m * 256 + 4 * lane) = pk4bf(x);
    }
    if (gw < 40) {
        const int row = gw < 8 ? gw * 4096 + 4095 : NPROMPT + (gw - 8) * 64 + 63;
        float* dst = a.out + (gw < 8 ? OUT_SHIFT_P + (size_t)gw * SHW : OUT_SHIFT_S + (size_t)(gw - 8) * SHW);
        for (int c = lane; c < SHW; c += 64) dst[c] = bf_lo((unsigned)PS[(size_t)row * SHW + c]);
    }
}

typedef _Float16 h4 __attribute__((ext_vector_type(4)));
typedef _Float16 h8 __attribute__((ext_vector_type(8)));
#define MFMA16(a, b, c) __builtin_amdgcn_mfma_f32_16x16x16f16(a, b, c, 0, 0, 0)
#define MFMA32(a, b, c) __builtin_amdgcn_mfma_f32_16x16x32_f16(a, b, c, 0, 0, 0)
#define MFMA_PAD1(a) asm volatile("s_nop 7" : "+v"(a))
#define MFMA_PAD2(a, b) asm volatile("s_nop 7" : "+v"(a), "+v"(b))
#define MFMA_PAD5(a, b, c, d, e) asm volatile("s_nop 7" : "+v"(a), "+v"(b), "+v"(c), "+v"(d), "+v"(e))
__device__ __forceinline__ h4 cvt_h4(f32x4 v) { h4 r; r[0] = (f16)v[0]; r[1] = (f16)v[1]; r[2] = (f16)v[2]; r[3] = (f16)v[3]; return r; }
__device__ __forceinline__ f32x4 h4_f32(h4 v) { return (f32x4){(float)v[0], (float)v[1], (float)v[2], (float)v[3]}; }
constexpr int CK_NPROD = 6, CK_NCONS = 2, CK_NVB = 4 / CK_NCONS, CK_NSLOT = 6;
constexpr int CKS_ET = 0, CKS_GY = 2048, CKS_BK = 4096, CKS_XV = 8192, CKS_U0 = 10240, CKS_Y0 = 12288, CKS_LC = 14336, CKS_SIZE = 14848;
constexpr int CKP_AT = 0, CKP_BT = 2048, CKP_KT = 4096, CKP_RT = 6144, CKP_ATT = 8192, CKP_EX = 10240, CKP_LR = 11264, CKP_SIZE = 11520;
constexpr int CK_SLOTS = 0, CK_SCR = CK_NSLOT * CKS_SIZE, CK_FLAGS = CK_SCR + CK_NPROD * CKP_SIZE, CK_END = CK_FLAGS + 256;
static_assert(CK_END <= LDS_BYTES - 256, "chunked scan LDS map");
__device__ __forceinline__ int ck_img8(int row, int e4) { return row * 128 + ((((e4 >> 1) ^ (row & 7))) << 4) + ((e4 & 1) << 3); }
__device__ __forceinline__ int ck_img16(int row, int c16) { return row * 128 + ((c16 ^ (row & 7)) << 4); }
__device__ __forceinline__ bf16 f2bf_c(float f) { const unsigned u = __float_as_uint(f); return (bf16)((u + 0x7fffu + ((u >> 16) & 1u)) >> 16); }
__device__ __forceinline__ void ck_wait_ge(volatile LAS unsigned* flag, unsigned target) { while (*flag < target) __builtin_amdgcn_s_sleep(1); asm volatile("" ::: "memory"); }

struct CkRaw { u32x2 r[4], k[4], v[4], lw[4], ar[4], pr, pk, pv; };
__device__ __forceinline__ void ck_load(CkRaw& R, const bf16* PS, const f16* LW, const f16* AR, int mq, int cidx, int m_lo) {
#pragma unroll
    for (int i = 0; i < 4; ++i) { const bf16* base = PS + (size_t)(mq + i) * SHW + cidx;
        R.r[i] = *(const u32x2*)base; R.k[i] = *(const u32x2*)(base + 1024); R.v[i] = *(const u32x2*)(base + 2048);
        R.lw[i] = *(const u32x2*)(LW + (size_t)(mq + i) * 1024 + cidx); R.ar[i] = *(const u32x2*)(AR + (size_t)(mq + i) * 1024 + cidx); }
    const int mp = mq - 1 < m_lo ? m_lo : mq - 1; const bf16* pb = PS + (size_t)mp * SHW + cidx;
    R.pr = *(const u32x2*)pb; R.pk = *(const u32x2*)(pb + 1024); R.pv = *(const u32x2*)(pb + 2048);
}
struct CkK { f32x4 mu_r, mu_k, mu_v, kk, ka; };
__device__ __forceinline__ void ck_prep(LAS unsigned char* slot, LAS unsigned char* scr, const CkRaw& R, const float* const* in, int cidx, bool first, const float* ssrc, int lane) {
    const int q = lane >> 4, kg = lane & 15;
    f32x4 lv[4];
    lv[0] = dec4h(R.lw[0]); lv[1] = dec4h(R.lw[1]) + lv[0]; lv[2] = dec4h(R.lw[2]) + lv[1]; lv[3] = dec4h(R.lw[3]) + lv[2];
    *(LAS f32x4*)(scr + CKP_EX + lane * 16) = lv[3];
    const f32x4 zero4 = (f32x4){0.f, 0.f, 0.f, 0.f};
    f32x4 pre, lref, l15;
    { const f32x4 Q0 = *(const LAS f32x4*)(scr + CKP_EX + kg * 16), Q1 = *(const LAS f32x4*)(scr + CKP_EX + (16 + kg) * 16), Q2 = *(const LAS f32x4*)(scr + CKP_EX + (32 + kg) * 16), Q3 = *(const LAS f32x4*)(scr + CKP_EX + (48 + kg) * 16);
      pre = (q > 0 ? Q0 : zero4) + (q > 1 ? Q1 : zero4) + (q > 2 ? Q2 : zero4); lref = Q0 + Q1; l15 = (Q0 + Q1) + (Q2 + Q3); }
    f32x4 eC, eprev;
    { f32x4 lamref, lamC;
#pragma unroll
      for (int j = 0; j < 4; ++j) { eC[j] = __builtin_amdgcn_exp2f(l15[j] - lref[j]); lamref[j] = __builtin_amdgcn_exp2f(lref[j]); lamC[j] = __builtin_amdgcn_exp2f(l15[j]); eprev[j] = __builtin_amdgcn_exp2f(pre[j] - lref[j]); }
      if (q == 0) { *(LAS f32x4*)(slot + CKS_LC + kg * 16) = lamC; *(LAS f32x4*)(scr + CKP_LR + kg * 16) = lamref; } }
    pre = pre - lref;
    const f32x4 mu_r = *(const f32x4*)(in[6] + cidx), mu_k = *(const f32x4*)(in[6] + 1024 + cidx), mu_v = *(const f32x4*)(in[6] + 2048 + cidx), c_kk = *(const f32x4*)(in[12] + cidx), c_ka = *(const f32x4*)(in[13] + cidx);
    f32x4 pr = dec4bf(R.pr), pk = dec4bf(R.pk), pv = dec4bf(R.pv);
    if (first) { pr = zero4; pk = zero4; pv = zero4; if (ssrc) { pr = *(const f32x4*)ssrc; pk = *(const f32x4*)(ssrc + 1024); pv = *(const f32x4*)(ssrc + 2048); } }
    h4 att[4], bbt[4], kbt[4], xt[4];
#pragma unroll
    for (int i = 0; i < 4; ++i) {
        const f32x4 r = dec4bf(R.r[i]), k = dec4bf(R.k[i]), v = dec4bf(R.v[i]), ar = dec4h(R.ar[i]);
        const f32x4 xr = r + (pr - r) * mu_r, xk = k + (pk - k) * mu_k, xv = v + (pv - v) * mu_v;
        pr = r; pk = k; pv = v;
        const f32x4 kkr = xk * c_kk;
        float ssq = (kkr[0] * kkr[0] + kkr[1] * kkr[1]) + (kkr[2] * kkr[2] + kkr[3] * kkr[3]);
        ssq = row_sum16(ssq);
        const float inv = __builtin_amdgcn_rsqf(fmaxf(ssq, 1e-24f));
        const f32x4 kkn = kkr * inv;
        f32x4 e, rc;
#pragma unroll
        for (int j = 0; j < 4; ++j) { e[j] = __builtin_amdgcn_exp2f(lv[i][j] + pre[j]); rc[j] = __builtin_amdgcn_rcpf(e[j]); }
        const f32x4 at = -kkn * eprev, bt = kkn * ar * rc, kt = xk * (1.f + (ar - 1.f) * c_ka) * rc, rt = xr * e, bb = bt * eC, kb = kt * eC;
        eprev = e;
        const int o = ck_img8(4 * q + i, kg);
        *(LAS h4*)(scr + CKP_AT + o) = cvt_h4(at); *(LAS h4*)(scr + CKP_BT + o) = cvt_h4(bt); *(LAS h4*)(scr + CKP_KT + o) = cvt_h4(kt); *(LAS h4*)(scr + CKP_RT + o) = cvt_h4(rt);
#pragma unroll
        for (int j = 0; j < 4; ++j) { att[j][i] = (f16)at[j]; bbt[j][i] = (f16)bb[j]; kbt[j][i] = (f16)kb[j]; xt[j][i] = (f16)xv[j]; }
    }
#pragma unroll
    for (int j = 0; j < 4; ++j) {
        const int key = 4 * kg + j;
        *(LAS h4*)(scr + CKP_ATT + key * 32 + q * 8) = att[j];
        *(LAS h4*)(slot + CKS_BK + key * 64 + q * 16) = bbt[j]; *(LAS h4*)(slot + CKS_BK + key * 64 + q * 16 + 8) = kbt[j];
        *(LAS h4*)(slot + CKS_XV + key * 32 + q * 8) = xt[j];
    }
}
__device__ __forceinline__ void ck_mfma(LAS unsigned char* slot, LAS unsigned char* scr, int lane) {
    const int n = lane & 15, q = lane >> 4;
    const f32x4 z4 = (f32x4){0.f, 0.f, 0.f, 0.f};
    f32x4 Nab = z4, NabT = z4, NakT = z4, Nbr = z4, Nkr = z4;
#pragma unroll
    for (int ks = 0; ks < 2; ++ks) {
        const int o = ck_img16(n, 4 * ks + q);
        const h8 fa = *(const LAS h8*)(scr + CKP_AT + o), fb = *(const LAS h8*)(scr + CKP_BT + o), fk = *(const LAS h8*)(scr + CKP_KT + o), fr8 = *(const LAS h8*)(scr + CKP_RT + o);
        Nab = MFMA32(fb, fa, Nab); NabT = MFMA32(fa, fb, NabT); NakT = MFMA32(fa, fk, NakT); Nbr = MFMA32(fb, fr8, Nbr); Nkr = MFMA32(fk, fr8, Nkr);
    }
    MFMA_PAD5(Nab, NabT, NakT, Nbr, Nkr);
    f32x4 P, Qm, MakT, Mbr, Mkr, Tm, Tt;
#pragma unroll
    for (int ii = 0; ii < 4; ++ii) { const int row = 4 * q + ii;
        P[ii] = row < n ? Nab[ii] : 0.f; Qm[ii] = n < row ? NabT[ii] : 0.f; MakT[ii] = n < row ? NakT[ii] : 0.f;
        Mbr[ii] = row <= n ? Nbr[ii] : 0.f; Mkr[ii] = row <= n ? Nkr[ii] : 0.f;
        const float id = row == n ? 1.f : 0.f; Tm[ii] = id + P[ii]; Tt[ii] = id + Qm[ii]; }
#pragma unroll
    for (int lev = 0; lev < 3; ++lev) {
        const h4 hp = cvt_h4(P), hq = cvt_h4(Qm);
        f32x4 P2 = MFMA16(hq, hp, z4), Q2 = MFMA16(hp, hq, z4);
        MFMA_PAD2(P2, Q2);
        const h4 hp2 = cvt_h4(P2), hq2 = cvt_h4(Q2), ht = cvt_h4(Tm), htt = cvt_h4(Tt);
        f32x4 Tn = MFMA16(htt, hp2, Tm), Ttn = MFMA16(hp2, htt, Tt);
        MFMA_PAD2(Tn, Ttn);
        P = P2; Qm = Q2; Tm = Tn; Tt = Ttn; (void)ht; (void)hq2;
    }
    const h4 hT = cvt_h4(Tm), hMbr = cvt_h4(Mbr), hMakT = cvt_h4(MakT);
    f32x4 F = MFMA16(hMakT, hT, z4);
    f32x4 Ft = MFMA16(hT, hMakT, z4);
    MFMA_PAD2(F, Ft);
    const h4 hF = cvt_h4(F), hFt = cvt_h4(Ft);
    f32x4 Hy = MFMA16(hFt, hMbr, Mkr);
    MFMA_PAD1(Hy);
    const h4 hHy = cvt_h4(Hy);
#pragma unroll
    for (int kb = 0; kb < 4; ++kb) {
        const h4 fat = *(const LAS h4*)(scr + CKP_ATT + (16 * kb + n) * 32 + q * 8);
        const f32x4 lam = *(const LAS f32x4*)(scr + CKP_LR + (16 * kb + 4 * q) * 4);
        f32x4 E = MFMA16(fat, hT, z4);
        f32x4 Et = MFMA16(hT, fat, z4);
        MFMA_PAD2(E, Et);
        const int oe = ck_img8(n, 8 * (kb >> 1) + 2 * q + (kb & 1));
        *(LAS h4*)(slot + CKS_ET + oe) = cvt_h4(E * lam);
        const f32x4 rt = h4_f32(*(const LAS h4*)(scr + CKP_RT + ck_img8(n, 4 * kb + q)));
        f32x4 Gy = MFMA16(cvt_h4(Et), hMbr, rt);
        const h4 fx = *(const LAS h4*)(slot + CKS_XV + (16 * kb + n) * 32 + q * 8);
        f32x4 U0 = MFMA16(hF, fx, z4), Y0 = MFMA16(hHy, fx, z4);
        MFMA_PAD2(U0, Y0); MFMA_PAD1(Gy);
        *(LAS h4*)(slot + CKS_GY + oe) = cvt_h4(Gy * lam);
        *(LAS h4*)(slot + CKS_U0 + kb * 512 + lane * 8) = cvt_h4(U0); *(LAS h4*)(slot + CKS_Y0 + kb * 512 + lane * 8) = cvt_h4(Y0);
    }
}
template <bool ST_Y> __device__ __forceinline__ void ck_consume(const LAS unsigned char* slot, f32x4 (&Sb)[4], int vb, int lane, bf16* Yrow  ) {
    const int n = lane & 15, q = lane >> 4;
    f32x4 U = h4_f32(*(const LAS h4*)(slot + CKS_U0 + vb * 512 + lane * 8)), Yv = h4_f32(*(const LAS h4*)(slot + CKS_Y0 + vb * 512 + lane * 8));
#pragma unroll
    for (int ks = 0; ks < 2; ++ks) {
        const int o = ck_img16(n, 4 * ks + q);
        const h8 fe = *(const LAS h8*)(slot + CKS_ET + o), fg = *(const LAS h8*)(slot + CKS_GY + o);
        h8 fs;
#pragma unroll
        for (int j = 0; j < 8; ++j) fs[j] = (f16)Sb[2 * ks + (j >> 2)][j & 3];
        U = MFMA32(fe, fs, U); Yv = MFMA32(fg, fs, Yv);
    }
    MFMA_PAD2(U, Yv);
#pragma unroll
    for (int ii = 0; ii < 4; ++ii) { if (ST_Y) Yrow[(size_t)(4 * q + ii) * 1024 + 16 * vb + n] = f2bf_c(Yv[ii]); else asm volatile("" :: "v"(Yv[ii])); }
    const h4 fx = *(const LAS h4*)(slot + CKS_XV + (16 * vb + n) * 32 + q * 8);
    h8 fuv;
#pragma unroll
    for (int j = 0; j < 4; ++j) { fuv[j] = (f16)U[j]; fuv[4 + j] = fx[j]; }
#pragma unroll
    for (int kb = 0; kb < 4; ++kb) {
        const h8 fbk = *(const LAS h8*)(slot + CKS_BK + (16 * kb + n) * 64 + q * 16);
        const f32x4 lam = *(const LAS f32x4*)(slot + CKS_LC + (16 * kb + 4 * q) * 4);
        Sb[kb] = MFMA32(fbk, fuv, Sb[kb] * lam);
    }
}
template <class E> __device__ __forceinline__ void run_gemm_sub(LAS unsigned char* lds, const bf16* A, const bf16* Bt, int Mrows, int N, int K, const E& e, int nwg, int c) {
    pg8::Gemm g{A, Bt, Mrows, N, K}; pg8::StaticOrder S; S.init(Mrows, N, nwg, c);
    pg8::gemm_phase<E, pg8::StaticOrder, true, true>(lds, g, S, e);
}
__device__ __forceinline__ int scan_sb(int bid, int G) { return G == 256 ? ((bid & 4) ? 128 : 0) + (((bid >> 3) << 2) | (bid & 3)) : bid; }
template <int MODE> __device__ __forceinline__ void phase_scan(const Args& a, LAS unsigned char* lds) {
    PH_PROLOG
    const int sb = scan_sb(bid, G);
    const bf16* PS = (const bf16*)(a.ws + WS_PS); const f16* LW = (const f16*)((const unsigned char*)a.out + U); const f16* AR = (const f16*)(a.ws + WS_AR);
    bf16* Y = (bf16*)((unsigned char*)a.out + U);
    volatile LAS unsigned* ready = (volatile LAS unsigned*)(lds + CK_FLAGS); volatile LAS unsigned* done = ready + 8;
    const int nsw = G > 128 ? G - 128 : G, sw0 = G > 128 ? 128 : 0;
    for (int pass = 0;; ++pass) {
        int task;
        if (G > 128) { if (sb < 128) { if (pass > 0) break; task = sb; } else { task = 128 + (sb - 128) + pass * nsw; if (task >= 640) break; } }
        else { task = sb + pass * G; if (task >= 640) break; }
        (void)sw0;
        const bool samp = task >= 128; const int tq = samp ? task - 128 : task;
        const int b = tq >> 4, h = tq & 15;
        const int m0 = samp ? NPROMPT + b * 64 : b * 4096, nch = samp ? 4 : 256;
        if (tid < 16) ready[tid] = tid == 12 ? (unsigned)CK_NPROD : 0u;
        __syncthreads();
        if (wave < CK_NPROD) {
            const int q = lane >> 4, kg = lane & 15, cidx = h * 64 + 4 * kg;
            const float* ssrc = samp ? a.in[2] + (size_t)b * SHW + cidx : nullptr;
            LAS unsigned char* scr = lds + CK_SCR + wave * CKP_SIZE;
            CkRaw R;
            if (wave < nch) ck_load(R, PS, LW, AR, m0 + 16 * wave + 4 * q, cidx, m0);
            int cn = 0;
            { unsigned tk = 0u; if (lane == 0) tk = __hip_atomic_fetch_add((LAS unsigned*)(lds + CK_FLAGS) + 12, 1u, __ATOMIC_RELAXED, __HIP_MEMORY_SCOPE_WORKGROUP); cn = (int)__builtin_amdgcn_readfirstlane(tk); }
            for (int c = wave; c < nch;) {
                LAS unsigned char* slot = lds + CK_SLOTS + (c % CK_NSLOT) * CKS_SIZE;
                unsigned tch0 = 0u, tch1 = 0u;
                if (c + 2 * CK_NPROD < nch) {
                    const int mt = m0 + 16 * (c + 2 * CK_NPROD);
                    { const int tk = lane / 5, ar_ = lane - 5 * tk; const size_t row = (size_t)(mt + tk);
                      const unsigned* p = ar_ < 3 ? (const unsigned*)(PS + row * SHW + ar_ * 1024 + h * 64) : (ar_ == 3 ? (const unsigned*)(LW + row * 1024 + h * 64) : (const unsigned*)(AR + row * 1024 + h * 64));
                      tch0 = *p; }
                    if (lane < 16) { const int idx = 64 + lane, tk = idx / 5, ar_ = idx - 5 * tk; const size_t row = (size_t)(mt + tk);
                      const unsigned* p = ar_ < 3 ? (const unsigned*)(PS + row * SHW + ar_ * 1024 + h * 64) : (ar_ == 3 ? (const unsigned*)(LW + row * 1024 + h * 64) : (const unsigned*)(AR + row * 1024 + h * 64));
                      tch1 = *p; }
                }
                if (c >= CK_NSLOT) {
#pragma unroll
                    for (int j = 0; j < CK_NCONS; ++j) ck_wait_ge(done + j, (unsigned)(c - CK_NSLOT + 1));
                }
                if (MODE != 3) ck_prep(slot, scr, R, a.in, cidx, c == 0 && q == 0, ssrc, lane);
                if (cn < nch) ck_load(R, PS, LW, AR, m0 + 16 * cn + 4 * q, cidx, m0);
                if (MODE != 2) ck_mfma(slot, scr, lane);
                asm volatile("s_waitcnt lgkmcnt(0)" ::: "memory");
                if (lane == 0) ready[c % CK_NSLOT] = (unsigned)(c + 1);
                asm volatile("" :: "v"(tch0), "v"(tch1));
                c = cn;
                { unsigned tk = 0u; if (lane == 0) tk = __hip_atomic_fetch_add((LAS unsigned*)(lds + CK_FLAGS) + 12, 1u, __ATOMIC_RELAXED, __HIP_MEMORY_SCOPE_WORKGROUP); cn = (int)__builtin_amdgcn_readfirstlane(tk); }
            }
        } else if (wave < CK_NPROD + CK_NCONS) {
            const int cj = wave - CK_NPROD, n = lane & 15, q = lane >> 4;
            f32x4 Sb[CK_NVB][4];
#pragma unroll
            for (int v = 0; v < CK_NVB; ++v)
#pragma unroll
                for (int kb = 0; kb < 4; ++kb) {
                    Sb[v][kb] = (f32x4){0.f, 0.f, 0.f, 0.f};
                    if (samp) Sb[v][kb] = *(const f32x4*)(a.in[3] + ((size_t)((b * 16 + h) * 64 + 16 * (cj * CK_NVB + v) + n)) * 64 + 16 * kb + 4 * q);
                }
            for (int c = 0; c < nch; ++c) {
                const LAS unsigned char* slot = lds + CK_SLOTS + (c % CK_NSLOT) * CKS_SIZE;
                ck_wait_ge(ready + (c % CK_NSLOT), (unsigned)(c + 1));
                asm volatile("" ::: "memory");
#pragma unroll
                for (int v = 0; v < CK_NVB; ++v) { if (MODE != 4) ck_consume<MODE == 0>(slot, Sb[v], cj * CK_NVB + v, lane, Y + (size_t)(m0 + 16 * c) * 1024 + h * 64); }
                asm volatile("s_waitcnt lgkmcnt(0)" ::: "memory");
                if (lane == 0) done[cj] = (unsigned)(c + 1);
            }
            float* So = a.out + (samp ? OUT_WKV_S : OUT_WKV_P);
#pragma unroll
            for (int v = 0; v < CK_NVB; ++v)
#pragma unroll
                for (int kb = 0; kb < 4; ++kb) { if (MODE == 0) *(f32x4*)(So + ((size_t)((b * 16 + h) * 64 + 16 * (cj * CK_NVB + v) + n)) * 64 + 16 * kb + 4 * q) = Sb[v][kb]; else asm volatile("" :: "v"(Sb[v][kb])); }
        }
        __syncthreads();
    }
    if (MODE == 0 && G > 128 && sb >= 128) {
        conv_items(a, CV_EARLY, CV_ALL, (sb - 128) * 8 + wave, (G - 128) * 8, lane);
        __syncthreads();
        EpiP1b e{(bf16*)a.out, (bf16*)(a.ws + WS_P4E3), P1E_STRIDE, (float*)(a.ws + WS_LX)};
        run_gemm_sub(lds, (const bf16*)(a.ws + WS_XN), (const bf16*)(a.ws + WS_WIN) + (size_t)SHW * 1024, a.p1e, 4096, 1024, e, G - 128, sb - 128);
    }
}

__device__ __forceinline__ void ld16bf(const bf16* p, float (&o)[16]) {
    const u32x4 w0 = *(const u32x4*)p, w1 = *(const u32x4*)(p + 8); f32x4 a, b, c, d; dec8bf(w0, a, b); dec8bf(w1, c, d);
#pragma unroll
    for (int i = 0; i < 4; ++i) { o[i] = a[i]; o[4 + i] = b[i]; o[8 + i] = c[i]; o[12 + i] = d[i]; }
}
__device__ __forceinline__ void ld16h(const f16* p, float (&o)[16]) {
    const u32x4 w0 = *(const u32x4*)p, w1 = *(const u32x4*)(p + 8);
    const f32x4 a = dec4h((u32x2){w0.x, w0.y}), b = dec4h((u32x2){w0.z, w0.w}), c = dec4h((u32x2){w1.x, w1.y}), d = dec4h((u32x2){w1.z, w1.w});
#pragma unroll
    for (int i = 0; i < 4; ++i) { o[i] = a[i]; o[4 + i] = b[i]; o[8 + i] = c[i]; o[12 + i] = d[i]; }
}
__device__ __forceinline__ void ld16f(const float* p, float (&o)[16]) {
#pragma unroll
    for (int j = 0; j < 4; ++j) { const f32x4 x = ((const f32x4*)p)[j];
#pragma unroll
        for (int i = 0; i < 4; ++i) o[4 * j + i] = x[i]; }
}
__device__ __forceinline__ void tokshift16(float (&x)[16], const bf16* prevp, bool has_prev, bool samp, const float* ssrc, const float* mu) {
    float tmp[16], cst[16];
    if (has_prev) ld16bf(prevp, tmp);
    else if (samp) ld16f(ssrc, tmp);
    else {
#pragma unroll
        for (int i = 0; i < 16; ++i) tmp[i] = 0.f; }
    ld16f(mu, cst);
#pragma unroll
    for (int i = 0; i < 16; ++i) x[i] = x[i] + (tmp[i] - x[i]) * cst[i];
}
__device__ __forceinline__ float oct_sum(float x) { x += dppf<0xB1>(x); x += dppf<0x4E>(x); x += dppf<0x141>(x); return x; }
__device__ __forceinline__ void ld8f(const float* p, float (&o)[8]) { const f32x4 a = *(const f32x4*)p, b = *(const f32x4*)(p + 4);
#pragma unroll
    for (int i = 0; i < 4; ++i) { o[i] = a[i]; o[4 + i] = b[i]; } }
__device__ __forceinline__ void ld8bf(const bf16* p, float (&o)[8]) { f32x4 a, b; dec8bf(*(const u32x4*)p, a, b);
#pragma unroll
    for (int i = 0; i < 4; ++i) { o[i] = a[i]; o[4 + i] = b[i]; } }
__device__ __forceinline__ void ld8h(const f16* p, float (&o)[8]) { const u32x4 w = *(const u32x4*)p; const f32x4 a = dec4h((u32x2){w.x, w.y}), b = dec4h((u32x2){w.z, w.w});
#pragma unroll
    for (int i = 0; i < 4; ++i) { o[i] = a[i]; o[4 + i] = b[i]; } }
template <bool DRY> __device__ __forceinline__ void phase_gn(const Args& a, LAS unsigned char* lds) {
    PH_PROLOG
    const bf16* PS = (const bf16*)(a.ws + WS_PS); const f16* AR = (const f16*)(a.ws + WS_AR); f16* Gp = (f16*)(a.ws + WS_G);
    const bf16* Y = (const bf16*)((const unsigned char*)a.out + U);
    const int h = gw & 15, c = h * 64 + 8 * (lane & 7), r8 = lane >> 3;
    float mu_r[8], mu_k[8], mu_v[8], ka[8], rkc[8], gg[8], gb[8];
    ld8f(a.in[6] + c, mu_r); ld8f(a.in[6] + 1024 + c, mu_k); ld8f(a.in[6] + 2048 + c, mu_v); ld8f(a.in[13] + c, ka); ld8f(a.in[14] + c, rkc); ld8f(a.in[15] + c, gg); ld8f(a.in[16] + c, gb);
    for (int rg = gw >> 4; rg < M / 8; rg += NGW >> 4) {
        const int m = rg * 8 + r8; const bool samp = m >= NPROMPT; const int t = samp ? ((m - NPROMPT) & 63) : (m & 4095);
        const bf16* base = PS + (size_t)m * SHW + c;
        float xr[8], xk[8], xv[8], pr[8], pk[8], pv[8], ar[8], y[8], g[8];
        ld8bf(base, xr); ld8bf(base + 1024, xk); ld8bf(base + 2048, xv);
        if (t > 0) { ld8bf(base - SHW, pr); ld8bf(base - SHW + 1024, pk); ld8bf(base - SHW + 2048, pv); }
        else if (samp) { const float* ss = a.in[2] + (size_t)((m - NPROMPT) >> 6) * SHW + c; ld8f(ss, pr); ld8f(ss + 1024, pk); ld8f(ss + 2048, pv); }
        else {
#pragma unroll
            for (int i = 0; i < 8; ++i) { pr[i] = 0.f; pk[i] = 0.f; pv[i] = 0.f; } }
        ld8h(AR + (size_t)m * 1024 + c, ar); ld8bf(Y + (size_t)m * 1024 + c, y); ld8h(Gp + (size_t)m * 1024 + c, g);
        float rk = 0.f, s = 0.f;
#pragma unroll
        for (int i = 0; i < 8; ++i) {
            xr[i] = xr[i] + (pr[i] - xr[i]) * mu_r[i]; xk[i] = xk[i] + (pk[i] - xk[i]) * mu_k[i]; xv[i] = xv[i] + (pv[i] - xv[i]) * mu_v[i];
            xk[i] = xk[i] * (1.f + (ar[i] - 1.f) * ka[i]);
            rk += xr[i] * xk[i] * rkc[i]; s += y[i];
        }
        rk = oct_sum(rk);
        const float mean = oct_sum(s) * (1.f / 64.f); float q2 = 0.f;
#pragma unroll
        for (int i = 0; i < 8; ++i) { y[i] -= mean; q2 += y[i] * y[i]; }
        const float rstd = rsqrtf(oct_sum(q2) * (1.f / 64.f) + 64e-5f);
        float o[8];
#pragma unroll
        for (int i = 0; i < 8; ++i) o[i] = (y[i] * rstd * gg[i] + gb[i] + rk * xv[i]) * g[i];
        u32x4 w; w.x = pkbf(o[0], o[1]); w.y = pkbf(o[2], o[3]); w.z = pkbf(o[4], o[5]); w.w = pkbf(o[6], o[7]);
        if (!DRY || rk == 1.2345e30f) *(u32x4*)((bf16*)Gp + (size_t)m * 1024 + c) = w;
    }
}

__device__ __forceinline__ int gm_swz(int row) { return (row & 3) | (((row >> 3) & 1) << 2); }
__device__ __forceinline__ void phase_gmlp(const Args& a, LAS unsigned char* lds, int u_lo, int u_hi, int u_first, int u_step) {
    PH_PROLOG
    const bf16* PU = (const bf16*)(a.ws + WS_P4); const bf16* PV = (const bf16*)(a.ws + WS_P4 + U); bf16* OB = (bf16*)(a.ws + WS_OB);
    const bf16* WSP = (const bf16*)(a.ws + WS_WSP); const float* LNP = (const float*)(a.ws + WS_LX);
    LAS float* stats = (LAS float*)lds;
    LAS unsigned char* img = lds + 4096;
    const int trow_s = wave >= 4 ? 64 : 0, t0 = wave * 16;
    const bf16* PUn = PU; const bf16* PVn = PV; const int p1e = a.p1e;
    for (int unit = u_lo + u_first; unit < u_hi; unit += u_step) {
        const int ch = unit >> 3, g = unit & 7; const bool samp = ch >= 256; const int m0 = ch * 128;
        PU = m0 < p1e ? (const bf16*)a.out : PUn; PV = m0 < p1e ? (const bf16*)a.out + P1E_STRIDE : PVn;
        if (tid < 128) {
            const float* p = LNP + (size_t)(m0 + tid) * 32; float sm = 0.f, sq = 0.f;
#pragma unroll
            for (int j = 0; j < 8; ++j) { const f32x4 v = *(const f32x4*)(p + 4 * j); sm += v[0] + v[2]; sq += v[1] + v[3]; }
            const float mean = sm * (1.f / 1024.f), var = sq * (1.f / 1024.f) - mean * mean;
            stats[2 * tid] = mean; stats[2 * tid + 1] = rsqrtf(fmaxf(var, 0.f) + 1e-5f);
        }
        __syncthreads();
#pragma unroll
        for (int i = 0; i < 4; ++i) {
            const int p = tid + 512 * i, row = p >> 4, c8 = p & 15, gc = g * 128 + 8 * c8;
            f32x4 x0, x1; dec8bf(*(const u32x4*)(PV + (size_t)(m0 + row) * 1024 + gc), x0, x1);
            const float mean = stats[2 * row], rstd = stats[2 * row + 1];
            const f32x4 g0 = *(const f32x4*)(a.in[17] + gc), g1 = *(const f32x4*)(a.in[17] + gc + 4), b0 = *(const f32x4*)(a.in[18] + gc), b1 = *(const f32x4*)(a.in[18] + gc + 4);
            x0 = (x0 - mean) * rstd * g0 + b0; x1 = (x1 - mean) * rstd * g1 + b1;
            *(LAS u32x4*)(img + row * 256 + (((c8 >> 1) ^ gm_swz(row)) << 5) + (c8 & 1) * 16) = pk8bf(x0, x1);
            if (samp) { float* o = a.out + OUT_VS + (size_t)(m0 + row - NPROMPT) * 1024 + gc; *(f32x4*)o = x0; *(f32x4*)(o + 4) = x1; }
        }
        __syncthreads();
        const int trow_off = samp ? trow_s : 0;
        const int ks_lo = trow_off >> 5, ks_hi = (t0 + 15) >> 5;
        f32x4 acc[8];
#pragma unroll
        for (int ct = 0; ct < 8; ++ct) acc[ct] = (f32x4){0.f, 0.f, 0.f, 0.f};
        for (int ks = ks_lo; ks <= ks_hi; ++ks) {
            const bf16x8 wf = *(const bf16x8*)(WSP + ((size_t)(g * 128 + t0 - trow_off + (lane & 15))) * 128 + 32 * ks - trow_off + 8 * (lane >> 4));
            const int row = 32 * ks + 8 * (lane >> 4) + ((lane & 15) >> 2);
            const int sw = gm_swz(row);
#pragma unroll
            for (int ct = 0; ct < 8; ++ct) {
                LAS unsigned char* p = img + row * 256 + ((ct ^ sw) << 5) + (lane & 3) * 8;
                const s16x4 lo = __builtin_amdgcn_ds_read_tr16_b64_v4i16((LAS s16x4*)p), hi = __builtin_amdgcn_ds_read_tr16_b64_v4i16((LAS s16x4*)(p + 1024));
                bf16x8 vf; vf[0] = lo[0]; vf[1] = lo[1]; vf[2] = lo[2]; vf[3] = lo[3]; vf[4] = hi[0]; vf[5] = hi[1]; vf[6] = hi[2]; vf[7] = hi[3];
                acc[ct] = __builtin_amdgcn_mfma_f32_16x16x32_bf16(vf, wf, acc[ct], 0, 0, 0);
            }
        }
        asm volatile("s_nop 7" : "+v"(acc[0]), "+v"(acc[1]), "+v"(acc[2]), "+v"(acc[3]), "+v"(acc[4]), "+v"(acc[5]), "+v"(acc[6]), "+v"(acc[7]));
        const int t = t0 + (lane & 15);
        const float bias = a.in[20][g * 128 + t - trow_off];
#pragma unroll
        for (int ct = 0; ct < 8; ++ct) {
            const size_t o = (size_t)(m0 + t) * 1024 + g * 128 + 16 * ct + 4 * (lane >> 4);
            const f32x4 pu = dec4bf(*(const u32x2*)(PU + o));
            *(u32x2*)(OB + o) = pk4bf(pu * (acc[ct] + bias));
        }
        __syncthreads();
    }
}

__device__ __forceinline__ void phase_p5b(const Args& a, LAS unsigned char* lds) {
    PH_PROLOG
    const float* MO = (const float*)(a.ws + WS_MO); bf16* F = (bf16*)(a.ws + WS_F);
    for (int m = gw; m < M; m += NGW) {
        const float* xr = xrow_ptr(a, m); f32x4 v[4]; float ss = 0.f;
#pragma unroll
        for (int j = 0; j < 4; ++j) { v[j] = ((const f32x4*)(MO + (size_t)m * 1024))[lane + 64 * j]; ss += (v[j][0] * v[j][0] + v[j][1] * v[j][1]) + (v[j][2] * v[j][2] + v[j][3] * v[j][3]); }
        const float rs = rsqrtf(wave_sum(ss) * (1.f / 1024.f) + 1e-6f); float s2 = 0.f;
#pragma unroll
        for (int j = 0; j < 4; ++j) { const f32x4 g = ((const f32x4*)a.in[24])[lane + 64 * j], x = ((const f32x4*)xr)[lane + 64 * j];
            v[j] = x + v[j] * rs * g; ((f32x4*)(a.out + OUT_Y + (size_t)m * 1024))[lane + 64 * j] = v[j];
            s2 += (v[j][0] * v[j][0] + v[j][1] * v[j][1]) + (v[j][2] * v[j][2] + v[j][3] * v[j][3]); }
        const float rs2 = rsqrtf(wave_sum(s2) * (1.f / 1024.f) + 1e-6f);
#pragma unroll
        for (int j = 0; j < 4; ++j) { const f32x4 g = ((const f32x4*)a.in[25])[lane + 64 * j]; ((u32x2*)(F + (size_t)m * 1024))[lane + 64 * j] = pk4bf(v[j] * rs2 * g); }
    }
}
__device__ __forceinline__ void phase_p7b(const Args& a, LAS unsigned char* lds) {
    PH_PROLOG
    const float* F2 = (const float*)(a.ws + WS_F2);
    for (int m = gw; m < M; m += NGW) {
        f32x4 v[4]; float ss = 0.f;
#pragma unroll
        for (int j = 0; j < 4; ++j) { v[j] = ((const f32x4*)(F2 + (size_t)m * 1024))[lane + 64 * j]; ss += (v[j][0] * v[j][0] + v[j][1] * v[j][1]) + (v[j][2] * v[j][2] + v[j][3] * v[j][3]); }
        const float rs = rsqrtf(wave_sum(ss) * (1.f / 1024.f) + 1e-6f);
        f32x4* o = (f32x4*)(a.out + OUT_Y + (size_t)m * 1024);
#pragma unroll
        for (int j = 0; j < 4; ++j) { const f32x4 g = ((const f32x4*)a.in[29])[lane + 64 * j]; o[lane + 64 * j] = o[lane + 64 * j] + v[j] * rs * g; }
    }
}

#define XB_TMO      128
#define XB_XCNT(j)  (256  + 64 * (j))
#define XB_XSUB(j)  (1280 + 64 * (j))
#define XB_XGEN(j)  (2304 + 64 * (j))
#define XB_TOP      3328
#define XB_TOPGEN   3392
#define XCD_BAR_WORDS 3456
#define XB_SPIN_CAP (1u << 18)

__device__ __forceinline__ unsigned xb_ld(unsigned* p)              { return __hip_atomic_load(p, __ATOMIC_RELAXED, __HIP_MEMORY_SCOPE_AGENT); }
__device__ __forceinline__ unsigned xb_add(unsigned* p, unsigned v) { return __hip_atomic_fetch_add(p, v, __ATOMIC_RELAXED, __HIP_MEMORY_SCOPE_AGENT); }
__device__ __forceinline__ unsigned xb_xcc_id() { return (unsigned)__builtin_amdgcn_s_getreg((3 << 11) | 20) & 0xFu; }
#define XB_SPIN(cond, bar) do { unsigned _sp = 0; while (cond) { __builtin_amdgcn_s_sleep(1); \
    if ((++_sp & 255u) == 0u) { if (xb_ld(&(bar)[XB_TMO])) break; if (_sp > XB_SPIN_CAP) { atomicAdd(&(bar)[XB_TMO], 1u); break; } } } } while (0)

struct XcdBarrier {
    unsigned* bar; unsigned x;
    volatile LAS unsigned* st;
};

__device__ __forceinline__ XcdBarrier xcd_barrier_post(unsigned* bar, volatile LAS unsigned* st) {
    XcdBarrier b; b.bar = bar; b.x = xb_xcc_id(); b.st = st;
    if (threadIdx.x == 0) (void)xb_add(&bar[XB_XCNT(b.x)], 1u);
    return b;
}
__device__ __forceinline__ void xcd_barrier_complete(unsigned* bar, unsigned x, unsigned& nloc, unsigned& nx) {
    const unsigned G = gridDim.x * gridDim.y * gridDim.z;
    unsigned sum, cnt, mine, sp = 0u;
    for (;;) {
        sum = 0u; cnt = 0u; mine = 0u;
#pragma unroll
        for (unsigned j = 0; j < 16; ++j) { const unsigned c = xb_ld(&bar[XB_XCNT(j)]); sum += c; cnt += (c > 0u) ? 1u : 0u; mine = (j == x) ? c : mine; }
        if (sum == G) break;
        __builtin_amdgcn_s_sleep(1);
        if ((++sp & 255u) == 0u) { if (xb_ld(&bar[XB_TMO])) break; if (sp > XB_SPIN_CAP) { atomicAdd(&bar[XB_TMO], 1u); break; } }
    }
    nloc = mine > 0u ? mine : 1u; nx = cnt > 0u ? cnt : 1u;
}

__device__ __forceinline__ void xcd_barrier(const XcdBarrier& b) {
    asm volatile("s_waitcnt vmcnt(0)" ::: "memory");
    __syncthreads();
    if (threadIdx.x == 0) {
        unsigned* bar = b.bar;
        __builtin_amdgcn_s_waitcnt(0);
        unsigned nloc = b.st[0], nx = b.st[1];
        if (nloc == 0u) { xcd_barrier_complete(bar, b.x, nloc, nx); b.st[0] = nloc; b.st[1] = nx; }
        const unsigned old = xb_add(&bar[XB_XSUB(b.x)], 1u);
        const unsigned gen = old / nloc;
        if (old + 1u == (gen + 1u) * nloc) {
            __builtin_amdgcn_fence(__ATOMIC_RELEASE, "agent");
            asm volatile("s_waitcnt vmcnt(0)" ::: "memory");
            const unsigned og = xb_add(&bar[XB_TOP], 1u);
            const unsigned tg = og / nx;
            if (og + 1u == (tg + 1u) * nx) xb_add(&bar[XB_TOPGEN], 1u);
            else XB_SPIN(xb_ld(&bar[XB_TOPGEN]) == tg, bar);
            __builtin_amdgcn_fence(__ATOMIC_ACQUIRE, "agent");
            xb_add(&bar[XB_XGEN(b.x)], 1u);
            asm volatile("s_waitcnt vmcnt(0)" ::: "memory");
        } else {
            XB_SPIN(xb_ld(&bar[XB_XGEN(b.x)]) == gen, bar);
            __builtin_amdgcn_fence(__ATOMIC_ACQUIRE, "agent");
            asm volatile("s_waitcnt vmcnt(0)" ::: "memory");
        }
    }
    __syncthreads();
}

struct ListOrder {
    int r0, c0, r1, c1;
    __device__ __forceinline__ bool next(int i, pg8::Unit& u) const {
        if (i > 1) return false; const int r = i == 0 ? r0 : r1, c = i == 0 ? c0 : c1; if (r < 0) return false;
        const int pm = r * 64 + (c >> 5) * 8 + (c & 7); if (pm >= M / 256) return false; u.pm = pm; u.pn = (c >> 3) & 3; return true; }
    __device__ __forceinline__ void a_ready(const pg8::Unit&) const {}
    __device__ __forceinline__ void done(const pg8::Unit&) const {}
};
struct OneUnit { int pm, pn;
    __device__ __forceinline__ bool next(int i, pg8::Unit& u) const { if (i > 0) return false; u.pm = pm; u.pn = pn; return true; }
    __device__ __forceinline__ void a_ready(const pg8::Unit&) const {}
    __device__ __forceinline__ void done(const pg8::Unit&) const {}
};
struct FSlab { float* slab; __device__ __forceinline__ void operator()(int r, int c, f32x4 v) const { *(f32x4*)(slab + (size_t)(r & 255) * 1024 + c) = v; } };
constexpr int CW_TAILD = 32064;
constexpr int CW_EARLY = 32640;
constexpr int CW_TAILB = 32000;
__device__ __forceinline__ void cnt_publish(unsigned* cnt) {
    asm volatile("s_waitcnt vmcnt(0)" ::: "memory"); __syncthreads();
    if (threadIdx.x == 0) { __builtin_amdgcn_fence(__ATOMIC_RELEASE, "agent"); asm volatile("s_waitcnt vmcnt(0)" ::: "memory"); (void)xb_add(cnt, 1u); }
}
__device__ __forceinline__ void cnt_wait(unsigned* cnt, unsigned need, unsigned* bar) {
    if (threadIdx.x == 0) { XB_SPIN(xb_ld(cnt) < need, bar); __builtin_amdgcn_fence(__ATOMIC_ACQUIRE, "agent"); asm volatile("s_waitcnt vmcnt(0)" ::: "memory"); }
    __syncthreads();
}
template <class E> __device__ __forceinline__ void run_gemm_list(LAS unsigned char* lds, const bf16* A, const bf16* Bt, const E& e, const ListOrder& S) {
    pg8::Gemm g{A, Bt, M, 1024, 1024}; pg8::gemm_phase<E, ListOrder, true, true>(lds, g, S, e); __syncthreads();
}
template <class E> __device__ __forceinline__ void run_gemm(LAS unsigned char* lds, const bf16* A, const bf16* Bt, int N, int K, const E& e) {
    pg8::Gemm g{A, Bt, M, N, K}; pg8::StaticOrder S; S.init(M, N, (int)gridDim.x, (int)blockIdx.x);
    pg8::gemm_phase<E, pg8::StaticOrder, true, true>(lds, g, S, e);
}
__global__ void __launch_bounds__(512, 2) mk_fwd(Args a) {
    extern __shared__ __attribute__((aligned(16))) unsigned char lds_raw[];
    LAS unsigned char* lds = (LAS unsigned char*)lds_raw;
    unsigned char* ws = a.ws;
    const int lo = a.ph_lo, hi = a.ph_hi;
    volatile LAS unsigned* MISC = (volatile LAS unsigned*)(lds + LDS_BYTES - 256);
    if (threadIdx.x < 64) MISC[threadIdx.x] = 0u;
    __syncthreads();
#define IN(k) (lo <= (k) && (k) < hi)
#ifndef MK_SCANPROBE
#define MK_SCANPROBE 0
#endif
#ifndef MK_REP
#define MK_REP -1
#endif
#define XBAR() do { XcdBarrier b_; b_.bar = (unsigned*)a.ws; b_.x = xb_xcc_id(); b_.st = (volatile LAS unsigned*)(lds + LDS_BYTES - 256) + 8; xcd_barrier(b_); } while (0)
#define SEAM(k) do { if (IN(k) && IN((k) + 1)) { if ((k) == 0) { cg::this_grid().sync(); if (threadIdx.x == 0) (void)xb_add((unsigned*)a.ws + XB_XCNT(xb_xcc_id()), 1u); } else XBAR(); } } while (0)
#define REP(k, ...) do { if (MK_REP == (k)) { XBAR(); __VA_ARGS__; } } while (0)
    if (IN(0)) { phase_p0(a, lds); REP(0, phase_p0(a, lds)); } SEAM(0);
    if (IN(1)) { Epi8<FStoreBf16> e{{(bf16*)(ws + WS_PS), SHW}}; run_gemm(lds, (const bf16*)(ws + WS_XN), (const bf16*)(ws + WS_WIN), SHW, 1024, e); REP(1, Epi8<FStoreBf16> e{{(bf16*)(ws + WS_PS), SHW}}; run_gemm(lds, (const bf16*)(ws + WS_XN), (const bf16*)(ws + WS_WIN), SHW, 1024, e)); } SEAM(1);
    if (IN(2)) { phase_p2a(a, lds); REP(2, phase_p2a(a, lds)); } SEAM(2);
    if (IN(3)) { Epi8<FLora> e{{(f16*)((unsigned char*)a.out + U), (f16*)(ws + WS_AR), (f16*)(ws + WS_G), a.in[7], a.in[9]}}; run_gemm(lds, (const bf16*)(ws + WS_LX), (const bf16*)(ws + WS_LORA), 3072, 256, e); REP(3, Epi8<FLora> e{{(f16*)((unsigned char*)a.out + U), (f16*)(ws + WS_AR), (f16*)(ws + WS_G), a.in[7], a.in[9]}}; run_gemm(lds, (const bf16*)(ws + WS_LX), (const bf16*)(ws + WS_LORA), 3072, 256, e)); } SEAM(3);
    if (IN(4)) { phase_scan<0>(a, lds); if (MK_SCANPROBE > 0) { XBAR(); phase_scan<MK_SCANPROBE>(a, lds); }
        const int sb_ = scan_sb((int)blockIdx.x, (int)gridDim.x);
        if (a.p1e > 0 && sb_ >= 128) {
            unsigned* ctl = (unsigned*)ws; cnt_publish(ctl + CW_EARLY); cnt_wait(ctl + CW_EARLY, 128u, ctl);
            phase_gmlp(a, lds, 0, (a.p1e >> 7) * 8, sb_ - 128, 128); }
    } SEAM(4);
    if (IN(5)) { phase_gn<false>(a, lds); REP(5, phase_gn<true>(a, lds)); } SEAM(5);
    if (IN(6)) { const int p1e = a.p1e;
        EpiP1b e{(bf16*)(ws + WS_P4) + (size_t)p1e * 1024, (bf16*)(ws + WS_P4 + 3 * U) + (size_t)p1e * 1024, U / 2, (float*)(ws + WS_LX) + (size_t)p1e * 32};
        run_gemm_sub(lds, (const bf16*)(ws + WS_XN) + (size_t)p1e * 1024, (const bf16*)(ws + WS_WIN) + (size_t)SHW * 1024, M - p1e, 4096, 1024, e, (int)gridDim.x, (int)blockIdx.x); } SEAM(6);
    if (IN(7)) { phase_gmlp(a, lds, (a.p1e >> 7) * 8, 272 * 8, (int)blockIdx.x, (int)gridDim.x); } SEAM(7);
    const int wc_ = (int)blockIdx.x;
    if (IN(8)) { { u32x4* z = (u32x4*)(ws + WS_LX + RS_GRAN_OFF); const size_t n16 = 3 * RS_GRAN_BANK / 16;
            for (size_t i = (size_t)blockIdx.x * 512 + threadIdx.x; i < n16; i += (size_t)gridDim.x * 512) z[i] = (u32x4){0u, 0u, 0u, 0u}; }
        Epi8<FGateA> e{{(const bf16*)(ws + WS_P4 + 2 * U), (const bf16*)a.out + 2 * P1E_STRIDE, a.p1e, (bf16*)(ws + WS_MM)}};
        run_gemm_list(lds, (const bf16*)(ws + WS_OA), (const bf16*)(ws + WS_WA), e, ListOrder{0, wc_, 1, wc_}); } SEAM(8);
    if (IN(9)) {
        if (wc_ < 32) { Epi8<FGateA> e{{(const bf16*)(ws + WS_P4 + 2 * U), (const bf16*)a.out + 2 * P1E_STRIDE, a.p1e, (bf16*)(ws + WS_MM)}};
            run_gemm_list(lds, (const bf16*)(ws + WS_OA), (const bf16*)(ws + WS_WA), e, ListOrder{2, wc_, -1, 0}); }
        Epi8<FGateB> e{{(const bf16*)(ws + WS_P4 + 3 * U), (const bf16*)(ws + WS_P4E3), a.p1e, (bf16*)(ws + WS_MM)}};
        run_gemm_list(lds, (const bf16*)(ws + WS_OB), (const bf16*)(ws + WS_WB), e, wc_ < 32 ? ListOrder{1, wc_, -1, 0} : ListOrder{0, wc_, 1, wc_}); } SEAM(9);
    if (IN(10)) { unsigned* ctl = (unsigned*)ws; float* slots = (float*)(ws + WS_LX);
        if (wc_ < 64) { Epi8<FGateB> e{{(const bf16*)(ws + WS_P4 + 3 * U), (const bf16*)(ws + WS_P4E3), a.p1e, (bf16*)(ws + WS_MM)}};
            run_gemm_list(lds, (const bf16*)(ws + WS_OB), (const bf16*)(ws + WS_WB), e, wc_ < 32 ? ListOrder{0, wc_, -1, 0} : ListOrder{2, wc_ - 32, -1, 0});
            cnt_publish(ctl + CW_TAILB); }
        unsigned long long* gr = (unsigned long long*)(ws + WS_LX + RS_GRAN_OFF);
        EpiMix e{a.in[0], a.in[1], a.out, (bf16*)(ws + WS_F), a.in[24], a.in[25], RowStat{gr, ctl}, RowStat{gr + RS_GRAN_BANK / 8, ctl}};
        pg8::Gemm g{(const bf16*)(ws + WS_MM), (const bf16*)(ws + WS_WO), M, 1024, 1024};
#pragma unroll 1
        for (int rr = 0; rr < 3; ++rr) {
            int r = rr, c = wc_;
            if (rr == 0 && wc_ < 64) c = 256;
            if (rr == 2) { if (wc_ < 64) r = 0; else if (wc_ < 96) c = wc_ - 64; else c = 256; }
            if (rr == 2 && c < 256) cnt_wait(ctl + CW_TAILB, 64u, ctl);
            RoundOrder S{r, c}; pg8::gemm_phase<EpiMix, RoundOrder, false, true>(lds, g, S, e);
            LDS_BAR(); }
    } SEAM(10);
    if (IN(12)) { EpiGU e{(bf16*)(ws + WS_H)}; run_gemm(lds, (const bf16*)(ws + WS_F), (const bf16*)(ws + WS_GU), 2 * DFF, 1024, e); REP(12, EpiGU e{(bf16*)(ws + WS_H)}; run_gemm(lds, (const bf16*)(ws + WS_F), (const bf16*)(ws + WS_GU), 2 * DFF, 1024, e)); } SEAM(12);
    if (IN(13)) { unsigned* ctl = (unsigned*)ws; float* slots = (float*)(ws + WS_LX);
        EpiFfn e{a.out, a.in[29], RowStat{(unsigned long long*)(ws + WS_LX + RS_GRAN_OFF) + 2 * (RS_GRAN_BANK / 8), ctl}};
        pg8::Gemm g{(const bf16*)(ws + WS_H), (const bf16*)(ws + WS_WD), M, 1024, DFF};
#pragma unroll 1
        for (int r = 0; r < 2; ++r) { RoundOrder S{r, wc_}; pg8::gemm_phase<EpiFfn, RoundOrder, false, true>(lds, g, S, e); LDS_BAR(); }
        if (gridDim.x == 256) {
            const int t = wc_ >> 3, sl = wc_ & 7, rb = 128 + (t >> 2), kt0 = sl < 6 ? 6 * sl : 36 + 4 * (sl - 6);
            float* pslab = (float*)(ws + WS_F) + (size_t)(rb - 128) * 8 * 256 * 1024;
            Epi4<FSlab> es{{pslab + (size_t)sl * 256 * 1024}};
            pg8::Gemm gt{(const bf16*)(ws + WS_H) + kt0 * 64, (const bf16*)(ws + WS_WD) + kt0 * 64, M, 1024, DFF, sl < 6 ? 6 : 4};
            pg8::gemm_phase<Epi4<FSlab>, OneUnit, true, true>(lds, gt, OneUnit{rb, t & 3}, es);
            cnt_publish(ctl + CW_TAILD + 64 * (rb - 128));
            cnt_wait(ctl + CW_TAILD + 64 * (rb - 128), 32u, ctl);
            const int lane = threadIdx.x & 63, rl = (wc_ & 31) * 8 + (int)(threadIdx.x >> 6); const size_t row = (size_t)rb * 256 + rl;
            f32x4 v[4]; float ss = 0.f;
#pragma unroll
            for (int jq = 0; jq < 4; ++jq) { f32x4 acc4 = (f32x4){0.f, 0.f, 0.f, 0.f};
#pragma unroll
                for (int k = 0; k < 8; ++k) acc4 += *(const f32x4*)(pslab + ((size_t)k * 256 + rl) * 1024 + 256 * jq + 4 * lane);
                v[jq] = acc4; ss += acc4[0] * acc4[0] + acc4[1] * acc4[1] + acc4[2] * acc4[2] + acc4[3] * acc4[3]; }
            ss = wave_sum(ss);
            const float rs = rsqrtf(ss * (1.f / 1024.f) + 1e-6f);
            float* orow = a.out + row * 1024;
#pragma unroll
            for (int jq = 0; jq < 4; ++jq) { const int c = 256 * jq + 4 * lane; const f32x4 xv = *(const f32x4*)(orow + c), gg = *(const f32x4*)(a.in[29] + c); *(f32x4*)(orow + c) = xv + v[jq] * rs * gg; }
        } else { RoundOrder S{2, wc_}; pg8::gemm_phase<EpiFfn, RoundOrder, false, true>(lds, g, S, e); __syncthreads(); }
    }
    if (MK_REP == 100) { for (int i = 0; i < 14; ++i) XBAR(); }
#undef IN
#undef SEAM
}


#ifndef MK_DBG
#define MK_DBG 0
#endif
__global__ void dbg_zero(float* p, size_t n) { for (size_t i = (size_t)blockIdx.x * blockDim.x + threadIdx.x; i < n; i += (size_t)gridDim.x * blockDim.x) p[i] = 0.f; }
extern "C" void kernel_launch(void* const* d_in, const int* in_sizes, int n_in, void* d_out, int out_size, void* d_ws, size_t ws_size, hipStream_t stream) {
    static int grid = 0, bad = 0;
    if (grid == 0) {
        if (n_in != 30 || (size_t)out_size != OUT_END || ws_size < WS_END) { bad = 1; fprintf(stderr, "kernel_launch: unexpected shapes (n_in %d out %d ws %zu, need ws >= %zu)\n", n_in, out_size, ws_size, (size_t)WS_END); }
        int dev = 0, cus = 0, per_cu = 0;
        (void)hipGetDevice(&dev); (void)hipDeviceGetAttribute(&cus, hipDeviceAttributeMultiprocessorCount, dev);
        (void)hipFuncSetAttribute((const void*)mk_fwd, hipFuncAttributeMaxDynamicSharedMemorySize, LDS_BYTES);
        (void)hipOccupancyMaxActiveBlocksPerMultiprocessor(&per_cu, (const void*)mk_fwd, 512, LDS_BYTES);
        if (per_cu < 1) { fprintf(stderr, "kernel_launch: occupancy query says %d blocks per CU\n", per_cu); per_cu = 1; }
        grid = cus > 0 ? cus : 256;
        (void)hipGetLastError();
    }
    if (bad) return;
    Args a{};
    for (int i = 0; i < 30; ++i) a.in[i] = (const float*)d_in[i];
    a.out = (float*)d_out; a.ws = (unsigned char*)d_ws; a.p1e = grid > 128 ? P1E_HOST : 0;
#if MK_ONE_LAUNCH
    (void)hipMemsetAsync(d_ws, 0, 131072, stream);
    a.ph_lo = 0; a.ph_hi = NPHASE;
    void* args[] = {&a};
    hipError_t e = hipLaunchCooperativeKernel((const void*)mk_fwd, dim3(grid), dim3(512), args, LDS_BYTES, stream);
    if (e != hipSuccess) fprintf(stderr, "cooperative launch failed: %s (grid %d)\n", hipGetErrorString(e), grid);
#else
    const int nph = MK_DBG == 1 ? 5 : (MK_DBG == 2 ? 3 : (MK_DBG == 3 ? 8 : NPHASE));
    for (int p = 0; p < nph; ++p) { a.ph_lo = p; a.ph_hi = p + 1; hipLaunchKernelGGL(mk_fwd, dim3(grid), dim3(512), LDS_BYTES, stream, a); }
    float* o = (float*)d_out;
    if (MK_DBG >= 1) hipLaunchKernelGGL(dbg_zero, dim3(1024), dim3(256), 0, stream, o + OUT_Y, (size_t)M * 1024);
    if (MK_DBG == 1 || MK_DBG == 2) hipLaunchKernelGGL(dbg_zero, dim3(1024), dim3(256), 0, stream, o + OUT_VS, (size_t)32 * 64 * 1024);
    if (MK_DBG == 2) { hipLaunchKernelGGL(dbg_zero, dim3(1024), dim3(256), 0, stream, o + OUT_WKV_P, (size_t)8 * 16 * 4096); hipLaunchKernelGGL(dbg_zero, dim3(1024), dim3(256), 0, stream, o + OUT_WKV_S, (size_t)32 * 16 * 4096); }
#endif
}
```
